# Optimizing an MI355X kernel written in HIP

```python
import math
import jax
import jax.numpy as jnp
from jax import lax
import numpy as np


D_MODEL = 1024
BATCH = 32
SEQ = 2048
DEPTH = 2

N_A = DEPTH // 2
N_B = DEPTH - N_A
CONV_W = 3
D_FF = 2816
N_HEADS = 16
N_KV_GROUPS = 4
HPG = N_HEADS // N_KV_GROUPS
HEAD_DIM = 64
CMP_LEN = 32
CMP_STRIDE = 16
CMP_HIDDEN = 128
SLC_LEN = 64
N_SEL = 16
WINDOW = 512
Q_BLOCK = 128
BAND = WINDOW + Q_BLOCK
N_BUCKETS = 32
MAX_DISTANCE = 128
N_KV_SLOTS = 6
EPS = 1e-6
NEG = -1e30

kernel_name = 'yoco_shortconv_nsa_hybrid'


def rmsnorm(x, g):
    xf = x.astype(jnp.float32)
    y = xf * lax.rsqrt(jnp.mean(xf * xf, axis=-1, keepdims=True) + EPS)
    return (y * g.astype(jnp.float32)).astype(x.dtype)


def causal_dwconv(u, w):
    s = u.shape[1]
    up = jnp.pad(u, ((0, 0), (CONV_W - 1, 0), (0, 0)))
    return sum(up[:, k:k + s] * w[k] for k in range(CONV_W))


def rel_bucket(dist):
    max_exact = N_BUCKETS // 2
    d = jnp.maximum(dist, 0)
    df = jnp.maximum(d, 1).astype(jnp.float32)
    large = max_exact + (jnp.log(df / max_exact) / math.log(MAX_DISTANCE / max_exact)
                         * (N_BUCKETS - max_exact)).astype(jnp.int32)
    return jnp.where(d < max_exact, d, jnp.minimum(large, N_BUCKETS - 1))


def short_conv_mixer(h, w_in, conv_w, w_out):
    bg, cg, v = jnp.split(h @ w_in, 3, axis=-1)
    return (bg * causal_dwconv(cg * v, conv_w)) @ w_out


def conv_ffn(h, w_up, conv_w, w_down):
    u = causal_dwconv(h @ w_up, conv_w)
    a, g = jnp.split(u, 2, axis=-1)
    return (jax.nn.silu(a) * g) @ w_down


def nsa_shared_kv(s, w_kv, cmp_pe, cmp_w1, cmp_b1, cmp_w2):
    b, n, _ = s.shape
    kv = (s @ w_kv).reshape(b, n, N_KV_SLOTS, N_KV_GROUPS, HEAD_DIM)
    n_c = (n - CMP_LEN) // CMP_STRIDE + 1
    n_s = n // SLC_LEN
    idx = (jnp.arange(n_c) * CMP_STRIDE)[:, None] + jnp.arange(CMP_LEN)[None, :]

    def compress(tok, j):
        blk = tok[:, idx] + cmp_pe[j][None, None, :, None, :]
        blk = blk.transpose(0, 1, 3, 2, 4).reshape(b, n_c, N_KV_GROUPS, CMP_LEN * HEAD_DIM)
        return jax.nn.gelu(blk @ cmp_w1[j] + cmp_b1[j]) @ cmp_w2[j]

    k_cmp = compress(kv[:, :, 0], 0)
    v_cmp = compress(kv[:, :, 1], 1)
    k_slc = kv[:, :, 2].reshape(b, n_s, SLC_LEN, N_KV_GROUPS, HEAD_DIM)
    v_slc = kv[:, :, 3].reshape(b, n_s, SLC_LEN, N_KV_GROUPS, HEAD_DIM)
    pad = ((0, 0), (WINDOW, 0), (0, 0), (0, 0))
    k_win = jnp.pad(kv[:, :, 4], pad)
    v_win = jnp.pad(kv[:, :, 5], pad)
    return (k_cmp, v_cmp, k_slc, v_slc, k_win, v_win)


def nsa_query_block(q, gate, qs, k_cmp, v_cmp, k_slc, v_slc, k_win, v_win, rel_bias, overlap):
    t_len = q.shape[0]
    n_c = k_cmp.shape[0]
    n_s = k_slc.shape[0]
    n_sel = min(N_SEL, n_s)
    garr = jnp.arange(N_KV_GROUPS)
    tb = rel_bias.astype(jnp.float32).reshape(N_BUCKETS, N_KV_GROUPS, HPG)
    qg = (q * HEAD_DIM ** -0.5).reshape(t_len, N_KV_GROUPS, HPG, HEAD_DIM).transpose(1, 2, 0, 3)
    t_pos = qs + jnp.arange(t_len)

    c_end = jnp.arange(n_c) * CMP_STRIDE + (CMP_LEN - 1)
    dist_c = t_pos[:, None] - c_end[None, :]
    mask_c = dist_c >= 0
    bias_c = tb[rel_bucket(dist_c)].transpose(2, 3, 0, 1)
    s_c = jnp.einsum('ghtd,cgd->ghtc', qg, k_cmp).astype(jnp.float32) + bias_c
    p_c = jax.nn.softmax(jnp.where(mask_c, s_c, NEG), axis=-1) * mask_c
    o_c = jnp.einsum('ghtc,cgd->ghtd', p_c.astype(v_cmp.dtype), v_cmp)

    imp = jnp.einsum('ghtc,cs->gts', p_c, overlap)
    cur = t_pos // SLC_LEN
    jb = jnp.arange(n_s)[None, :]
    forced = (jb == 0) | (jb == cur[:, None]) | (jb == cur[:, None] - 1)
    score = jnp.where(forced, jnp.inf, jnp.where(jb <= cur[:, None], imp, -jnp.inf))
    _, sel = lax.top_k(score, n_sel)
    key_pos = sel[..., None] * SLC_LEN + jnp.arange(SLC_LEN)
    dist_s = t_pos[None, :, None, None] - key_pos
    mask_s = dist_s >= 0
    ks = k_slc.transpose(2, 0, 1, 3)[garr[:, None, None], sel]
    vs = v_slc.transpose(2, 0, 1, 3)[garr[:, None, None], sel]
    bias_s = jnp.moveaxis(tb[rel_bucket(dist_s), garr[:, None, None, None]], -1, 1)
    s_s = jnp.einsum('ghtd,gtnld->ghtnl', qg, ks).astype(jnp.float32) + bias_s
    s_s = jnp.where(mask_s[:, None], s_s, NEG)
    p_s = jax.nn.softmax(s_s.reshape(N_KV_GROUPS, HPG, t_len, -1), axis=-1).reshape(s_s.shape)
    o_s = jnp.einsum('ghtnl,gtnld->ghtd', p_s.astype(vs.dtype), vs)

    kw = lax.dynamic_slice_in_dim(k_win, qs, BAND, axis=0)
    vw = lax.dynamic_slice_in_dim(v_win, qs, BAND, axis=0)
    key_pos_w = qs - WINDOW + jnp.arange(BAND)
    dist_w = t_pos[:, None] - key_pos_w[None, :]
    mask_w = (dist_w >= 0) & (dist_w < WINDOW) & (key_pos_w[None, :] >= 0)
    bias_w = tb[rel_bucket(dist_w)].transpose(2, 3, 0, 1)
    s_w = jnp.einsum('ghtd,kgd->ghtk', qg, kw).astype(jnp.float32) + bias_w
    p_w = jax.nn.softmax(jnp.where(mask_w, s_w, NEG), axis=-1)
    o_w = jnp.einsum('ghtk,kgd->ghtd', p_w.astype(vw.dtype), vw)

    g = gate.reshape(t_len, N_KV_GROUPS, HPG, 3).transpose(1, 2, 0, 3)
    o = g[..., 0:1] * o_c + g[..., 1:2] * o_s + g[..., 2:3] * o_w
    return o.transpose(2, 0, 1, 3).reshape(t_len, N_HEADS * HEAD_DIM)


def nsa_mixer(h, w_qg, w_o, kv, rel_bias):
    b, n, _ = h.shape
    k_cmp, v_cmp, k_slc, v_slc, k_win, v_win = kv
    n_c = k_cmp.shape[1]
    n_s = k_slc.shape[1]
    nq = n // Q_BLOCK
    c_start = jnp.arange(n_c)[:, None] * CMP_STRIDE
    s_start = jnp.arange(n_s)[None, :] * SLC_LEN
    overlap = ((c_start < s_start + SLC_LEN) & (c_start + CMP_LEN > s_start)).astype(jnp.float32)
    hd = N_HEADS * HEAD_DIM
    qg = h @ w_qg
    q = qg[..., :hd].reshape(b * nq, Q_BLOCK, N_HEADS, HEAD_DIM)
    gate = jax.nn.sigmoid(qg[..., hd:]).reshape(b * nq, Q_BLOCK, N_HEADS, 3)
    b_idx = jnp.repeat(jnp.arange(b), nq)
    q_start = jnp.tile(jnp.arange(nq) * Q_BLOCK, b)

    def step(args):
        qb, gb, bi, qs = args
        return nsa_query_block(qb, gb, qs, k_cmp[bi], v_cmp[bi], k_slc[bi], v_slc[bi],
                               k_win[bi], v_win[bi], rel_bias, overlap)

    o = lax.map(step, (q, gate, b_idx, q_start))
    return o.reshape(b, n, hd) @ w_o


def setup_inputs(seed: int = 0) -> dict:
    key = jax.random.key(seed)
    k = jax.random.split(key, 20)

    def nrm(kk, shape, scale):
        return jax.random.normal(kk, shape, jnp.float32) * scale

    def gain(kk, shape):
        return 1.0 + 0.02 * jax.random.normal(kk, shape, jnp.float32)

    d, f, hd = D_MODEL, D_FF, N_HEADS * HEAD_DIM
    return {
        'x': nrm(k[0], (BATCH, SEQ, d), 1.0),
        'mix_norm': gain(k[1], (DEPTH, d)),
        'a_w_in': nrm(k[2], (N_A, d, 3 * d), d ** -0.5),
        'a_conv': nrm(k[3], (N_A, CONV_W, d), CONV_W ** -0.5),
        'a_w_out': nrm(k[4], (N_A, d, d), d ** -0.5),
        'ffn_norm': gain(k[5], (DEPTH, d)),
        'ffn_up': nrm(k[6], (DEPTH, d, 2 * f), d ** -0.5),
        'ffn_conv': nrm(k[7], (DEPTH, CONV_W, 2 * f), CONV_W ** -0.5),
        'ffn_down': nrm(k[8], (DEPTH, f, d), f ** -0.5),
        'kv_norm': gain(k[9], (d,)),
        'w_kv': nrm(k[10], (d, N_KV_SLOTS * N_KV_GROUPS * HEAD_DIM), d ** -0.5),
        'cmp_pe': nrm(k[11], (2, CMP_LEN, HEAD_DIM), 0.1),
        'cmp_w1': nrm(k[12], (2, CMP_LEN * HEAD_DIM, CMP_HIDDEN), (CMP_LEN * HEAD_DIM) ** -0.5),
        'cmp_b1': nrm(k[13], (2, CMP_HIDDEN), 0.02),
        'cmp_w2': nrm(k[14], (2, CMP_HIDDEN, HEAD_DIM), CMP_HIDDEN ** -0.5),
        'b_w_qg': nrm(k[15], (N_B, d, hd + 3 * N_HEADS), d ** -0.5),
        'b_w_o': nrm(k[16], (N_B, hd, d), hd ** -0.5),
        'rel_bias': nrm(k[17], (N_BUCKETS, N_HEADS), 0.5),
        'final_norm': gain(k[18], (d,)),
    }


def reference(x, mix_norm, a_w_in, a_conv, a_w_out, ffn_norm, ffn_up, ffn_conv, ffn_down,
              kv_norm, w_kv, cmp_pe, cmp_w1, cmp_b1, cmp_w2, b_w_qg, b_w_o, rel_bias, final_norm):
    kv = None
    for layer in range(DEPTH):
        if layer < N_A:
            i = layer
            x = x + short_conv_mixer(rmsnorm(x, mix_norm[layer]), a_w_in[i], a_conv[i], a_w_out[i])
        else:
            i = layer - N_A
            if layer == N_A:
                kv = nsa_shared_kv(rmsnorm(x, kv_norm), w_kv, cmp_pe, cmp_w1, cmp_b1, cmp_w2)
            x = x + nsa_mixer(rmsnorm(x, mix_norm[layer]), b_w_qg[i], b_w_o[i], kv, rel_bias)
        x = x + conv_ffn(rmsnorm(x, ffn_norm[layer]), ffn_up[layer], ffn_conv[layer], ffn_down[layer])
    return rmsnorm(x, final_norm)
```

```cpp
#include <hip/hip_runtime.h>
#include <hip/hip_cooperative_groups.h>
#include <cstdio>
namespace cg = cooperative_groups;

#define LAS __attribute__((address_space(3)))
typedef unsigned short bf16_t;
typedef short bf16x8 __attribute__((ext_vector_type(8)));
typedef float f32x4 __attribute__((ext_vector_type(4)));
typedef float f32x2 __attribute__((ext_vector_type(2)));
typedef unsigned u32x4 __attribute__((ext_vector_type(4)));
typedef unsigned u32x2 __attribute__((ext_vector_type(2)));

constexpr int NB = 32, SEQ = 2048, DM = 1024, DFF = 2816, MROWS = NB * SEQ;
constexpr int NKV = 1536, NQG = 1072, NKVQG = 2816, NCMP = 127;
constexpr int NTHREADS = 512;
constexpr int LDS_BYTES = 147456 + 16;

constexpr size_t WS_WIN = 0;
constexpr size_t WS_WOUT = WS_WIN + (size_t)3072 * 1024 * 2;
constexpr size_t WS_WUP0 = WS_WOUT + (size_t)1024 * 1024 * 2;
constexpr size_t WS_WUP1 = WS_WUP0 + (size_t)5632 * 1024 * 2;
constexpr size_t WS_WDN0 = WS_WUP1 + (size_t)5632 * 1024 * 2;
constexpr size_t WS_WDN1 = WS_WDN0 + (size_t)1024 * 2816 * 2;
constexpr size_t WS_WKVQG = WS_WDN1 + (size_t)1024 * 2816 * 2;
constexpr size_t WS_WO = WS_WKVQG + (size_t)2816 * 1024 * 2;
constexpr size_t WS_W1T = WS_WO + (size_t)1024 * 1024 * 2;
constexpr size_t WS_B1F = WS_W1T + (size_t)2 * 256 * 2048 * 2;
constexpr size_t WS_HB = 56ull << 20;
constexpr size_t WS_BIG = WS_HB + (size_t)MROWS * 1024 * 2;
constexpr size_t WS_KV = WS_BIG;
constexpr size_t WS_Q = WS_BIG + (size_t)MROWS * NKV * 2;
constexpr size_t WS_Y = WS_BIG + (size_t)MROWS * DFF * 2;
constexpr size_t WS_RAW = WS_Y + (size_t)MROWS * 1024 * 2;
constexpr size_t WS_GATE = WS_RAW + (size_t)16384 * 5632 * 2;
constexpr size_t WS_KCMP = WS_GATE + (size_t)MROWS * 48 * 4;
constexpr size_t WS_RS = WS_KCMP + (size_t)2 * 32 * 128 * 4 * 64 * 4;
constexpr size_t WS_KCB = WS_RS + (size_t)MROWS * 4;
constexpr size_t WS_HID = WS_KCB + (size_t)2 * 32 * 128 * 4 * 64 * 2;
constexpr size_t WS_SSP = WS_HID + (size_t)2 * 16384 * 128 * 4;
constexpr size_t WS_BAR = WS_SSP + (size_t)MROWS * 16 * 4;
constexpr size_t WS_END = WS_BAR + 16384;

__device__ __forceinline__ float bf2f(bf16_t b) { return __uint_as_float(((unsigned)b) << 16); }
__device__ __forceinline__ bf16_t f2bf(float f) { unsigned u = __float_as_uint(f); u += 0x7fffu + ((u >> 16) & 1u); return (bf16_t)(u >> 16); }
__device__ __forceinline__ unsigned cvt_pk_bf16(float lo, float hi) { unsigned r; asm volatile("v_cvt_pk_bf16_f32 %0, %1, %2" : "=v"(r) : "v"(lo), "v"(hi)); return r; }
__device__ __forceinline__ float wave_sum(float v) { for (int o = 32; o >= 1; o >>= 1) v += __shfl_xor(v, o); return v; }
__device__ __forceinline__ float wave_max(float v) { for (int o = 32; o >= 1; o >>= 1) v = fmaxf(v, __shfl_xor(v, o)); return v; }

__device__ __forceinline__ float gelu_tanh(float x) { const float u = 0.7978845608028654f * (x + 0.044715f * x * x * x); return 0.5f * x * (1.0f + tanhf(u)); }
struct Args { const float* in[19]; float* out; unsigned char* ws; int ph_lo, ph_hi, seq0, nseq, nchunk, pad; };

namespace pg8 {
constexpr int BM = 256, BK = 64, HALF = 128, HTB = HALF * BK * 2, STAGE_BYTES = 8 * HTB, NXCD = 8, WGM = 8;
__host__ __device__ __forceinline__ int lds_byte(int r, int c) { const int st = (r >> 4) * 2 + (c >> 5), rr = r & 15, cc = c & 31, ob = rr * 64 + cc * 2; return st * 1024 + (ob ^ (((ob >> 9) & 1) << 5)); }
__host__ __device__ __forceinline__ void stage_rc(int b, int& R, int& C) { const int st = b / 1024, sb = b % 1024, swz = sb ^ (((sb >> 9) & 1) << 5); R = (st >> 1) * 16 + swz / 64; C = (st & 1) * 32 + (swz % 64) / 2; }
__host__ __device__ __forceinline__ int perm32(int rho) { const int n = rho >> 4, i = rho & 15; return 8 * (i >> 2) + 4 * n + (i & 3); }
struct Unit { int pm, pn; };
struct Gemm { const bf16_t* A; const bf16_t* Bt; int M, N, K; int amode, aperm; size_t a_kstep, a_hstep, a_tstep, a_pnstep; };
__device__ __forceinline__ Gemm dense(const bf16_t* A, const bf16_t* Bt, int M, int N, int K) { Gemm g; g.A = A; g.Bt = Bt; g.M = M; g.N = N; g.K = K; g.amode = 0; g.aperm = 0; g.a_kstep = 128; g.a_hstep = (size_t)128 * K * 2; g.a_tstep = (size_t)256 * K * 2; g.a_pnstep = 0; return g; }
struct StaticOrder {
    int nM, nN, nwg, G, c;
    __device__ void init(int M, int N, int G_, int c_) { nM = M / BM; nN = N / BM; nwg = nM * nN; G = G_; c = c_; }
    __device__ bool next(int i, Unit& u) const {
        const long L = (long)i * G + c; if (L >= nwg) return false;
        int wgid = (int)L; { const int q = nwg / NXCD, r = nwg % NXCD, xcd = wgid % NXCD, off = wgid / NXCD; wgid = (xcd < r ? xcd * (q + 1) : r * (q + 1) + (xcd - r) * q) + off; }
        const int nig = WGM * nN, gid = wgid / nig, fm = gid * WGM, gsz = (nM - fm) < WGM ? (nM - fm) : WGM;
        u.pm = fm + ((wgid % nig) % gsz); u.pn = (wgid % nig) / gsz; return true;
    }
};

__device__ __forceinline__ float row_scale16(const float* ssp, int row, int fq) {
    const f32x4 p = *(const f32x4*)(ssp + (size_t)row * 16 + 4 * fq); float s = (p[0] + p[1]) + (p[2] + p[3]);
    s += __shfl_xor(s, 16); s += __shfl_xor(s, 32); return rsqrtf(s * (1.0f / DM) + 1e-6f); }
template <bool BASE_F32, bool OUT_F32> struct EpiResid {
    static constexpr bool PERM = true; static constexpr bool HAS_PRE = false;
    const float* base32; bf16_t* xb; float* out32; float* ssp;
    __device__ __forceinline__ void operator()(f32x4 (&acc)[2][2][4][2], const Unit& u, int ui, int wr, int wc, int fr, int fq) const {
        const int row0 = u.pm * BM + wr * 64 + fr, col0 = u.pn * BM + wc * 32 + 8 * fq;
#pragma unroll
        for (int ai = 0; ai < 2; ++ai)
#pragma unroll
            for (int m = 0; m < 4; ++m) { const int row = row0 + ai * HALF + m * 16; const size_t off = (size_t)row * DM + col0; float ss = 0.f;
#pragma unroll
                for (int bj = 0; bj < 2; ++bj) { const size_t o = off + bj * HALF; f32x4 v0, v1;
                    if (BASE_F32) { v0 = *(const f32x4*)(base32 + o); v1 = *(const f32x4*)(base32 + o + 4); }
                    else { const u32x4 b = *(const u32x4*)(xb + o);
                        v0 = (f32x4){__uint_as_float(b.x << 16), __uint_as_float(b.x & 0xffff0000u), __uint_as_float(b.y << 16), __uint_as_float(b.y & 0xffff0000u)};
                        v1 = (f32x4){__uint_as_float(b.z << 16), __uint_as_float(b.z & 0xffff0000u), __uint_as_float(b.w << 16), __uint_as_float(b.w & 0xffff0000u)}; }
                    v0 += acc[ai][bj][m][0]; v1 += acc[ai][bj][m][1];
                    ss += ((v0[0] * v0[0] + v0[1] * v0[1]) + (v0[2] * v0[2] + v0[3] * v0[3])) + ((v1[0] * v1[0] + v1[1] * v1[1]) + (v1[2] * v1[2] + v1[3] * v1[3]));
                    if (OUT_F32) { *(f32x4*)(out32 + o) = v0; *(f32x4*)(out32 + o + 4) = v1; }
                    else { u32x4 w; w.x = cvt_pk_bf16(v0[0], v0[1]); w.y = cvt_pk_bf16(v0[2], v0[3]); w.z = cvt_pk_bf16(v1[0], v1[1]); w.w = cvt_pk_bf16(v1[2], v1[3]); *(u32x4*)(xb + o) = w; } }
                if (!OUT_F32) { ss += __shfl_xor(ss, 16); ss += __shfl_xor(ss, 32); if (fq == 0) ssp[(size_t)row * 16 + u.pn * 4 + wc] = ss; } }
    }
};
struct EpiKVQG {
    static constexpr bool PERM = true;
    const float* ssp; bf16_t* kv; bf16_t* q; float* gate;
    __device__ __forceinline__ void operator()(f32x4 (&acc)[2][2][4][2], const Unit& u, int ui, int wr, int wc, int fr, int fq) const {
        const int row0 = u.pm * BM + wr * 64 + fr, cin = wc * 32 + 8 * fq;
#pragma unroll
        for (int ai = 0; ai < 2; ++ai)
#pragma unroll
            for (int m = 0; m < 4; ++m) { const int row = row0 + ai * HALF + m * 16; const float s = row_scale16(ssp, row, fq);
#pragma unroll
                for (int bj = 0; bj < 2; ++bj) { f32x4 v0 = acc[ai][bj][m][0] * s, v1 = acc[ai][bj][m][1] * s; const int col = cin + bj * HALF;
                    if (u.pn < 6) { u32x4 w; w.x = cvt_pk_bf16(v0[0], v0[1]); w.y = cvt_pk_bf16(v0[2], v0[3]); w.z = cvt_pk_bf16(v1[0], v1[1]); w.w = cvt_pk_bf16(v1[2], v1[3]);
                        *(u32x4*)(kv + (size_t)row * NKV + u.pn * BM + col) = w; }
                    else if (u.pn < 10) { v0 *= 0.125f; v1 *= 0.125f; u32x4 w; w.x = cvt_pk_bf16(v0[0], v0[1]); w.y = cvt_pk_bf16(v0[2], v0[3]); w.z = cvt_pk_bf16(v1[0], v1[1]); w.w = cvt_pk_bf16(v1[2], v1[3]);
                        *(u32x4*)(q + (size_t)row * DM + (u.pn - 6) * BM + col) = w; }
                    else if (col < 48) { f32x4 g0, g1;
#pragma unroll
                        for (int j = 0; j < 4; ++j) { g0[j] = 1.0f / (1.0f + __expf(-v0[j])); g1[j] = 1.0f / (1.0f + __expf(-v1[j])); }
                        *(f32x4*)(gate + (size_t)row * 48 + col) = g0; *(f32x4*)(gate + (size_t)row * 48 + col + 4) = g1; } } }
    }
};

struct ChainOrder {
    int nP, nchain_x, G8, xcd, slot; bool live;
    __device__ void init(int nP_, int G, int c) { nP = nP_; G8 = G / 8; xcd = c % 8; slot = c / 8; nchain_x = (NB / 8) * nP; live = c < 8 * G8; }
    __device__ bool next(int i, Unit& u) const {
        const int ci = i >> 3, w = i & 7, Lx = ci * G8 + slot; if (!live || Lx >= nchain_x) return false;
        const int seq = (Lx & 3) * 8 + xcd; u.pn = Lx >> 2; u.pm = seq * 8 + w; return true; }
};
template <int CTRL> __device__ __forceinline__ float dppf(float old, float src) {
    return __builtin_bit_cast(float, __builtin_amdgcn_update_dpp(__builtin_bit_cast(int, old), __builtin_bit_cast(int, src), CTRL, 0xf, 0xf, false)); }

template <int MODE, bool SSP> struct EpiConvPair {
    static constexpr bool PERM = true;
    const float* rs; const float* cw; int cw_ld, goff; bf16_t* O; int ldo; LAS float* exch;
    __device__ __forceinline__ void operator()(f32x4 (&acc)[2][2][4][2], const Unit& u, int ui, int wr, int wc, int fr, int fq) const {
        const int row0 = u.pm * BM + wr * 64 + 4 * fr, lcol = wc * 32 + 8 * fq;
#pragma unroll
        for (int ai = 0; ai < 2; ++ai)
#pragma unroll
            for (int m = 0; m < 4; ++m) { const float sc = SSP ? row_scale16(rs, row0 + ai * HALF + m, fq) : rs[row0 + ai * HALF + m];
#pragma unroll
                for (int n = 0; n < 2; ++n) { if (MODE == 0) { acc[ai][0][m][n] *= sc; acc[ai][1][m][n] *= sc; } else acc[ai][0][m][n] = (acc[ai][0][m][n] * sc) * (acc[ai][1][m][n] * sc); } }
        LAS float* ex = exch + (ui & 1) * 2048;
        if (fr == 15) {
#pragma unroll
            for (int ai = 0; ai < 2; ++ai)
#pragma unroll
                for (int r = 0; r < 2; ++r) { LAS float* p = ex + ((ai * 2 + wr) * 2 + r) * 256 + lcol;
                    *(LAS f32x4*)p = acc[ai][0][2 + r][0]; *(LAS f32x4*)(p + 4) = acc[ai][0][2 + r][1];
                    if (MODE == 0) { *(LAS f32x4*)(p + 128) = acc[ai][1][2 + r][0]; *(LAS f32x4*)(p + 132) = acc[ai][1][2 + r][1]; } } }
        asm volatile("s_waitcnt lgkmcnt(0)" ::: "memory"); __builtin_amdgcn_s_barrier(); asm volatile("" ::: "memory"); __builtin_amdgcn_s_barrier(); asm volatile("" ::: "memory");
        const int f = u.pn * HALF + lcol;
        u32x2 keep[2][4];
#pragma unroll
        for (int n = 0; n < 2; ++n) {
            f32x4 wa[3], wg[3];
#pragma unroll
            for (int k = 0; k < 3; ++k) { wa[k] = *(const f32x4*)(cw + (size_t)k * cw_ld + f + 4 * n); if (MODE == 0) wg[k] = *(const f32x4*)(cw + (size_t)k * cw_ld + goff + f + 4 * n); }
#pragma unroll
            for (int ai = 0; ai < 2; ++ai) {
                const int blk = ai * 2 + wr;
                f32x4 ba2 = (f32x4){0.f, 0.f, 0.f, 0.f}, ba3 = ba2, bg2 = ba2, bg3 = ba2;
                const LAS float* src = nullptr;
                if (blk > 0) src = ex + (blk - 1) * 512; else if ((u.pm & 7) != 0) src = exch + ((ui & 1) ^ 1) * 2048 + 3 * 512;
                if (src != nullptr) { const LAS float* p = src + lcol + 4 * n; ba2 = *(const LAS f32x4*)p; ba3 = *(const LAS f32x4*)(p + 256);
                    if (MODE == 0) { bg2 = *(const LAS f32x4*)(p + 128); bg3 = *(const LAS f32x4*)(p + 256 + 128); } }
                float o[4][4];
#pragma unroll
                for (int j = 0; j < 4; ++j) {
                    const float v0 = acc[ai][0][0][n][j], v1 = acc[ai][0][1][n][j], v2 = acc[ai][0][2][n][j], v3 = acc[ai][0][3][n][j];
                    const float p2 = dppf<0x111>(ba2[j], v2), p3 = dppf<0x111>(ba3[j], v3);
                    const float w0 = wa[0][j], w1 = wa[1][j], w2 = wa[2][j];
                    float y[4] = {w2 * v0 + w1 * p3 + w0 * p2, w2 * v1 + w1 * v0 + w0 * p3, w2 * v2 + w1 * v1 + w0 * v0, w2 * v3 + w1 * v2 + w0 * v1};
                    if (MODE == 0) {
                        const float g0 = acc[ai][1][0][n][j], g1 = acc[ai][1][1][n][j], g2 = acc[ai][1][2][n][j], g3 = acc[ai][1][3][n][j];
                        const float q2 = dppf<0x111>(bg2[j], g2), q3 = dppf<0x111>(bg3[j], g3);
                        const float x0 = wg[0][j], x1 = wg[1][j], x2 = wg[2][j];
                        const float z[4] = {x2 * g0 + x1 * q3 + x0 * q2, x2 * g1 + x1 * g0 + x0 * q3, x2 * g2 + x1 * g1 + x0 * g0, x2 * g3 + x1 * g2 + x0 * g1};
#pragma unroll
                        for (int m = 0; m < 4; ++m) o[m][j] = y[m] * __builtin_amdgcn_rcpf(1.0f + __expf(-y[m])) * z[m];
                    } else {
#pragma unroll
                        for (int m = 0; m < 4; ++m) o[m][j] = y[m];
                    }
                }
#pragma unroll
                for (int m = 0; m < 4; ++m) { u32x2 w; w.x = cvt_pk_bf16(o[m][0], o[m][1]); w.y = cvt_pk_bf16(o[m][2], o[m][3]);
                    if (n == 0) keep[ai][m] = w;
                    else { u32x4 w4; w4.x = keep[ai][m].x; w4.y = keep[ai][m].y; w4.z = w.x; w4.w = w.y; __builtin_nontemporal_store(w4, (u32x4*)(O + (size_t)(row0 + ai * HALF + m) * ldo + f)); } }
            }
            __builtin_amdgcn_sched_barrier(0);
        }
    }
};
struct EpiCmpHidden {
    static constexpr bool PERM = true;
    const float* b1f; float* H;
    __device__ __forceinline__ void operator()(f32x4 (&acc)[2][2][4][2], const Unit& u, int ui, int wr, int wc, int fr, int fq) const {
        const int row0 = u.pm * BM + wr * 64 + fr, col = wc * 32 + 8 * fq;
        const f32x4 b0 = *(const f32x4*)(b1f + u.pn * 128 + col), b1 = *(const f32x4*)(b1f + u.pn * 128 + col + 4);
#pragma unroll
        for (int ai = 0; ai < 2; ++ai)
#pragma unroll
            for (int m = 0; m < 4; ++m) { const int row = row0 + ai * HALF + m * 16; f32x4 v0 = acc[ai][0][m][0] + b0, v1 = acc[ai][0][m][1] + b1;
#pragma unroll
                for (int j = 0; j < 4; ++j) { v0[j] = gelu_tanh(v0[j]); v1[j] = gelu_tanh(v1[j]); }
                float* hp = H + ((size_t)u.pn * 16384 + row) * 128 + col; *(f32x4*)hp = v0; *(f32x4*)(hp + 4) = v1; }
    }
};
struct EpiMulB {
    static constexpr bool PERM = true;
    const float* rs; const bf16_t* other; bf16_t* Yo;
    __device__ __forceinline__ void operator()(f32x4 (&acc)[2][2][4][2], const Unit& u, int ui, int wr, int wc, int fr, int fq) const {
        const int row0 = u.pm * BM + wr * 64 + fr, col0 = u.pn * BM + wc * 32 + 8 * fq;
#pragma unroll
        for (int ai = 0; ai < 2; ++ai)
#pragma unroll
            for (int m = 0; m < 4; ++m) { const int row = row0 + ai * HALF + m * 16; const float sc = rs[row];
#pragma unroll
                for (int bj = 0; bj < 2; ++bj) { const size_t o = (size_t)row * DM + col0 + bj * HALF; const bf16x8 ov = *(const bf16x8*)(other + o);
                    const f32x4 v0 = acc[ai][bj][m][0] * sc, v1 = acc[ai][bj][m][1] * sc; u32x4 w;
                    w.x = cvt_pk_bf16(v0[0] * bf2f((bf16_t)ov[0]), v0[1] * bf2f((bf16_t)ov[1])); w.y = cvt_pk_bf16(v0[2] * bf2f((bf16_t)ov[2]), v0[3] * bf2f((bf16_t)ov[3]));
                    w.z = cvt_pk_bf16(v1[0] * bf2f((bf16_t)ov[4]), v1[1] * bf2f((bf16_t)ov[5])); w.w = cvt_pk_bf16(v1[2] * bf2f((bf16_t)ov[6]), v1[3] * bf2f((bf16_t)ov[7]));
                    *(u32x4*)(Yo + o) = w; } }
    }
};

template <class Epi, class Sched>
__device__ __forceinline__ void gemm_phase(LAS unsigned char* lds, const Gemm g, const Sched& S, const Epi& E) {
    int tid_ = threadIdx.x; asm volatile("" : "+v"(tid_));
    const int tid = tid_, wid = __builtin_amdgcn_readfirstlane(tid >> 6), lane = tid & 63, wr = wid >> 2, wc = wid & 3, fr = lane & 15, fq = lane >> 4;
    const int K = g.K, nt = K / BK;
    unsigned voffA[2], voffB[2];
#pragma unroll
    for (int i = 0; i < 2; ++i) { int R, C; stage_rc(tid * 16 + i * 8192, R, C); const int Rb = Epi::PERM ? ((R & ~31) + perm32(R & 31)) : R;
        const int Ra = g.aperm ? ((R & ~63) | ((R & 15) << 2) | ((R >> 4) & 3)) : R;
        voffA[i] = g.amode ? (unsigned)((R >> 2) * (16 * NKV) + (R & 3) * 64 + C) * 2u : (unsigned)(Ra * K + C) * 2u; voffB[i] = (unsigned)(Rb * K + C) * 2u; }
    const size_t kstep = (size_t)(BK * 2), hstep = (size_t)HALF * K * 2, tstep = 2 * hstep;
    const size_t akstep = g.a_kstep, ahstep = g.a_hstep, atstep = g.a_tstep;
    const unsigned ldsw = (unsigned)wid * 1024u;
    const int aoff = lds_byte(wr * 64 + fr, fq * 8), boff = lds_byte(wc * 32 + fr, fq * 8);
#define PG8_SA(b, h) (((b) * 2 + (h)) * HTB)
#define PG8_SB(b, h) ((4 + (b) * 2 + (h)) * HTB)
#define PG8_STAGE(bufoff, gbase, voff) do { _Pragma("unroll") for (int _i = 0; _i < 2; ++_i) \
        __builtin_amdgcn_global_load_lds((const unsigned*)((const char*)(gbase) + (voff)[_i]), (LAS unsigned*)(lds + (bufoff) + ldsw + _i * 8192), 16, 0, 0); } while (0)
#define PG8_LDA(dst, b, h) do { _Pragma("unroll") for (int m = 0; m < 4; ++m) _Pragma("unroll") for (int k = 0; k < 2; ++k) dst[m][k] = *(const LAS bf16x8*)(lds + PG8_SA(b, h) + aoff + m * 2048 + k * 1024); } while (0)
#define PG8_LDB(dst, b, h) do { _Pragma("unroll") for (int n = 0; n < 2; ++n) _Pragma("unroll") for (int k = 0; k < 2; ++k) dst[n][k] = *(const LAS bf16x8*)(lds + PG8_SB(b, h) + boff + n * 2048 + k * 1024); } while (0)
#define PG8_MMA(ai, bj, At, Bt) do { __builtin_amdgcn_s_setprio(1); _Pragma("unroll") for (int m = 0; m < 4; ++m) _Pragma("unroll") for (int n = 0; n < 2; ++n) _Pragma("unroll") for (int k = 0; k < 2; ++k) \
        acc[ai][bj][m][n] = __builtin_amdgcn_mfma_f32_16x16x32_bf16(Bt[n][k], At[m][k], acc[ai][bj][m][n], 0, 0, 0); __builtin_amdgcn_s_setprio(0); } while (0)
#define PG8_WAIT_V(n) asm volatile("s_waitcnt vmcnt(" #n ")" ::: "memory")
#define PG8_WAIT_L(n) asm volatile("s_waitcnt lgkmcnt(" #n ")" ::: "memory")
#define PG8_BAR __builtin_amdgcn_s_barrier()
#define PG8_SCHED __builtin_amdgcn_sched_barrier(0)
    Unit cur, nxt; int ui = 0;
    if (!S.next(0, cur)) return;
    f32x4 acc[2][2][4][2];
#pragma unroll
    for (int a = 0; a < 2; ++a)
#pragma unroll
        for (int b = 0; b < 2; ++b)
#pragma unroll
            for (int m = 0; m < 4; ++m)
#pragma unroll
                for (int n = 0; n < 2; ++n) acc[a][b][m][n] = (f32x4){0.f, 0.f, 0.f, 0.f};
    bf16x8 At[4][2], B0[2][2], B1[2][2];
    const char* cA = (const char*)g.A + (size_t)cur.pm * atstep + (size_t)cur.pn * g.a_pnstep; const char* cB = (const char*)g.Bt + (size_t)cur.pn * tstep;
    PG8_STAGE(PG8_SB(0, 0), cB, voffB); PG8_STAGE(PG8_SA(0, 0), cA, voffA); PG8_STAGE(PG8_SB(0, 1), cB + hstep, voffB); PG8_STAGE(PG8_SA(0, 1), cA + ahstep, voffA);
    if (wr == 1) PG8_BAR;
    PG8_WAIT_V(4); PG8_BAR;
    PG8_STAGE(PG8_SB(1, 0), cB + kstep, voffB); PG8_STAGE(PG8_SA(1, 0), cA + akstep, voffA); PG8_STAGE(PG8_SB(1, 1), cB + hstep + kstep, voffB);
    PG8_WAIT_V(6); PG8_BAR;
    for (;;) {
        const bool has_next = S.next(ui + 1, nxt);
        const char* nA = has_next ? (const char*)g.A + (size_t)nxt.pm * atstep + (size_t)nxt.pn * g.a_pnstep : cA; const char* nB = has_next ? (const char*)g.Bt + (size_t)nxt.pn * tstep : cB;
        for (int t = 0; t < nt; t += 2) {
            const bool last = (t == nt - 2);
            const char* a1 = cA + (size_t)(t + 1) * akstep;
            const char* a2 = last ? nA : cA + (size_t)(t + 2) * akstep; const char* b2 = last ? nB : cB + (size_t)(t + 2) * kstep;
            const char* a3 = a2 + akstep; const char* b3 = b2 + kstep;
            PG8_LDB(B0, 0, 0); PG8_SCHED; PG8_LDA(At, 0, 0); PG8_STAGE(PG8_SA(1, 1), a1 + ahstep, voffA);
            PG8_WAIT_L(8); PG8_BAR; PG8_WAIT_L(0); PG8_MMA(0, 0, At, B0); PG8_BAR; PG8_SCHED;
            PG8_LDB(B1, 0, 1); PG8_STAGE(PG8_SB(0, 0), b2, voffB);
            PG8_BAR; PG8_WAIT_L(0); PG8_MMA(0, 1, At, B1); PG8_BAR;
            PG8_LDA(At, 0, 1); PG8_STAGE(PG8_SA(0, 0), a2, voffA);
            PG8_BAR; PG8_WAIT_L(0); PG8_MMA(1, 0, At, B0); PG8_BAR; PG8_SCHED;
            PG8_STAGE(PG8_SB(0, 1), b2 + hstep, voffB);
            PG8_WAIT_V(6); PG8_BAR; PG8_MMA(1, 1, At, B1); PG8_BAR;
            PG8_LDB(B0, 1, 0); PG8_SCHED; PG8_LDA(At, 1, 0); PG8_STAGE(PG8_SA(0, 1), a2 + ahstep, voffA);
            PG8_WAIT_L(8); PG8_BAR; PG8_WAIT_L(0); PG8_MMA(0, 0, At, B0); PG8_BAR; PG8_SCHED;
            PG8_LDB(B1, 1, 1); PG8_STAGE(PG8_SB(1, 0), b3, voffB);
            PG8_BAR; PG8_WAIT_L(0); PG8_MMA(0, 1, At, B1); PG8_BAR;
            PG8_LDA(At, 1, 1); PG8_STAGE(PG8_SA(1, 0), a3, voffA);
            PG8_BAR; PG8_WAIT_L(0); PG8_MMA(1, 0, At, B0); PG8_BAR; PG8_SCHED;
            PG8_STAGE(PG8_SB(1, 1), b3 + hstep, voffB);
            PG8_WAIT_V(6); PG8_BAR; PG8_MMA(1, 1, At, B1); PG8_BAR;
        }
        E(acc, cur, ui, wr, wc, fr, fq);
        if (!has_next) break;
#pragma unroll
        for (int a = 0; a < 2; ++a)
#pragma unroll
            for (int b = 0; b < 2; ++b)
#pragma unroll
                for (int m = 0; m < 4; ++m)
#pragma unroll
                    for (int n = 0; n < 2; ++n) acc[a][b][m][n] = (f32x4){0.f, 0.f, 0.f, 0.f};
        cur = nxt; cA = nA; cB = nB; ++ui;
    }
    PG8_WAIT_V(0);
    if (wr == 0) PG8_BAR;
    PG8_BAR;
#undef PG8_SA
#undef PG8_SB
#undef PG8_STAGE
#undef PG8_LDA
#undef PG8_LDB
#undef PG8_MMA
#undef PG8_WAIT_V
#undef PG8_WAIT_L
#undef PG8_BAR
#undef PG8_SCHED
}
}

struct TrJob { const float* W0; int ld0, n0; const float* W1; int ld1, n1; const float* g0; const float* g1; int mode, pb0, pb1; bf16_t* Wt; int K, Nout; };
__device__ __forceinline__ TrJob get_job(int j, const Args& a) {
    unsigned char* ws = a.ws; TrJob t{}; t.W1 = nullptr; t.ld1 = 0; t.n1 = 0; t.g0 = nullptr; t.g1 = nullptr; t.mode = 0; t.pb0 = 0; t.pb1 = 0;
    switch (j) {
    case 0: t.W0 = a.in[2]; t.ld0 = 3072; t.n0 = 0; t.g0 = a.in[1]; t.mode = 1; t.pb0 = 1024; t.pb1 = 2048; t.Wt = (bf16_t*)(ws + WS_WIN); t.K = 1024; t.Nout = 2048; break;
    case 1: t.W0 = a.in[2]; t.ld0 = 3072; t.n0 = 1024; t.g0 = a.in[1]; t.Wt = (bf16_t*)(ws + WS_WIN) + (size_t)2048 * 1024; t.K = 1024; t.Nout = 1024; break;
    case 2: t.W0 = a.in[4]; t.ld0 = 1024; t.n0 = 1024; t.Wt = (bf16_t*)(ws + WS_WOUT); t.K = 1024; t.Nout = 1024; break;
    case 3: t.W0 = a.in[6]; t.ld0 = 5632; t.g0 = a.in[5]; t.mode = 1; t.pb0 = 0; t.pb1 = 2816; t.Wt = (bf16_t*)(ws + WS_WUP0); t.K = 1024; t.Nout = 5632; break;
    case 4: t.W0 = a.in[6] + (size_t)1024 * 5632; t.ld0 = 5632; t.g0 = a.in[5] + 1024; t.mode = 1; t.pb0 = 0; t.pb1 = 2816; t.Wt = (bf16_t*)(ws + WS_WUP1); t.K = 1024; t.Nout = 5632; break;
    case 5: t.W0 = a.in[8]; t.ld0 = 1024; t.n0 = 1024; t.Wt = (bf16_t*)(ws + WS_WDN0); t.K = 2816; t.Nout = 1024; break;
    case 6: t.W0 = a.in[8] + (size_t)2816 * 1024; t.ld0 = 1024; t.n0 = 1024; t.Wt = (bf16_t*)(ws + WS_WDN1); t.K = 2816; t.Nout = 1024; break;
    case 7: t.W0 = a.in[10]; t.ld0 = 1536; t.n0 = 1536; t.g0 = a.in[9]; t.W1 = a.in[15]; t.ld1 = 1072; t.n1 = 1072; t.g1 = a.in[1] + 1024; t.Wt = (bf16_t*)(ws + WS_WKVQG); t.K = 1024; t.Nout = 2816; break;
    case 8: t.W0 = a.in[16]; t.ld0 = 1024; t.n0 = 1024; t.Wt = (bf16_t*)(ws + WS_WO); t.K = 1024; t.Nout = 1024; break;
    case 9: t.W0 = a.in[12]; t.ld0 = 128; t.n0 = 128; t.Wt = (bf16_t*)(ws + WS_W1T); t.K = 2048; t.Nout = 256; break;
    default: t.W0 = a.in[12] + (size_t)2048 * 128; t.ld0 = 128; t.n0 = 128; t.Wt = (bf16_t*)(ws + WS_W1T) + (size_t)256 * 2048; t.K = 2048; t.Nout = 256; break;
    }
    return t;
}
__device__ __forceinline__ void wprep_phase(const Args& a, LAS unsigned char* lds) {
    LAS float* tile = (LAS float*)lds;
    const int tid = threadIdx.x, tx = tid & 63, ty = tid >> 6;
    int jstart = 0;
    for (int j = 0; j < 11; ++j) {
        const TrJob t = get_job(j, a);
        const int nkt = t.K / 64, nnt = t.Nout / 64, ntile = nkt * nnt;
        int first = ((int)blockIdx.x - jstart % (int)gridDim.x + (int)gridDim.x) % (int)gridDim.x;
        for (int ti = first; ti < ntile; ti += gridDim.x) {
            const int kt = ti % nkt, ntl = ti / nkt, k0 = kt * 64, n0 = ntl * 64;
            const int n = n0 + tx; const float* src = nullptr; int ld = 0; const float* gp = t.g0;
            if (t.mode == 1) { const int p = n >> 8, half = (n >> 7) & 1, c = n & 127; src = t.W0 + (half ? t.pb1 : t.pb0) + 128 * p + c; ld = t.ld0; }
            else if (n < t.n0) { src = t.W0 + n; ld = t.ld0; }
            else if (n - t.n0 < t.n1) { src = t.W1 + (n - t.n0); ld = t.ld1; gp = t.g1; }
            __syncthreads();
#pragma unroll
            for (int i = 0; i < 8; ++i) { const int k = k0 + ty + 8 * i; float v = 0.f; if (src) { v = src[(size_t)k * ld]; if (gp) v *= gp[k]; } tile[(ty + 8 * i) * 65 + tx] = v; }
            __syncthreads();
            { const int nn = tid >> 3, kc = (tid & 7) * 8; u32x4 w;
                w.x = cvt_pk_bf16(tile[(kc + 0) * 65 + nn], tile[(kc + 1) * 65 + nn]); w.y = cvt_pk_bf16(tile[(kc + 2) * 65 + nn], tile[(kc + 3) * 65 + nn]);
                w.z = cvt_pk_bf16(tile[(kc + 4) * 65 + nn], tile[(kc + 5) * 65 + nn]); w.w = cvt_pk_bf16(tile[(kc + 6) * 65 + nn], tile[(kc + 7) * 65 + nn]);
                *(u32x4*)(t.Wt + (size_t)(n0 + nn) * t.K + k0 + kc) = w; }
        }
        jstart += ntile;
    }
    if (tid < 64) for (int idx = blockIdx.x; idx < 256; idx += gridDim.x) { const int j = idx >> 7, n = idx & 127; float sacc = 0.f;
            for (int k = tid; k < 2048; k += 64) sacc += a.in[11][j * 2048 + k] * a.in[12][((size_t)j * 2048 + k) * 128 + n];
            sacc = wave_sum(sacc); if (tid == 0) ((float*)(a.ws + WS_B1F))[idx] = sacc + a.in[13][idx]; }
    __syncthreads();
}

__device__ __forceinline__ void rowstat_phase(const float* src, bf16_t* dstb, float* rs, int row0, int nrows) {
    const int wave = threadIdx.x >> 6, lane = threadIdx.x & 63;
    for (int r = blockIdx.x * 8 + wave; r < nrows; r += gridDim.x * 8) {
        const size_t row = (size_t)(row0 + r); const float* p = src + row * DM; float ss = 0.f;
#pragma unroll
        for (int i = 0; i < 2; ++i) { const int c = i * 512 + lane * 8; const f32x4 v0 = *(const f32x4*)(p + c), v1 = *(const f32x4*)(p + c + 4);
            ss += ((v0[0] * v0[0] + v0[1] * v0[1]) + (v0[2] * v0[2] + v0[3] * v0[3])) + ((v1[0] * v1[0] + v1[1] * v1[1]) + (v1[2] * v1[2] + v1[3] * v1[3]));
            if (dstb) { u32x4 w; w.x = cvt_pk_bf16(v0[0], v0[1]); w.y = cvt_pk_bf16(v0[2], v0[3]); w.z = cvt_pk_bf16(v1[0], v1[1]); w.w = cvt_pk_bf16(v1[2], v1[3]); *(u32x4*)(dstb + row * DM + c) = w; } }
        ss = wave_sum(ss);
        if (lane == 0) rs[row] = rsqrtf(ss * (1.0f / DM) + 1e-6f);
    }
}
__device__ __forceinline__ void final_phase(float* out, const bf16_t* xb, const float* ssp, const float* gain, int row0, int nrows) {
    const int wave = threadIdx.x >> 6, lane = threadIdx.x & 63;
    for (int r = blockIdx.x * 8 + wave; r < nrows; r += gridDim.x * 8) {
        const size_t row = (size_t)(row0 + r);
        float ss = lane < 16 ? ssp[row * 16 + lane] : 0.f; ss = wave_sum(ss);
        const float sc = rsqrtf(ss * (1.0f / DM) + 1e-6f);
#pragma unroll
        for (int i = 0; i < 2; ++i) { const int c = i * 512 + lane * 8; const bf16x8 v = *(const bf16x8*)(xb + row * DM + c);
            const f32x4 g0 = *(const f32x4*)(gain + c), g1 = *(const f32x4*)(gain + c + 4);
            f32x4 o0, o1;
#pragma unroll
            for (int j = 0; j < 4; ++j) { o0[j] = bf2f((bf16_t)v[j]) * sc * g0[j]; o1[j] = bf2f((bf16_t)v[4 + j]) * sc * g1[j]; }
            __builtin_nontemporal_store(o0, (f32x4*)(out + row * DM + c)); __builtin_nontemporal_store(o1, (f32x4*)(out + row * DM + c + 4)); }
    }
}
__device__ __forceinline__ void compress_out_phase(const Args& a, LAS unsigned char* lds) {
    const float* H = (const float*)(a.ws + WS_HID); bf16_t* kcb = (bf16_t*)(a.ws + WS_KCB); const float* w2 = a.in[14];
    LAS float* w2s = (LAS float*)lds;
    const int tid = threadIdx.x, wave = tid >> 6, lane = tid & 63;
    LAS float* hrow = w2s + 2 * 128 * 64 + wave * 128;
    for (int e = tid; e < 2 * 128 * 64; e += NTHREADS) w2s[e] = w2[e];
    __syncthreads();
    for (int r = blockIdx.x * 8 + wave; r < 2 * 16384; r += gridDim.x * 8) {
        const int j = r >> 14, row = r & 16383, i = (row >> 2) & 127;
        hrow[lane] = H[(size_t)r * 128 + lane]; hrow[lane + 64] = H[(size_t)r * 128 + 64 + lane];
        asm volatile("s_waitcnt lgkmcnt(0)" ::: "memory");
        float o = 0.f;
#pragma unroll 8
        for (int n = 0; n < 128; ++n) o += hrow[n] * w2s[(j * 128 + n) * 64 + lane];
        kcb[(size_t)r * 64 + lane] = (i == 127) ? (bf16_t)0 : f2bf(o);
        asm volatile("s_waitcnt lgkmcnt(0)" ::: "memory");
    }
    __syncthreads();
}
__device__ __forceinline__ int rel_bucket(int d) { if (d < 16) return d; const int l = 16 + (int)(logf((float)d / 16.0f) / 2.0794415416798357f * 16.0f); return l < 31 ? l : 31; }

typedef float f32x16 __attribute__((ext_vector_type(16)));
typedef short s16x4 __attribute__((ext_vector_type(4)));
typedef __bf16 bf16x2_t __attribute__((ext_vector_type(2)));
#define MFMA32(a, b, c) __builtin_amdgcn_mfma_f32_32x32x16_bf16((a), (b), (c), 0, 0, 0)
constexpr int TP = 144, TILE_B = 64 * TP;
constexpr int TABN = 336;
constexpr int AT_IMP = 4 * TILE_B, AT_SELM = AT_IMP + 4 * 64 * 33 * 4, AT_BTAB = AT_SELM + 256, AT_BUCK = AT_BTAB + TABN * 16, AT_OUT = AT_BUCK + 512, AT_END = AT_OUT + 8 * 8192;
constexpr float LOG2E = 1.4426950408889634f;
__device__ __forceinline__ unsigned pk2(float a, float b) { const f32x2 v = {a, b}; return __builtin_bit_cast(unsigned, __builtin_convertvector(v, bf16x2_t)); }
__device__ __forceinline__ int crow16(int i) { return (i & 3) + 8 * (i >> 2); }

__device__ __forceinline__ float xor32f(float v, int xaddr) { return __builtin_bit_cast(float, __builtin_amdgcn_ds_bpermute(xaddr, __builtin_bit_cast(int, v))); }
template <int CTRL> __device__ __forceinline__ unsigned dppu(unsigned v) { return (unsigned)__builtin_amdgcn_update_dpp(0, (int)v, CTRL, 0xf, 0xf, true); }
struct AttnState { f32x16 O[2]; float m, l; int xaddr; };

template <int BR, bool PASS2>
__device__ __forceinline__ void attn_block(LAS unsigned char* lds, int Kt, int Vt, int kpos0, bool selbit, const bf16x8 (&qf)[4], AttnState& st, int hh, int tq, int lane,
                                           float inv, LAS float* improw, float& eprev, int blk, bool win) {
    const int h = lane >> 5, l31 = lane & 31;
    const int tq0 = __builtin_amdgcn_readfirstlane(tq - l31);
    if (BR != 0) { if (tq0 + 31 < kpos0) return; if (win && tq0 - (kpos0 + 63) >= 512) return; }
    f32x16 S[2];
    {   bf16x8 kf[2][4];
#pragma unroll
        for (int kb = 0; kb < 2; ++kb)
#pragma unroll
            for (int s = 0; s < 4; ++s) kf[kb][s] = *(const LAS bf16x8*)(lds + Kt + (32 * kb + l31) * TP + (16 * s + 8 * h) * 2);
#pragma unroll
        for (int kb = 0; kb < 2; ++kb)
#pragma unroll
            for (int i = 0; i < 16; ++i) S[kb][i] = 0.f;
        __builtin_amdgcn_s_setprio(1);
#pragma unroll
        for (int s = 0; s < 4; ++s)
#pragma unroll
            for (int kb = 0; kb < 2; ++kb) S[kb] = MFMA32(kf[kb][s], qf[s], S[kb]);
        __builtin_amdgcn_s_setprio(0);
    }
    const LAS float* btab = (const LAS float*)(lds + AT_BTAB);
    const bool fast = (BR != 0) && (tq0 - (kpos0 + 63) >= 113) && (!win || (tq0 + 31 - kpos0) <= 511);
    float mx = -INFINITY, cb = 0.f; const bool okl = (BR == 1) ? (selbit || win) : true;
    const bool nearp = (BR == 1) && !fast && (tq0 + 31 - kpos0) <= 271;
    if (fast) { cb = btab[(127 + 64) * 4 + hh]; float mr = S[0][0];
#pragma unroll
        for (int kb = 0; kb < 2; ++kb)
#pragma unroll
            for (int i = 0; i < 16; ++i) mr = fmaxf(mr, S[kb][i]);
        mx = okl ? __builtin_fmaf(mr, LOG2E, cb) : -INFINITY;
    } else if (nearp) {
        const LAS float* tb = btab + (tq - kpos0 - 4 * h + 64 - 59) * 4 + hh;
#pragma unroll
        for (int kb = 0; kb < 2; ++kb)
#pragma unroll
            for (int i0 = 0; i0 < 16; i0 += 8) { float bv[8];
#pragma unroll
                for (int e = 0; e < 8; ++e) bv[e] = tb[(59 - 32 * kb - crow16(i0 + e)) * 4];
                __builtin_amdgcn_sched_barrier(0);
#pragma unroll
                for (int e = 0; e < 8; ++e) { const float v = __builtin_fmaf(S[kb][i0 + e], LOG2E, bv[e]); S[kb][i0 + e] = v; mx = fmaxf(mx, v); }
                __builtin_amdgcn_sched_barrier(0); }
        mx = okl ? mx : -INFINITY;
    } else {
#pragma unroll
        for (int kb = 0; kb < 2; ++kb)
#pragma unroll
            for (int i0 = 0; i0 < 16; i0 += 8) {
                float bv[8]; float pen[8];
#pragma unroll
                for (int e = 0; e < 8; ++e) { const int i = i0 + e; const int kidx = kpos0 + 32 * kb + 4 * h + crow16(i); const int dist = tq - ((BR == 0) ? (16 * kidx + 31) : kidx);
                    const int dc = dist < -1 ? -1 : (dist > 127 ? 127 : dist);
                    bv[e] = btab[(dc + 64) * 4 + hh]; pen[e] = (BR == 1 && win && dist >= 512) ? -INFINITY : 0.f; }
                __builtin_amdgcn_sched_barrier(0);
#pragma unroll
                for (int e = 0; e < 8; ++e) { const int i = i0 + e; float v = __builtin_fmaf(S[kb][i], LOG2E, bv[e]); if (BR == 1) v += pen[e]; S[kb][i] = v; mx = fmaxf(mx, v); }
                __builtin_amdgcn_sched_barrier(0);
            }
        if (BR == 1) mx = okl ? mx : -INFINITY;
    }
    __builtin_amdgcn_sched_barrier(0);
    if (!PASS2) {
        mx = fmaxf(mx, xor32f(mx, st.xaddr));
        const float mnew = fmaxf(st.m, mx), muse = (mnew == -INFINITY) ? 0.f : mnew, alpha = __builtin_amdgcn_exp2f(st.m - muse);
        float ls = 0.f;
        if (fast) { const float cbm = okl ? (cb - muse) : -INFINITY;
#pragma unroll
            for (int kb = 0; kb < 2; ++kb)
#pragma unroll
                for (int i = 0; i < 16; ++i) { const float pv = __builtin_amdgcn_exp2f(__builtin_fmaf(S[kb][i], LOG2E, cbm)); S[kb][i] = pv; ls += pv; }
        } else { const float musel = (BR == 1 && !okl) ? INFINITY : muse;
#pragma unroll
            for (int kb = 0; kb < 2; ++kb)
#pragma unroll
                for (int i = 0; i < 16; ++i) { const float pv = __builtin_amdgcn_exp2f(S[kb][i] - musel); S[kb][i] = pv; ls += pv; }
        }
        st.l = st.l * alpha + ls; st.m = mnew;
        if (__builtin_amdgcn_ballot_w64(alpha != 1.0f) != 0ull) {
#pragma unroll
            for (int db = 0; db < 2; ++db)
#pragma unroll
                for (int i = 0; i < 16; ++i) st.O[db][i] *= alpha; }
        const int i16 = lane & 15, q4 = i16 >> 2, p4 = i16 & 3, b16 = (lane >> 4) & 1;
        LAS unsigned char* vbase = lds + Vt + (4 * h + q4) * TP + 32 * b16 + 8 * p4;
#pragma unroll
        for (int kb = 0; kb < 2; ++kb) {
            bf16x8 vf[2][2];
#pragma unroll
            for (int s2 = 0; s2 < 2; ++s2)
#pragma unroll
                for (int db = 0; db < 2; ++db) { LAS unsigned char* va = vbase + (32 * kb + 16 * s2) * TP + db * 64;
                    const s16x4 lo = __builtin_bit_cast(s16x4, __builtin_amdgcn_ds_read_tr16_b64_v4i16((LAS s16x4*)va));
                    const s16x4 hi = __builtin_bit_cast(s16x4, __builtin_amdgcn_ds_read_tr16_b64_v4i16((LAS s16x4*)(va + 8 * TP)));
                    vf[s2][db] = __builtin_shufflevector(lo, hi, 0, 1, 2, 3, 4, 5, 6, 7); }
            __builtin_amdgcn_sched_barrier(0);
#pragma unroll
            for (int s2 = 0; s2 < 2; ++s2) {
                u32x4 pw; pw.x = pk2(S[kb][8 * s2 + 0], S[kb][8 * s2 + 1]); pw.y = pk2(S[kb][8 * s2 + 2], S[kb][8 * s2 + 3]); pw.z = pk2(S[kb][8 * s2 + 4], S[kb][8 * s2 + 5]); pw.w = pk2(S[kb][8 * s2 + 6], S[kb][8 * s2 + 7]);
                const bf16x8 pf = __builtin_bit_cast(bf16x8, pw);
#pragma unroll
                for (int db = 0; db < 2; ++db) st.O[db] = MFMA32(vf[s2][db], pf, st.O[db]);
            }
            __builtin_amdgcn_sched_barrier(0);
        }
    } else {
        const float muse = (st.m == -INFINITY) ? 0.f : st.m;
#pragma unroll
        for (int kb = 0; kb < 2; ++kb)
#pragma unroll
            for (int gq = 0; gq < 4; ++gq) {
                const float p0 = __builtin_amdgcn_exp2f(S[kb][4 * gq] - muse) * inv, p1 = __builtin_amdgcn_exp2f(S[kb][4 * gq + 1] - muse) * inv,
                            p2 = __builtin_amdgcn_exp2f(S[kb][4 * gq + 2] - muse) * inv, p3 = __builtin_amdgcn_exp2f(S[kb][4 * gq + 3] - muse) * inv;
                const float esw = xor32f(p3, st.xaddr);
                const float val = ((p0 + p1) + (p2 + p3)) + (h ? esw : eprev);
                improw[16 * blk + 8 * kb + 2 * gq + h] = val; eprev = esw; }
    }
}

__device__ __forceinline__ void attn_mfma_phase(const Args& a, LAS unsigned char* lds) {
    const bf16_t* kv = (const bf16_t*)(a.ws + WS_KV); const bf16_t* qb_ = (const bf16_t*)(a.ws + WS_Q); const float* gate = (const float*)(a.ws + WS_GATE);
    const bf16_t* kcb = (const bf16_t*)(a.ws + WS_KCB); bf16_t* yo = (bf16_t*)(a.ws + WS_Y); const float* relb = a.in[17];
    int tid_ = threadIdx.x; asm volatile("" : "+v"(tid_));
    const int tid = tid_, wid = __builtin_amdgcn_readfirstlane(tid >> 6), lane = tid & 63, hh = wid >> 1, qh = wid & 1, h = lane >> 5, l31 = lane & 31;
    const int lkey = tid >> 3, lch = tid & 7;
    LAS int* buck = (LAS int*)(lds + AT_BUCK); LAS float* btab = (LAS float*)(lds + AT_BTAB); LAS unsigned* selm = (LAS unsigned*)(lds + AT_SELM); LAS float* imp = (LAS float*)(lds + AT_IMP);
    if (tid < 128) buck[tid] = rel_bucket(tid);
    __syncthreads();
    const int nitems = NB * 32 * 4;
    for (int it = blockIdx.x; it < nitems; it += gridDim.x) {
        const int qb = it >> 7, b = (it >> 2) & 31, g = it & 3, qs = 64 * qb, head = g * 4 + hh, tq = qs + 32 * qh + l31;
        const size_t rowq = (size_t)b * SEQ + tq;
        bf16x8 qf[4];
#pragma unroll
        for (int s = 0; s < 4; ++s) qf[s] = *(const bf16x8*)(qb_ + rowq * DM + head * 64 + 16 * s + 8 * h);
        const float* gp = gate + rowq * 48 + head * 3; const float g0 = gp[0], g1 = gp[1], g2 = gp[2];
        __syncthreads();
        for (int e = tid; e < TABN * 4; e += NTHREADS) { const int d = (e >> 2) - 64; btab[e] = d < 0 ? -INFINITY : relb[buck[d > 127 ? 127 : d] * 16 + g * 4 + (e & 3)] * LOG2E; }
        {
            const bf16_t* kc = kcb + (((size_t)b * 128) * 4 + g) * 64; const bf16_t* vc = kc + (size_t)NB * 128 * 4 * 64;
#pragma unroll
            for (int blk = 0; blk < 2; ++blk) { const u32x4 kx = *(const u32x4*)(kc + (size_t)(64 * blk + lkey) * 256 + lch * 8), vx = *(const u32x4*)(vc + (size_t)(64 * blk + lkey) * 256 + lch * 8);
                *(LAS u32x4*)(lds + blk * TILE_B + lkey * TP + lch * 16) = kx; *(LAS u32x4*)(lds + (2 + blk) * TILE_B + lkey * TP + lch * 16) = vx; }
        }
        __syncthreads();
        AttnState st; float edummy = 0.f; LAS unsigned char* outp = lds + AT_OUT + wid * 8192 + lane * 16;
#pragma unroll
        for (int db = 0; db < 2; ++db)
#pragma unroll
            for (int i = 0; i < 16; ++i) st.O[db][i] = 0.f;
        st.m = -INFINITY; st.l = 0.f; st.xaddr = (lane ^ 32) << 2;
#pragma nounroll
        for (int blk = 0; blk < (qb >= 16 ? 2 : 1); ++blk)
            attn_block<0, false>(lds, blk * TILE_B, (2 + blk) * TILE_B, 64 * blk, true, qf, st, hh, tq, lane, 0.f, nullptr, edummy, blk, false);
        {   const float lt = st.l + xor32f(st.l, st.xaddr), inv = lt > 0.f ? 1.0f / lt : 0.f, sc = g0 * inv;
#pragma unroll
            for (int db = 0; db < 2; ++db)
#pragma unroll
                for (int gq = 0; gq < 4; ++gq) { const f32x4 v = {st.O[db][4 * gq] * sc, st.O[db][4 * gq + 1] * sc, st.O[db][4 * gq + 2] * sc, st.O[db][4 * gq + 3] * sc};
                    *(LAS f32x4*)(outp + (db * 4 + gq) * 1024) = v; st.O[db][4 * gq] = 0.f; st.O[db][4 * gq + 1] = 0.f; st.O[db][4 * gq + 2] = 0.f; st.O[db][4 * gq + 3] = 0.f; }
            if (qb >= 16) { float ep = 0.f; LAS float* improw = imp + (hh * 64 + 32 * qh + l31) * 33;
#pragma nounroll
                for (int blk = 0; blk < 2; ++blk) attn_block<0, true>(lds, blk * TILE_B, (2 + blk) * TILE_B, 64 * blk, true, qf, st, hh, tq, lane, inv, improw, ep, blk, false); }
            st.m = -INFINITY; st.l = 0.f; }
        __syncthreads();
        if (qb >= 16) {
            {
                const int q = tid >> 3, j0 = (tid & 7) * 4;
#pragma unroll
                for (int u = 0; u < 4; ++u) { const int j = j0 + u; imp[q * 33 + j] = (imp[(0 * 64 + q) * 33 + j] + imp[(1 * 64 + q) * 33 + j]) + (imp[(2 * 64 + q) * 33 + j] + imp[(3 * 64 + q) * 33 + j]); }
            }
            __syncthreads();
            const int q = tid >> 3, sub = tid & 7; unsigned mk = 0u;
            for (int u = 0; u < 4; ++u) { const int s = 4 * sub + u; const float mine = imp[q * 33 + s];
                int rank = 0;
                for (int j = 1; j < 32; ++j) { const float ij = imp[q * 33 + j]; const bool cj = (j < qb - 1); if (cj && (ij > mine || (ij == mine && j < s))) ++rank; }
                const bool forced = (s == 0) || (s == qb) || (s == qb - 1); if (forced || (s <= qb && rank < 13)) mk |= 1u << s; }
            mk |= dppu<0xB1>(mk); mk |= dppu<0x4E>(mk); mk |= dppu<0x141>(mk);
            if (sub == 0) selm[q] = mk;
        } else if (tid < 64) selm[tid] = (qb >= 31) ? 0xffffffffu : ((2u << qb) - 1u);
        __syncthreads();
        const unsigned mysel = selm[32 * qh + l31];
        const int nsel = qb + 1, wlo = qb > 8 ? qb - 8 : 0, nstep = nsel + (qb - wlo + 1);
        const bf16_t* kvb = kv + (size_t)b * SEQ * NKV + g * 64;
        u32x4 kx, vx;
        { const bf16_t* r0 = kvb + (size_t)(0 + lkey) * NKV + lch * 8; kx = *(const u32x4*)(r0 + 2 * 256); vx = *(const u32x4*)(r0 + 3 * 256); }
        *(LAS u32x4*)(lds + 0 * TILE_B + lkey * TP + lch * 16) = kx; *(LAS u32x4*)(lds + 2 * TILE_B + lkey * TP + lch * 16) = vx;
        __syncthreads();
        for (int k = 0; k < nstep; ++k) {
            const int buf = k & 1;
            if (k + 1 < nstep) { const int k1 = k + 1, isw = k1 >= nsel, jb1 = isw ? wlo + (k1 - nsel) : k1; const bf16_t* r0 = kvb + (size_t)(64 * jb1 + lkey) * NKV + lch * 8 + (isw ? 4 * 256 : 2 * 256);
                kx = *(const u32x4*)r0; vx = *(const u32x4*)(r0 + 256); }
            if (k == nsel) {
                const float lt = st.l + xor32f(st.l, st.xaddr), sc = g1 / lt;
#pragma unroll
                for (int db = 0; db < 2; ++db)
#pragma unroll
                    for (int gq = 0; gq < 4; ++gq) { f32x4 v = *(LAS f32x4*)(outp + (db * 4 + gq) * 1024);
                        v[0] += st.O[db][4 * gq] * sc; v[1] += st.O[db][4 * gq + 1] * sc; v[2] += st.O[db][4 * gq + 2] * sc; v[3] += st.O[db][4 * gq + 3] * sc;
                        *(LAS f32x4*)(outp + (db * 4 + gq) * 1024) = v; st.O[db][4 * gq] = 0.f; st.O[db][4 * gq + 1] = 0.f; st.O[db][4 * gq + 2] = 0.f; st.O[db][4 * gq + 3] = 0.f; }
                st.m = -INFINITY; st.l = 0.f; }
            { const bool isw = k >= nsel; const int jbk = isw ? wlo + k - nsel : k;
              attn_block<1, false>(lds, buf * TILE_B, (2 + buf) * TILE_B, 64 * jbk, (mysel >> (jbk & 31)) & 1u, qf, st, hh, tq, lane, 0.f, nullptr, edummy, 0, isw); }
            if (k + 1 < nstep) { *(LAS u32x4*)(lds + (buf ^ 1) * TILE_B + lkey * TP + lch * 16) = kx; *(LAS u32x4*)(lds + (2 + (buf ^ 1)) * TILE_B + lkey * TP + lch * 16) = vx; }
            __syncthreads();
        }
        {   const float lt = st.l + xor32f(st.l, st.xaddr), sc = g2 / lt;
            u32x2 w[2][4];
#pragma unroll
            for (int db = 0; db < 2; ++db)
#pragma unroll
                for (int gq = 0; gq < 4; ++gq) { const f32x4 v = *(LAS f32x4*)(outp + (db * 4 + gq) * 1024);
                    w[db][gq].x = pk2(v[0] + st.O[db][4 * gq] * sc, v[1] + st.O[db][4 * gq + 1] * sc); w[db][gq].y = pk2(v[2] + st.O[db][4 * gq + 2] * sc, v[3] + st.O[db][4 * gq + 3] * sc); }
            LAS unsigned char* tp = lds + AT_OUT + wid * 8192;
#pragma unroll
            for (int db = 0; db < 2; ++db)
#pragma unroll
                for (int gq = 0; gq < 4; ++gq) *(LAS u32x2*)(tp + l31 * TP + (32 * db + 8 * gq + 4 * h) * 2) = w[db][gq];
            asm volatile("s_waitcnt lgkmcnt(0)" ::: "memory");
            bf16_t* obase = yo + ((size_t)b * SEQ + qs + 32 * qh) * DM + head * 64;
#pragma unroll
            for (int it = 0; it < 4; ++it) { const int r = (lane >> 3) + 8 * it, ch = lane & 7; const u32x4 v = *(const LAS u32x4*)(tp + r * TP + ch * 16); *(u32x4*)(obase + (size_t)r * DM + ch * 8) = v; }
        }
    }
    __syncthreads();
}

#define XB_TMO      128
#define XB_XCNT(j)  (256  + 64 * (j))
#define XB_XSUB(j)  (1280 + 64 * (j))
#define XB_XGEN(j)  (2304 + 64 * (j))
#define XB_TOP      3328
#define XB_TOPGEN   3392
#define XCD_BAR_WORDS 3456
#define XB_SPIN_CAP (1u << 18)
__device__ __forceinline__ unsigned xb_ld(unsigned* p)              { return __hip_atomic_load(p, __ATOMIC_RELAXED, __HIP_MEMORY_SCOPE_AGENT); }
__device__ __forceinline__ unsigned xb_add(unsigned* p, unsigned v) { return __hip_atomic_fetch_add(p, v, __ATOMIC_RELAXED, __HIP_MEMORY_SCOPE_AGENT); }
__device__ __forceinline__ unsigned xb_xcc_id() { return (unsigned)__builtin_amdgcn_s_getreg((3 << 11) | 20) & 0xFu; }
#define XB_SPIN(cond, bar) do { unsigned _sp = 0; while (cond) { __builtin_amdgcn_s_sleep(1); \
    if ((++_sp & 255u) == 0u) { if (xb_ld(&(bar)[XB_TMO])) break; if (_sp > XB_SPIN_CAP) { atomicAdd(&(bar)[XB_TMO], 1u); break; } } } } while (0)
struct XcdBarrier { unsigned* bar; unsigned x; volatile LAS unsigned* st; };
__device__ __forceinline__ XcdBarrier xcd_barrier_post(unsigned* bar, volatile LAS unsigned* st) {
    XcdBarrier b; b.bar = bar; b.x = xb_xcc_id(); b.st = st;
    if (threadIdx.x == 0) (void)xb_add(&bar[XB_XCNT(b.x)], 1u);
    return b;
}
__device__ __forceinline__ void xcd_barrier_complete(unsigned* bar, unsigned x, unsigned& nloc, unsigned& nx) {
    const unsigned G = gridDim.x * gridDim.y * gridDim.z;
    unsigned sum, cnt, mine, sp = 0u;
    for (;;) {
        sum = 0u; cnt = 0u; mine = 0u;
#pragma unroll
        for (unsigned j = 0; j < 16; ++j) { const unsigned c = xb_ld(&bar[XB_XCNT(j)]); sum += c; cnt += (c > 0u) ? 1u : 0u; mine = (j == x) ? c : mine; }
        if (sum == G) break;
        __builtin_amdgcn_s_sleep(1);
        if ((++sp & 255u) == 0u) { if (xb_ld(&bar[XB_TMO])) break; if (sp > XB_SPIN_CAP) { atomicAdd(&bar[XB_TMO], 1u); break; } }
    }
    nloc = mine > 0u ? mine : 1u; nx = cnt > 0u ? cnt : 1u;
}
__device__ __forceinline__ void xcd_barrier(const XcdBarrier& b) {
    asm volatile("s_waitcnt vmcnt(0)" ::: "memory");
    __syncthreads();
    if (threadIdx.x == 0) {
        unsigned* bar = b.bar;
        __builtin_amdgcn_s_waitcnt(0);
        unsigned nloc = b.st[0], nx = b.st[1];
        if (nloc == 0u) { xcd_barrier_complete(bar, b.x, nloc, nx); b.st[0] = nloc; b.st[1] = nx; }
        const unsigned old = xb_add(&bar[XB_XSUB(b.x)], 1u);
        const unsigned gen = old / nloc;
        if (old + 1u == (gen + 1u) * nloc) {
            __builtin_amdgcn_fence(__ATOMIC_RELEASE, "agent");
            asm volatile("s_waitcnt vmcnt(0)" ::: "memory");
            const unsigned og = xb_add(&bar[XB_TOP], 1u);
            const unsigned tg = og / nx;
            if (og + 1u == (tg + 1u) * nx) xb_add(&bar[XB_TOPGEN], 1u);
            else XB_SPIN(xb_ld(&bar[XB_TOPGEN]) == tg, bar);
            __builtin_amdgcn_fence(__ATOMIC_ACQUIRE, "agent");
            xb_add(&bar[XB_XGEN(b.x)], 1u);
            asm volatile("s_waitcnt vmcnt(0)" ::: "memory");
        } else {
            XB_SPIN(xb_ld(&bar[XB_XGEN(b.x)]) == gen, bar);
            __builtin_amdgcn_fence(__ATOMIC_ACQUIRE, "agent");
            asm volatile("s_waitcnt vmcnt(0)" ::: "memory");
        }
    }
    __syncthreads();
}

enum { PH_WPREP = 0, PH_XPREP, PH_INCV, PH_INB, PH_OUTPROJ, PH_UP0, PH_DN0, PH_KVQG, PH_CMP, PH_CMP2, PH_ATTN, PH_WO, PH_UP1, PH_DN1, PH_FINAL, PH_COUNT };

__global__ void __launch_bounds__(NTHREADS, 2) mk_fwd(Args a) {
    extern __shared__ __attribute__((aligned(16))) unsigned char lds_raw[];
    LAS unsigned char* lds = (LAS unsigned char*)lds_raw;
    LAS float* exch = (LAS float*)(lds + 131072);
    unsigned char* ws = a.ws;
    const int G = gridDim.x, bx = blockIdx.x;
    const float* x_in = a.in[0]; float* xo = a.out;
    bf16_t* HB = (bf16_t*)(ws + WS_HB); bf16_t* ACT = (bf16_t*)(ws + WS_BIG); bf16_t* Y = (bf16_t*)(ws + WS_Y); bf16_t* CVC = (bf16_t*)(ws + WS_RAW);
    float* RS = (float*)(ws + WS_RS); float* SSP = (float*)(ws + WS_SSP);
    const int lo = a.ph_lo, hi = a.ph_hi;
#define IN(k) (lo <= (k) && (k) < hi)
    volatile LAS unsigned* xst = (volatile LAS unsigned*)(lds + 147456);
    if (threadIdx.x < 4) xst[threadIdx.x] = 0u;
    __syncthreads();
    const XcdBarrier xbar = xcd_barrier_post((unsigned*)(ws + WS_BAR), xst);
#define SEAM(k) do { if (IN(k) && IN((k) + 1)) xcd_barrier(xbar); } while (0)
    if (hi < 0) cg::this_grid().sync();

    if (IN(PH_WPREP)) wprep_phase(a, lds);
    if (IN(PH_XPREP)) rowstat_phase(x_in, HB, RS, 0, MROWS);
    SEAM(PH_XPREP);
    if (IN(PH_INCV)) { pg8::Gemm g = pg8::dense(HB, (const bf16_t*)(ws + WS_WIN), MROWS, 2048, 1024); g.aperm = 1; pg8::ChainOrder S; S.init(8, G, bx);
        pg8::EpiConvPair<1, false> E{RS, a.in[3], DM, 0, CVC, DM, exch}; pg8::gemm_phase(lds, g, S, E); }
    SEAM(PH_INCV);
    if (IN(PH_INB)) { const pg8::Gemm g = pg8::dense(HB, (const bf16_t*)(ws + WS_WIN) + (size_t)2048 * 1024, MROWS, 1024, 1024); pg8::StaticOrder S; S.init(MROWS, 1024, G, bx);
        pg8::EpiMulB E{RS, CVC, Y}; pg8::gemm_phase(lds, g, S, E); }
    SEAM(PH_INB);
    if (IN(PH_OUTPROJ)) { const pg8::Gemm g = pg8::dense(Y, (const bf16_t*)(ws + WS_WOUT), MROWS, 1024, 1024); pg8::StaticOrder S; S.init(MROWS, 1024, G, bx);
        pg8::EpiResid<true, false> E{x_in, HB, nullptr, SSP}; pg8::gemm_phase(lds, g, S, E); }
    SEAM(PH_OUTPROJ);
    if (IN(PH_UP0)) { pg8::Gemm g = pg8::dense(HB, (const bf16_t*)(ws + WS_WUP0), MROWS, 5632, 1024); g.aperm = 1; pg8::ChainOrder S; S.init(22, G, bx);
        pg8::EpiConvPair<0, true> E{SSP, a.in[7], 5632, DFF, ACT, DFF, exch}; pg8::gemm_phase(lds, g, S, E); }
    SEAM(PH_UP0);
    if (IN(PH_DN0)) { const pg8::Gemm g = pg8::dense(ACT, (const bf16_t*)(ws + WS_WDN0), MROWS, 1024, 2816); pg8::StaticOrder S; S.init(MROWS, 1024, G, bx);
        pg8::EpiResid<false, false> E{nullptr, HB, nullptr, SSP}; pg8::gemm_phase(lds, g, S, E); }
    SEAM(PH_DN0);
    if (IN(PH_KVQG)) { const pg8::Gemm g = pg8::dense(HB, (const bf16_t*)(ws + WS_WKVQG), MROWS, NKVQG, 1024); pg8::StaticOrder S; S.init(MROWS, NKVQG, G, bx);
        pg8::EpiKVQG E{SSP, (bf16_t*)(ws + WS_KV), (bf16_t*)(ws + WS_Q), (float*)(ws + WS_GATE)}; pg8::gemm_phase(lds, g, S, E); }
    SEAM(PH_KVQG);
    if (IN(PH_CMP)) { pg8::Gemm g = pg8::dense((const bf16_t*)(ws + WS_KV), (const bf16_t*)(ws + WS_W1T), 16384, 512, 2048);
        g.amode = 1; g.a_kstep = (size_t)NKV * 2; g.a_hstep = (size_t)32 * 16 * NKV * 2; g.a_tstep = (size_t)1024 * NKV * 2; g.a_pnstep = 512;
        pg8::StaticOrder S; S.init(16384, 512, G, bx); pg8::EpiCmpHidden E{(const float*)(ws + WS_B1F), (float*)(ws + WS_HID)}; pg8::gemm_phase(lds, g, S, E); }
    SEAM(PH_CMP);
    if (IN(PH_CMP2)) compress_out_phase(a, lds);
    SEAM(PH_CMP2);
    if (IN(PH_ATTN)) attn_mfma_phase(a, lds);
    SEAM(PH_ATTN);
    if (IN(PH_WO)) { const pg8::Gemm g = pg8::dense(Y, (const bf16_t*)(ws + WS_WO), MROWS, 1024, 1024); pg8::StaticOrder S; S.init(MROWS, 1024, G, bx);
        pg8::EpiResid<false, false> E{nullptr, HB, nullptr, SSP}; pg8::gemm_phase(lds, g, S, E); }
    SEAM(PH_WO);
    if (IN(PH_UP1)) { pg8::Gemm g = pg8::dense(HB, (const bf16_t*)(ws + WS_WUP1), MROWS, 5632, 1024); g.aperm = 1; pg8::ChainOrder S; S.init(22, G, bx);
        pg8::EpiConvPair<0, true> E{SSP, a.in[7] + 3 * 5632, 5632, DFF, ACT, DFF, exch}; pg8::gemm_phase(lds, g, S, E); }
    SEAM(PH_UP1);
    if (IN(PH_DN1)) { const pg8::Gemm g = pg8::dense(ACT, (const bf16_t*)(ws + WS_WDN1), MROWS, 1024, 2816); pg8::StaticOrder S; S.init(MROWS, 1024, G, bx);
        pg8::EpiResid<false, false> E{nullptr, HB, nullptr, SSP}; pg8::gemm_phase(lds, g, S, E); }
    SEAM(PH_DN1);
    if (IN(PH_FINAL)) final_phase(xo, HB, SSP, a.in[18], 0, MROWS);
#undef IN
#undef SEAM
}

extern "C" void kernel_launch(void* const* d_in, const int* in_sizes, int n_in, void* d_out, int out_size, void* d_ws, size_t ws_size, hipStream_t stream) {
    static int grid = 0;
    if (grid == 0) {
        if (n_in != 19 || ws_size < WS_END) { fprintf(stderr, "kernel_launch: unexpected shapes (n_in %d, ws %zu < %zu)\n", n_in, ws_size, (size_t)WS_END); grid = -1; return; }
        int dev = 0, cus = 0;
        (void)hipGetDevice(&dev); (void)hipDeviceGetAttribute(&cus, hipDeviceAttributeMultiprocessorCount, dev);
        if (hipFuncSetAttribute((const void*)mk_fwd, hipFuncAttributeMaxDynamicSharedMemorySize, LDS_BYTES) != hipSuccess) { fprintf(stderr, "kernel_launch: hipFuncSetAttribute failed\n"); grid = -1; return; }
        int per_cu = 0;
        if (hipOccupancyMaxActiveBlocksPerMultiprocessor(&per_cu, (const void*)mk_fwd, NTHREADS, LDS_BYTES) != hipSuccess || per_cu < 1) per_cu = 1;
        (void)hipGetLastError();
        grid = (cus > 0 ? cus : 256) * per_cu;
    }
    if (grid < 0) return;
    Args a{};
    for (int i = 0; i < 19; ++i) a.in[i] = (const float*)d_in[i];
    a.out = (float*)d_out; a.ws = (unsigned char*)d_ws;
    (void)hipMemsetAsync((unsigned char*)d_ws + WS_BAR, 0, 16384, stream);
    a.ph_lo = 0; a.ph_hi = PH_COUNT;
    void* kargs[] = {&a};
    hipError_t e = hipLaunchCooperativeKernel((const void*)mk_fwd, dim3(grid), dim3(NTHREADS), kargs, LDS_BYTES, stream);
    if (e != hipSuccess) fprintf(stderr, "cooperative launch failed: %s (grid %d)\n", hipGetErrorString(e), grid);
}
```

```cpp
#include <hip/hip_runtime.h>
#include <hip/hip_cooperative_groups.h>
#include <cstdio>
#include <type_traits>
namespace cg = cooperative_groups;

#define LAS __attribute__((address_space(3)))
typedef unsigned short bf16_t;
typedef short bf16x8 __attribute__((ext_vector_type(8)));
typedef float f32x4 __attribute__((ext_vector_type(4)));
typedef float f32x2 __attribute__((ext_vector_type(2)));
typedef unsigned u32x4 __attribute__((ext_vector_type(4)));
typedef unsigned u32x2 __attribute__((ext_vector_type(2)));

constexpr int NB = 32, SEQ = 2048, DM = 1024, DFF = 2816, MROWS = NB * SEQ;
constexpr int NKV = 1536, NQG = 1072, NKVQG = 2816, NCMP = 127;
constexpr int NTHREADS = 512;
constexpr int EPC_OFF = 147456 + 16, LDS_BYTES = EPC_OFF + 8192;

constexpr size_t WS_WIN = 0;
constexpr size_t WS_WOUT = WS_WIN + (size_t)3072 * 1024 * 2;
constexpr size_t WS_WUP0 = WS_WOUT + (size_t)1024 * 1024 * 2;
constexpr size_t WS_WUP1 = WS_WUP0 + (size_t)5632 * 1024 * 2;
constexpr size_t WS_WDN0 = WS_WUP1 + (size_t)5632 * 1024 * 2;
constexpr size_t WS_WDN1 = WS_WDN0 + (size_t)1024 * 2816 * 2;
constexpr size_t WS_WKVQG = WS_WDN1 + (size_t)1024 * 2816 * 2;
constexpr size_t WS_WO = WS_WKVQG + (size_t)2816 * 1024 * 2;
constexpr size_t WS_W1T = WS_WO + (size_t)1024 * 1024 * 2;
constexpr size_t WS_B1F = WS_W1T + (size_t)2 * 256 * 2048 * 2;
constexpr size_t WS_HB = 56ull << 20;
constexpr size_t WS_BIG = WS_HB + (size_t)MROWS * 1024 * 2;
constexpr size_t WS_KV = WS_BIG;
constexpr size_t WS_Q = WS_BIG + (size_t)MROWS * NKV * 2;
constexpr size_t WS_Y = WS_BIG + (size_t)MROWS * DFF * 2;
constexpr size_t WS_RAW = WS_Y + (size_t)MROWS * 1024 * 2;
constexpr size_t WS_GATE = WS_RAW + (size_t)16384 * 5632 * 2;
constexpr size_t WS_KCMP = WS_GATE + (size_t)MROWS * 48 * 4;
constexpr size_t WS_RS = WS_KCMP + (size_t)2 * 32 * 128 * 4 * 64 * 4;
constexpr size_t WS_KCB = WS_RS + (size_t)MROWS * 4;
constexpr size_t WS_HID = WS_KCB + (size_t)2 * 32 * 128 * 4 * 64 * 2;
constexpr size_t WS_SSP = WS_HID + (size_t)2 * 16384 * 128 * 4;
constexpr size_t WS_BAR = WS_SSP + (size_t)MROWS * 16 * 4;
constexpr size_t WS_END = WS_BAR + 16384;

__device__ __forceinline__ float bf2f(bf16_t b) { return __uint_as_float(((unsigned)b) << 16); }
__device__ __forceinline__ bf16_t f2bf(float f) { unsigned u = __float_as_uint(f); u += 0x7fffu + ((u >> 16) & 1u); return (bf16_t)(u >> 16); }
__device__ __forceinline__ unsigned cvt_pk_bf16(float lo, float hi) { unsigned r; asm volatile("v_cvt_pk_bf16_f32 %0, %1, %2" : "=v"(r) : "v"(lo), "v"(hi)); return r; }
__device__ __forceinline__ float wave_sum(float v) { for (int o = 32; o >= 1; o >>= 1) v += __shfl_xor(v, o); return v; }
__device__ __forceinline__ float wave_max(float v) { for (int o = 32; o >= 1; o >>= 1) v = fmaxf(v, __shfl_xor(v, o)); return v; }

__device__ __forceinline__ float gelu_tanh(float x) { const float u = 0.7978845608028654f * (x + 0.044715f * x * x * x); return 0.5f * x * (1.0f + tanhf(u)); }
struct Args { const float* in[19]; float* out; unsigned char* ws; int ph_lo, ph_hi, seq0, nseq, nchunk, pad; };

namespace pg8 {
constexpr int BM = 256, BK = 64, HALF = 128, HTB = HALF * BK * 2, STAGE_BYTES = 8 * HTB, NXCD = 8, WGM = 8;
__host__ __device__ __forceinline__ int lds_byte(int r, int c) { const int st = (r >> 4) * 2 + (c >> 5), rr = r & 15, cc = c & 31, ob = rr * 64 + cc * 2; return st * 1024 + (ob ^ (((ob >> 9) & 1) << 5)); }
__host__ __device__ __forceinline__ void stage_rc(int b, int& R, int& C) { const int st = b / 1024, sb = b % 1024, swz = sb ^ (((sb >> 9) & 1) << 5); R = (st >> 1) * 16 + swz / 64; C = (st & 1) * 32 + (swz % 64) / 2; }
__host__ __device__ __forceinline__ int perm32(int rho) { const int n = rho >> 4, i = rho & 15; return 8 * (i >> 2) + 4 * n + (i & 3); }
struct Unit { int pm, pn; };
struct Gemm { const bf16_t* A; const bf16_t* Bt; int M, N, K; int amode, aperm; size_t a_kstep, a_hstep, a_tstep, a_pnstep; };
__device__ __forceinline__ Gemm dense(const bf16_t* A, const bf16_t* Bt, int M, int N, int K) { Gemm g; g.A = A; g.Bt = Bt; g.M = M; g.N = N; g.K = K; g.amode = 0; g.aperm = 0; g.a_kstep = 128; g.a_hstep = (size_t)128 * K * 2; g.a_tstep = (size_t)256 * K * 2; g.a_pnstep = 0; return g; }
struct StaticOrder {
    int nM, nN, nwg, G, c;
    __device__ void init(int M, int N, int G_, int c_) { nM = M / BM; nN = N / BM; nwg = nM * nN; G = G_; c = c_; }
    __device__ bool next(int i, Unit& u) const {
        const long L = (long)i * G + c; if (L >= nwg) return false;
        int wgid = (int)L; { const int q = nwg / NXCD, r = nwg % NXCD, xcd = wgid % NXCD, off = wgid / NXCD; wgid = (xcd < r ? xcd * (q + 1) : r * (q + 1) + (xcd - r) * q) + off; }
        const int nig = WGM * nN, gid = wgid / nig, fm = gid * WGM, gsz = (nM - fm) < WGM ? (nM - fm) : WGM;
        u.pm = fm + ((wgid % nig) % gsz); u.pn = (wgid % nig) / gsz; return true;
    }
};

__device__ __forceinline__ float row_scale16(const float* ssp, int row, int fq) {
    const f32x4 p = *(const f32x4*)(ssp + (size_t)row * 16 + 4 * fq); float s = (p[0] + p[1]) + (p[2] + p[3]);
    s += __shfl_xor(s, 16); s += __shfl_xor(s, 32); return rsqrtf(s * (1.0f / DM) + 1e-6f); }
template <bool BASE_F32, bool OUT_F32> struct EpiResid {
    static constexpr bool PERM = true; static constexpr bool HAS_PRE = false;
    const float* base32; bf16_t* xb; float* out32; float* ssp;
    __device__ __forceinline__ void operator()(f32x4 (&acc)[2][2][4][2], const Unit& u, int ui, int wr, int wc, int fr, int fq) const {
        const int row0 = u.pm * BM + wr * 64 + fr, col0 = u.pn * BM + wc * 32 + 8 * fq;
#pragma unroll
        for (int ai = 0; ai < 2; ++ai)
#pragma unroll
            for (int m = 0; m < 4; ++m) { const int row = row0 + ai * HALF + m * 16; const size_t off = (size_t)row * DM + col0; float ss = 0.f;
#pragma unroll
                for (int bj = 0; bj < 2; ++bj) { const size_t o = off + bj * HALF; f32x4 v0, v1;
                    if (BASE_F32) { v0 = *(const f32x4*)(base32 + o); v1 = *(const f32x4*)(base32 + o + 4); }
                    else { const u32x4 b = *(const u32x4*)(xb + o);
                        v0 = (f32x4){__uint_as_float(b.x << 16), __uint_as_float(b.x & 0xffff0000u), __uint_as_float(b.y << 16), __uint_as_float(b.y & 0xffff0000u)};
                        v1 = (f32x4){__uint_as_float(b.z << 16), __uint_as_float(b.z & 0xffff0000u), __uint_as_float(b.w << 16), __uint_as_float(b.w & 0xffff0000u)}; }
                    v0 += acc[ai][bj][m][0]; v1 += acc[ai][bj][m][1];
                    ss += ((v0[0] * v0[0] + v0[1] * v0[1]) + (v0[2] * v0[2] + v0[3] * v0[3])) + ((v1[0] * v1[0] + v1[1] * v1[1]) + (v1[2] * v1[2] + v1[3] * v1[3]));
                    if (OUT_F32) { *(f32x4*)(out32 + o) = v0; *(f32x4*)(out32 + o + 4) = v1; }
                    else { u32x4 w; w.x = cvt_pk_bf16(v0[0], v0[1]); w.y = cvt_pk_bf16(v0[2], v0[3]); w.z = cvt_pk_bf16(v1[0], v1[1]); w.w = cvt_pk_bf16(v1[2], v1[3]); *(u32x4*)(xb + o) = w; } }
                if (!OUT_F32) { ss += __shfl_xor(ss, 16); ss += __shfl_xor(ss, 32); if (fq == 0) ssp[(size_t)row * 16 + u.pn * 4 + wc] = ss; } }
    }
};
struct EpiKVQG {
    static constexpr bool PERM = true;
    const float* ssp; bf16_t* kv; bf16_t* q; float* gate;
    __device__ __forceinline__ void operator()(f32x4 (&acc)[2][2][4][2], const Unit& u, int ui, int wr, int wc, int fr, int fq) const {
        const int row0 = u.pm * BM + wr * 64 + fr, cin = wc * 32 + 8 * fq;
#pragma unroll
        for (int ai = 0; ai < 2; ++ai)
#pragma unroll
            for (int m = 0; m < 4; ++m) { const int row = row0 + ai * HALF + m * 16; const float s = row_scale16(ssp, row, fq);
#pragma unroll
                for (int bj = 0; bj < 2; ++bj) { f32x4 v0 = acc[ai][bj][m][0] * s, v1 = acc[ai][bj][m][1] * s; const int col = cin + bj * HALF;
                    if (u.pn < 6) { u32x4 w; w.x = cvt_pk_bf16(v0[0], v0[1]); w.y = cvt_pk_bf16(v0[2], v0[3]); w.z = cvt_pk_bf16(v1[0], v1[1]); w.w = cvt_pk_bf16(v1[2], v1[3]);
                        *(u32x4*)(kv + (size_t)row * NKV + u.pn * BM + col) = w; }
                    else if (u.pn < 10) { v0 *= 0.125f; v1 *= 0.125f; u32x4 w; w.x = cvt_pk_bf16(v0[0], v0[1]); w.y = cvt_pk_bf16(v0[2], v0[3]); w.z = cvt_pk_bf16(v1[0], v1[1]); w.w = cvt_pk_bf16(v1[2], v1[3]);
                        *(u32x4*)(q + (size_t)row * DM + (u.pn - 6) * BM + col) = w; }
                    else if (col < 48) { f32x4 g0, g1;
#pragma unroll
                        for (int j = 0; j < 4; ++j) { g0[j] = 1.0f / (1.0f + __expf(-v0[j])); g1[j] = 1.0f / (1.0f + __expf(-v1[j])); }
                        *(f32x4*)(gate + (size_t)row * 48 + col) = g0; *(f32x4*)(gate + (size_t)row * 48 + col + 4) = g1; } } }
    }
};

struct ChainOrder {
    int nP, nchain_x, G8, xcd, slot; bool live;
    __device__ void init(int nP_, int G, int c) { nP = nP_; G8 = G / 8; xcd = c % 8; slot = c / 8; nchain_x = (NB / 8) * nP; live = c < 8 * G8; }
    __device__ bool next(int i, Unit& u) const {
        const int ci = i >> 3, w = i & 7, Lx = ci * G8 + slot; if (!live || Lx >= nchain_x) return false;
        const int seq = (Lx & 3) * 8 + xcd; u.pn = Lx >> 2; u.pm = seq * 8 + w; return true; }
};
template <int CTRL> __device__ __forceinline__ float dppf(float old, float src) {
    return __builtin_bit_cast(float, __builtin_amdgcn_update_dpp(__builtin_bit_cast(int, old), __builtin_bit_cast(int, src), CTRL, 0xf, 0xf, false)); }

template <int MODE, bool SSP> struct EpiConvPair {
    static constexpr bool PERM = true;
    const float* rs; const float* cw; int cw_ld, goff; bf16_t* O; int ldo; LAS float* exch; LAS float* cache;
    struct Pref { f32x4 w; f32x4 p0, p1; };
    __device__ __forceinline__ void issue(const Unit& nu, Pref& r) const {
        const int tid = threadIdx.x; r.w = (f32x4){0.f, 0.f, 0.f, 0.f};
        if (tid < (MODE == 0 ? 192 : 96)) { const int tt = tid >> 5, type = tt / 3, tap = tt % 3; r.w = *(const f32x4*)(cw + (size_t)tap * cw_ld + type * goff + nu.pn * HALF + (tid & 31) * 4); }
        const size_t row = (size_t)nu.pm * BM + (tid >> 1);
        if (SSP) { r.p0 = *(const f32x4*)(rs + row * 16 + 8 * (tid & 1)); r.p1 = *(const f32x4*)(rs + row * 16 + 8 * (tid & 1) + 4); } else { r.p0 = (f32x4){rs[row], 0.f, 0.f, 0.f}; r.p1 = r.p0; }
    }
    __device__ __forceinline__ void commit(int par, const Pref& r) const {
        const int tid = threadIdx.x; LAS float* c = cache + par * 1024;
        if (tid < (MODE == 0 ? 192 : 96)) *(LAS f32x4*)(c + (tid >> 5) * 128 + (tid & 31) * 4) = r.w;
        float sc;
        if (SSP) { float ss = ((r.p0[0] + r.p0[1]) + (r.p0[2] + r.p0[3])) + ((r.p1[0] + r.p1[1]) + (r.p1[2] + r.p1[3])); ss += dppf<0xB1>(0.f, ss); sc = rsqrtf(ss * (1.0f / DM) + 1e-6f); } else sc = r.p0[0];
        if ((tid & 1) == 0) c[768 + (tid >> 1)] = sc;
    }
    __device__ __forceinline__ void pre(const Unit& u) const { Pref r; issue(u, r); commit(0, r); }
    __device__ __forceinline__ void run(f32x4 (&acc)[2][2][4][2], const Unit& u, int ui, int wr, int wc, int fr, int fq, bool has_next, const Unit& nu) const {
        Pref pf; if (has_next) issue(nu, pf);
        const LAS float* cc = cache + (ui & 1) * 1024;
        const int row0 = u.pm * BM + wr * 64 + 4 * fr, lcol = wc * 32 + 8 * fq, lrow0 = wr * 64 + 4 * fr;
#pragma unroll
        for (int ai = 0; ai < 2; ++ai)
#pragma unroll
            for (int m = 0; m < 4; ++m) { const float sc = cc[768 + lrow0 + ai * HALF + m];
#pragma unroll
                for (int n = 0; n < 2; ++n) { if (MODE == 0) { acc[ai][0][m][n] *= sc; acc[ai][1][m][n] *= sc; } else acc[ai][0][m][n] = (acc[ai][0][m][n] * sc) * (acc[ai][1][m][n] * sc); } }
        LAS float* ex = exch + (ui & 1) * 2048;
        if (fr == 15) {
#pragma unroll
            for (int ai = 0; ai < 2; ++ai)
#pragma unroll
                for (int r = 0; r < 2; ++r) { LAS float* p = ex + ((ai * 2 + wr) * 2 + r) * 256 + lcol;
                    *(LAS f32x4*)p = acc[ai][0][2 + r][0]; *(LAS f32x4*)(p + 4) = acc[ai][0][2 + r][1];
                    if (MODE == 0) { *(LAS f32x4*)(p + 128) = acc[ai][1][2 + r][0]; *(LAS f32x4*)(p + 132) = acc[ai][1][2 + r][1]; } } }
        asm volatile("s_waitcnt lgkmcnt(0)" ::: "memory"); __builtin_amdgcn_s_barrier(); asm volatile("" ::: "memory"); __builtin_amdgcn_s_barrier(); asm volatile("" ::: "memory");
        const int f = u.pn * HALF + lcol;
        u32x2 keep[2][4];
#pragma unroll
        for (int n = 0; n < 2; ++n) {
            f32x4 wa[3], wg[3];
#pragma unroll
            for (int k = 0; k < 3; ++k) { wa[k] = *(const LAS f32x4*)(cc + k * 128 + lcol + 4 * n); if (MODE == 0) wg[k] = *(const LAS f32x4*)(cc + (3 + k) * 128 + lcol + 4 * n); }
#pragma unroll
            for (int ai = 0; ai < 2; ++ai) {
                const int blk = ai * 2 + wr;
                f32x4 ba2 = (f32x4){0.f, 0.f, 0.f, 0.f}, ba3 = ba2, bg2 = ba2, bg3 = ba2;
                const LAS float* src = nullptr;
                if (blk > 0) src = ex + (blk - 1) * 512; else if ((u.pm & 7) != 0) src = exch + ((ui & 1) ^ 1) * 2048 + 3 * 512;
                if (src != nullptr) { const LAS float* p = src + lcol + 4 * n; ba2 = *(const LAS f32x4*)p; ba3 = *(const LAS f32x4*)(p + 256);
                    if (MODE == 0) { bg2 = *(const LAS f32x4*)(p + 128); bg3 = *(const LAS f32x4*)(p + 256 + 128); } }
                float o[4][4];
#pragma unroll
                for (int j = 0; j < 4; ++j) {
                    const float v0 = acc[ai][0][0][n][j], v1 = acc[ai][0][1][n][j], v2 = acc[ai][0][2][n][j], v3 = acc[ai][0][3][n][j];
                    const float p2 = dppf<0x111>(ba2[j], v2), p3 = dppf<0x111>(ba3[j], v3);
                    const float w0 = wa[0][j], w1 = wa[1][j], w2 = wa[2][j];
                    float y[4] = {w2 * v0 + w1 * p3 + w0 * p2, w2 * v1 + w1 * v0 + w0 * p3, w2 * v2 + w1 * v1 + w0 * v0, w2 * v3 + w1 * v2 + w0 * v1};
                    if (MODE == 0) {
                        const float g0 = acc[ai][1][0][n][j], g1 = acc[ai][1][1][n][j], g2 = acc[ai][1][2][n][j], g3 = acc[ai][1][3][n][j];
                        const float q2 = dppf<0x111>(bg2[j], g2), q3 = dppf<0x111>(bg3[j], g3);
                        const float x0 = wg[0][j], x1 = wg[1][j], x2 = wg[2][j];
                        const float z[4] = {x2 * g0 + x1 * q3 + x0 * q2, x2 * g1 + x1 * g0 + x0 * q3, x2 * g2 + x1 * g1 + x0 * g0, x2 * g3 + x1 * g2 + x0 * g1};
#pragma unroll
                        for (int m = 0; m < 4; ++m) o[m][j] = y[m] * __builtin_amdgcn_rcpf(1.0f + __expf(-y[m])) * z[m];
                    } else {
#pragma unroll
                        for (int m = 0; m < 4; ++m) o[m][j] = y[m];
                    }
                }
#pragma unroll
                for (int m = 0; m < 4; ++m) { u32x2 w; w.x = cvt_pk_bf16(o[m][0], o[m][1]); w.y = cvt_pk_bf16(o[m][2], o[m][3]);
                    if (n == 0) keep[ai][m] = w;
                    else { u32x4 w4; w4.x = keep[ai][m].x; w4.y = keep[ai][m].y; w4.z = w.x; w4.w = w.y; __builtin_nontemporal_store(w4, (u32x4*)(O + (size_t)(row0 + ai * HALF + m) * ldo + f)); } }
            }
            __builtin_amdgcn_sched_barrier(0);
        }
        if (has_next) commit((ui & 1) ^ 1, pf);
    }
};
template <class T, class = void> struct has_pre : std::false_type {};
template <class T> struct has_pre<T, std::void_t<decltype(&T::pre)>> : std::true_type {};
struct EpiCmpHidden {
    static constexpr bool PERM = true;
    const float* b1f; float* H;
    __device__ __forceinline__ void operator()(f32x4 (&acc)[2][2][4][2], const Unit& u, int ui, int wr, int wc, int fr, int fq) const {
        const int row0 = u.pm * BM + wr * 64 + fr, col = wc * 32 + 8 * fq;
        const f32x4 b0 = *(const f32x4*)(b1f + u.pn * 128 + col), b1 = *(const f32x4*)(b1f + u.pn * 128 + col + 4);
#pragma unroll
        for (int ai = 0; ai < 2; ++ai)
#pragma unroll
            for (int m = 0; m < 4; ++m) { const int row = row0 + ai * HALF + m * 16; f32x4 v0 = acc[ai][0][m][0] + b0, v1 = acc[ai][0][m][1] + b1;
#pragma unroll
                for (int j = 0; j < 4; ++j) { v0[j] = gelu_tanh(v0[j]); v1[j] = gelu_tanh(v1[j]); }
                float* hp = H + ((size_t)u.pn * 16384 + row) * 128 + col; *(f32x4*)hp = v0; *(f32x4*)(hp + 4) = v1; }
    }
};
struct EpiMulB {
    static constexpr bool PERM = true;
    const float* rs; const bf16_t* other; bf16_t* Yo;
    __device__ __forceinline__ void operator()(f32x4 (&acc)[2][2][4][2], const Unit& u, int ui, int wr, int wc, int fr, int fq) const {
        const int row0 = u.pm * BM + wr * 64 + fr, col0 = u.pn * BM + wc * 32 + 8 * fq;
#pragma unroll
        for (int ai = 0; ai < 2; ++ai)
#pragma unroll
            for (int m = 0; m < 4; ++m) { const int row = row0 + ai * HALF + m * 16; const float sc = rs[row];
#pragma unroll
                for (int bj = 0; bj < 2; ++bj) { const size_t o = (size_t)row * DM + col0 + bj * HALF; const bf16x8 ov = *(const bf16x8*)(other + o);
                    const f32x4 v0 = acc[ai][bj][m][0] * sc, v1 = acc[ai][bj][m][1] * sc; u32x4 w;
                    w.x = cvt_pk_bf16(v0[0] * bf2f((bf16_t)ov[0]), v0[1] * bf2f((bf16_t)ov[1])); w.y = cvt_pk_bf16(v0[2] * bf2f((bf16_t)ov[2]), v0[3] * bf2f((bf16_t)ov[3]));
                    w.z = cvt_pk_bf16(v1[0] * bf2f((bf16_t)ov[4]), v1[1] * bf2f((bf16_t)ov[5])); w.w = cvt_pk_bf16(v1[2] * bf2f((bf16_t)ov[6]), v1[3] * bf2f((bf16_t)ov[7]));
                    *(u32x4*)(Yo + o) = w; } }
    }
};

template <class Epi, class Sched>
__device__ __forceinline__ void gemm_phase(LAS unsigned char* lds, const Gemm g, const Sched& S, const Epi& E) {
    int tid_ = threadIdx.x; asm volatile("" : "+v"(tid_));
    const int tid = tid_, wid = __builtin_amdgcn_readfirstlane(tid >> 6), lane = tid & 63, wr = wid >> 2, wc = wid & 3, fr = lane & 15, fq = lane >> 4;
    const int K = g.K, nt = K / BK;
    unsigned voffA[2], voffB[2];
#pragma unroll
    for (int i = 0; i < 2; ++i) { int R, C; stage_rc(tid * 16 + i * 8192, R, C); const int Rb = Epi::PERM ? ((R & ~31) + perm32(R & 31)) : R;
        const int Ra = g.aperm ? ((R & ~63) | ((R & 15) << 2) | ((R >> 4) & 3)) : R;
        voffA[i] = g.amode ? (unsigned)((R >> 2) * (16 * NKV) + (R & 3) * 64 + C) * 2u : (unsigned)(Ra * K + C) * 2u; voffB[i] = (unsigned)(Rb * K + C) * 2u; }
    const size_t kstep = (size_t)(BK * 2), hstep = (size_t)HALF * K * 2, tstep = 2 * hstep;
    const size_t akstep = g.a_kstep, ahstep = g.a_hstep, atstep = g.a_tstep;
    const unsigned ldsw = (unsigned)wid * 1024u;
    const int aoff = lds_byte(wr * 64 + fr, fq * 8), boff = lds_byte(wc * 32 + fr, fq * 8);
#define PG8_SA(b, h) (((b) * 2 + (h)) * HTB)
#define PG8_SB(b, h) ((4 + (b) * 2 + (h)) * HTB)
#define PG8_STAGE(bufoff, gbase, voff) do { _Pragma("unroll") for (int _i = 0; _i < 2; ++_i) \
        __builtin_amdgcn_global_load_lds((const unsigned*)((const char*)(gbase) + (voff)[_i]), (LAS unsigned*)(lds + (bufoff) + ldsw + _i * 8192), 16, 0, 0); } while (0)
#define PG8_LDA(dst, b, h) do { _Pragma("unroll") for (int m = 0; m < 4; ++m) _Pragma("unroll") for (int k = 0; k < 2; ++k) dst[m][k] = *(const LAS bf16x8*)(lds + PG8_SA(b, h) + aoff + m * 2048 + k * 1024); } while (0)
#define PG8_LDB(dst, b, h) do { _Pragma("unroll") for (int n = 0; n < 2; ++n) _Pragma("unroll") for (int k = 0; k < 2; ++k) dst[n][k] = *(const LAS bf16x8*)(lds + PG8_SB(b, h) + boff + n * 2048 + k * 1024); } while (0)
#define PG8_MMA(ai, bj, At, Bt) do { __builtin_amdgcn_s_setprio(1); _Pragma("unroll") for (int m = 0; m < 4; ++m) _Pragma("unroll") for (int n = 0; n < 2; ++n) _Pragma("unroll") for (int k = 0; k < 2; ++k) \
        acc[ai][bj][m][n] = __builtin_amdgcn_mfma_f32_16x16x32_bf16(Bt[n][k], At[m][k], acc[ai][bj][m][n], 0, 0, 0); __builtin_amdgcn_s_setprio(0); } while (0)
#define PG8_WAIT_V(n) asm volatile("s_waitcnt vmcnt(" #n ")" ::: "memory")
#define PG8_WAIT_L(n) asm volatile("s_waitcnt lgkmcnt(" #n ")" ::: "memory")
#define PG8_BAR __builtin_amdgcn_s_barrier()
#define PG8_SCHED __builtin_amdgcn_sched_barrier(0)
    Unit cur, nxt; int ui = 0;
    if (!S.next(0, cur)) return;
    if constexpr (has_pre<Epi>::value) E.pre(cur);
    f32x4 acc[2][2][4][2];
#pragma unroll
    for (int a = 0; a < 2; ++a)
#pragma unroll
        for (int b = 0; b < 2; ++b)
#pragma unroll
            for (int m = 0; m < 4; ++m)
#pragma unroll
                for (int n = 0; n < 2; ++n) acc[a][b][m][n] = (f32x4){0.f, 0.f, 0.f, 0.f};
    bf16x8 At[4][2], B0[2][2], B1[2][2];
    const char* cA = (const char*)g.A + (size_t)cur.pm * atstep + (size_t)cur.pn * g.a_pnstep; const char* cB = (const char*)g.Bt + (size_t)cur.pn * tstep;
    PG8_STAGE(PG8_SB(0, 0), cB, voffB); PG8_STAGE(PG8_SA(0, 0), cA, voffA); PG8_STAGE(PG8_SB(0, 1), cB + hstep, voffB); PG8_STAGE(PG8_SA(0, 1), cA + ahstep, voffA);
    if (wr == 1) PG8_BAR;
    PG8_WAIT_V(4); PG8_BAR;
    PG8_STAGE(PG8_SB(1, 0), cB + kstep, voffB); PG8_STAGE(PG8_SA(1, 0), cA + akstep, voffA); PG8_STAGE(PG8_SB(1, 1), cB + hstep + kstep, voffB);
    PG8_WAIT_V(6); PG8_BAR;
    for (;;) {
        const bool has_next = S.next(ui + 1, nxt);
        const char* nA = has_next ? (const char*)g.A + (size_t)nxt.pm * atstep + (size_t)nxt.pn * g.a_pnstep : cA; const char* nB = has_next ? (const char*)g.Bt + (size_t)nxt.pn * tstep : cB;
        for (int t = 0; t < nt; t += 2) {
            const bool last = (t == nt - 2);
            const char* a1 = cA + (size_t)(t + 1) * akstep;
            const char* a2 = last ? nA : cA + (size_t)(t + 2) * akstep; const char* b2 = last ? nB : cB + (size_t)(t + 2) * kstep;
            const char* a3 = a2 + akstep; const char* b3 = b2 + kstep;
            PG8_LDB(B0, 0, 0); PG8_SCHED; PG8_LDA(At, 0, 0); PG8_STAGE(PG8_SA(1, 1), a1 + ahstep, voffA);
            PG8_WAIT_L(8); PG8_BAR; PG8_WAIT_L(0); PG8_MMA(0, 0, At, B0); PG8_BAR; PG8_SCHED;
            PG8_LDB(B1, 0, 1); PG8_STAGE(PG8_SB(0, 0), b2, voffB);
            PG8_BAR; PG8_WAIT_L(0); PG8_MMA(0, 1, At, B1); PG8_BAR;
            PG8_LDA(At, 0, 1); PG8_STAGE(PG8_SA(0, 0), a2, voffA);
            PG8_BAR; PG8_WAIT_L(0); PG8_MMA(1, 0, At, B0); PG8_BAR; PG8_SCHED;
            PG8_STAGE(PG8_SB(0, 1), b2 + hstep, voffB);
            PG8_WAIT_V(6); PG8_BAR; PG8_MMA(1, 1, At, B1); PG8_BAR;
            PG8_LDB(B0, 1, 0); PG8_SCHED; PG8_LDA(At, 1, 0); PG8_STAGE(PG8_SA(0, 1), a2 + ahstep, voffA);
            PG8_WAIT_L(8); PG8_BAR; PG8_WAIT_L(0); PG8_MMA(0, 0, At, B0); PG8_BAR; PG8_SCHED;
            PG8_LDB(B1, 1, 1); PG8_STAGE(PG8_SB(1, 0), b3, voffB);
            PG8_BAR; PG8_WAIT_L(0); PG8_MMA(0, 1, At, B1); PG8_BAR;
            PG8_LDA(At, 1, 1); PG8_STAGE(PG8_SA(1, 0), a3, voffA);
            PG8_BAR; PG8_WAIT_L(0); PG8_MMA(1, 0, At, B0); PG8_BAR; PG8_SCHED;
            PG8_STAGE(PG8_SB(1, 1), b3 + hstep, voffB);
            PG8_WAIT_V(6); PG8_BAR; PG8_MMA(1, 1, At, B1); PG8_BAR;
        }
        if constexpr (has_pre<Epi>::value) E.run(acc, cur, ui, wr, wc, fr, fq, has_next, nxt); else E(acc, cur, ui, wr, wc, fr, fq);
        if (!has_next) break;
#pragma unroll
        for (int a = 0; a < 2; ++a)
#pragma unroll
            for (int b = 0; b < 2; ++b)
#pragma unroll
                for (int m = 0; m < 4; ++m)
#pragma unroll
                    for (int n = 0; n < 2; ++n) acc[a][b][m][n] = (f32x4){0.f, 0.f, 0.f, 0.f};
        cur = nxt; cA = nA; cB = nB; ++ui;
    }
    PG8_WAIT_V(0);
    if (wr == 0) PG8_BAR;
    PG8_BAR;
#undef PG8_SA
#undef PG8_SB
#undef PG8_STAGE
#undef PG8_LDA
#undef PG8_LDB
#undef PG8_MMA
#undef PG8_WAIT_V
#undef PG8_WAIT_L
#undef PG8_BAR
#undef PG8_SCHED
}
}

struct TrJob { const float* W0; int ld0, n0; const float* W1; int ld1, n1; const float* g0; const float* g1; int mode, pb0, pb1; bf16_t* Wt; int K, Nout; };
__device__ __forceinline__ TrJob get_job(int j, const Args& a) {
    unsigned char* ws = a.ws; TrJob t{}; t.W1 = nullptr; t.ld1 = 0; t.n1 = 0; t.g0 = nullptr; t.g1 = nullptr; t.mode = 0; t.pb0 = 0; t.pb1 = 0;
    switch (j) {
    case 0: t.W0 = a.in[2]; t.ld0 = 3072; t.n0 = 0; t.g0 = a.in[1]; t.mode = 1; t.pb0 = 1024; t.pb1 = 2048; t.Wt = (bf16_t*)(ws + WS_WIN); t.K = 1024; t.Nout = 2048; break;
    case 1: t.W0 = a.in[2]; t.ld0 = 3072; t.n0 = 1024; t.g0 = a.in[1]; t.Wt = (bf16_t*)(ws + WS_WIN) + (size_t)2048 * 1024; t.K = 1024; t.Nout = 1024; break;
    case 2: t.W0 = a.in[4]; t.ld0 = 1024; t.n0 = 1024; t.Wt = (bf16_t*)(ws + WS_WOUT); t.K = 1024; t.Nout = 1024; break;
    case 3: t.W0 = a.in[6]; t.ld0 = 5632; t.g0 = a.in[5]; t.mode = 1; t.pb0 = 0; t.pb1 = 2816; t.Wt = (bf16_t*)(ws + WS_WUP0); t.K = 1024; t.Nout = 5632; break;
    case 4: t.W0 = a.in[6] + (size_t)1024 * 5632; t.ld0 = 5632; t.g0 = a.in[5] + 1024; t.mode = 1; t.pb0 = 0; t.pb1 = 2816; t.Wt = (bf16_t*)(ws + WS_WUP1); t.K = 1024; t.Nout = 5632; break;
    case 5: t.W0 = a.in[8]; t.ld0 = 1024; t.n0 = 1024; t.Wt = (bf16_t*)(ws + WS_WDN0); t.K = 2816; t.Nout = 1024; break;
    case 6: t.W0 = a.in[8] + (size_t)2816 * 1024; t.ld0 = 1024; t.n0 = 1024; t.Wt = (bf16_t*)(ws + WS_WDN1); t.K = 2816; t.Nout = 1024; break;
    case 7: t.W0 = a.in[10]; t.ld0 = 1536; t.n0 = 1536; t.g0 = a.in[9]; t.W1 = a.in[15]; t.ld1 = 1072; t.n1 = 1072; t.g1 = a.in[1] + 1024; t.Wt = (bf16_t*)(ws + WS_WKVQG); t.K = 1024; t.Nout = 2816; break;
    case 8: t.W0 = a.in[16]; t.ld0 = 1024; t.n0 = 1024; t.Wt = (bf16_t*)(ws + WS_WO); t.K = 1024; t.Nout = 1024; break;
    case 9: t.W0 = a.in[12]; t.ld0 = 128; t.n0 = 128; t.Wt = (bf16_t*)(ws + WS_W1T); t.K = 2048; t.Nout = 256; break;
    default: t.W0 = a.in[12] + (size_t)2048 * 128; t.ld0 = 128; t.n0 = 128; t.Wt = (bf16_t*)(ws + WS_W1T) + (size_t)256 * 2048; t.K = 2048; t.Nout = 256; break;
    }
    return t;
}
__device__ __forceinline__ void wprep_phase(const Args& a, LAS unsigned char* lds) {
    LAS float* tile = (LAS float*)lds;
    const int tid = threadIdx.x, tx = tid & 63, ty = tid >> 6;
    int jstart = 0;
    for (int j = 0; j < 11; ++j) {
        const TrJob t = get_job(j, a);
        const int nkt = t.K / 64, nnt = t.Nout / 64, ntile = nkt * nnt;
        int first = ((int)blockIdx.x - jstart % (int)gridDim.x + (int)gridDim.x) % (int)gridDim.x;
        for (int ti = first; ti < ntile; ti += gridDim.x) {
            const int kt = ti % nkt, ntl = ti / nkt, k0 = kt * 64, n0 = ntl * 64;
            const int n = n0 + tx; const float* src = nullptr; int ld = 0; const float* gp = t.g0;
            if (t.mode == 1) { const int p = n >> 8, half = (n >> 7) & 1, c = n & 127; src = t.W0 + (half ? t.pb1 : t.pb0) + 128 * p + c; ld = t.ld0; }
            else if (n < t.n0) { src = t.W0 + n; ld = t.ld0; }
            else if (n - t.n0 < t.n1) { src = t.W1 + (n - t.n0); ld = t.ld1; gp = t.g1; }
            __syncthreads();
#pragma unroll
            for (int i = 0; i < 8; ++i) { const int k = k0 + ty + 8 * i; float v = 0.f; if (src) { v = src[(size_t)k * ld]; if (gp) v *= gp[k]; } tile[(ty + 8 * i) * 65 + tx] = v; }
            __syncthreads();
            { const int nn = tid >> 3, kc = (tid & 7) * 8; u32x4 w;
                w.x = cvt_pk_bf16(tile[(kc + 0) * 65 + nn], tile[(kc + 1) * 65 + nn]); w.y = cvt_pk_bf16(tile[(kc + 2) * 65 + nn], tile[(kc + 3) * 65 + nn]);
                w.z = cvt_pk_bf16(tile[(kc + 4) * 65 + nn], tile[(kc + 5) * 65 + nn]); w.w = cvt_pk_bf16(tile[(kc + 6) * 65 + nn], tile[(kc + 7) * 65 + nn]);
                *(u32x4*)(t.Wt + (size_t)(n0 + nn) * t.K + k0 + kc) = w; }
        }
        jstart += ntile;
    }
    if (tid < 64) for (int idx = blockIdx.x; idx < 256; idx += gridDim.x) { const int j = idx >> 7, n = idx & 127; float sacc = 0.f;
            for (int k = tid; k < 2048; k += 64) sacc += a.in[11][j * 2048 + k] * a.in[12][((size_t)j * 2048 + k) * 128 + n];
            sacc = wave_sum(sacc); if (tid == 0) ((float*)(a.ws + WS_B1F))[idx] = sacc + a.in[13][idx]; }
    __syncthreads();
}

__device__ __forceinline__ void rowstat_phase(const float* src, bf16_t* dstb, float* rs, int row0, int nrows) {
    const int wave = threadIdx.x >> 6, lane = threadIdx.x & 63;
    for (int r = blockIdx.x * 8 + wave; r < nrows; r += gridDim.x * 8) {
        const size_t row = (size_t)(row0 + r); const float* p = src + row * DM; float ss = 0.f;
#pragma unroll
        for (int i = 0; i < 2; ++i) { const int c = i * 512 + lane * 8; const f32x4 v0 = *(const f32x4*)(p + c), v1 = *(const f32x4*)(p + c + 4);
            ss += ((v0[0] * v0[0] + v0[1] * v0[1]) + (v0[2] * v0[2] + v0[3] * v0[3])) + ((v1[0] * v1[0] + v1[1] * v1[1]) + (v1[2] * v1[2] + v1[3] * v1[3]));
            if (dstb) { u32x4 w; w.x = cvt_pk_bf16(v0[0], v0[1]); w.y = cvt_pk_bf16(v0[2], v0[3]); w.z = cvt_pk_bf16(v1[0], v1[1]); w.w = cvt_pk_bf16(v1[2], v1[3]); *(u32x4*)(dstb + row * DM + c) = w; } }
        ss = wave_sum(ss);
        if (lane == 0) rs[row] = rsqrtf(ss * (1.0f / DM) + 1e-6f);
    }
}
__device__ __forceinline__ void final_phase(float* out, const bf16_t* xb, const float* ssp, const float* gain, int row0, int nrows) {
    const int wave = threadIdx.x >> 6, lane = threadIdx.x & 63;
    for (int r = blockIdx.x * 8 + wave; r < nrows; r += gridDim.x * 8) {
        const size_t row = (size_t)(row0 + r);
        float ss = lane < 16 ? ssp[row * 16 + lane] : 0.f; ss = wave_sum(ss);
        const float sc = rsqrtf(ss * (1.0f / DM) + 1e-6f);
#pragma unroll
        for (int i = 0; i < 2; ++i) { const int c = i * 512 + lane * 8; const bf16x8 v = *(const bf16x8*)(xb + row * DM + c);
            const f32x4 g0 = *(const f32x4*)(gain + c), g1 = *(const f32x4*)(gain + c + 4);
            f32x4 o0, o1;
#pragma unroll
            for (int j = 0; j < 4; ++j) { o0[j] = bf2f((bf16_t)v[j]) * sc * g0[j]; o1[j] = bf2f((bf16_t)v[4 + j]) * sc * g1[j]; }
            __builtin_nontemporal_store(o0, (f32x4*)(out + row * DM + c)); __builtin_nontemporal_store(o1, (f32x4*)(out + row * DM + c + 4)); }
    }
}
__device__ __forceinline__ void compress_out_phase(const Args& a, LAS unsigned char* lds) {
    const float* H = (const float*)(a.ws + WS_HID); bf16_t* kcb = (bf16_t*)(a.ws + WS_KCB); const float* w2 = a.in[14];
    LAS float* w2s = (LAS float*)lds;
    const int tid = threadIdx.x, wave = tid >> 6, lane = tid & 63;
    LAS float* hrow = w2s + 2 * 128 * 64 + wave * 128;
    for (int e = tid; e < 2 * 128 * 64; e += NTHREADS) w2s[e] = w2[e];
    __syncthreads();
    for (int r = blockIdx.x * 8 + wave; r < 2 * 16384; r += gridDim.x * 8) {
        const int j = r >> 14, row = r & 16383, i = (row >> 2) & 127;
        hrow[lane] = H[(size_t)r * 128 + lane]; hrow[lane + 64] = H[(size_t)r * 128 + 64 + lane];
        asm volatile("s_waitcnt lgkmcnt(0)" ::: "memory");
        float o = 0.f;
#pragma unroll 8
        for (int n = 0; n < 128; ++n) o += hrow[n] * w2s[(j * 128 + n) * 64 + lane];
        kcb[(size_t)r * 64 + lane] = (i == 127) ? (bf16_t)0 : f2bf(o);
        asm volatile("s_waitcnt lgkmcnt(0)" ::: "memory");
    }
    __syncthreads();
}
__device__ __forceinline__ int rel_bucket(int d) { if (d < 16) return d; const int l = 16 + (int)(logf((float)d / 16.0f) / 2.0794415416798357f * 16.0f); return l < 31 ? l : 31; }

typedef float f32x16 __attribute__((ext_vector_type(16)));
typedef short s16x4 __attribute__((ext_vector_type(4)));
typedef __bf16 bf16x2_t __attribute__((ext_vector_type(2)));
#define MFMA32(a, b, c) __builtin_amdgcn_mfma_f32_32x32x16_bf16((a), (b), (c), 0, 0, 0)
constexpr int TP = 144, TILE_B = 64 * TP;
constexpr int TABN = 336;
constexpr int AT_IMP = 4 * TILE_B, AT_SELM = AT_IMP + 4 * 64 * 33 * 4, AT_BTAB = AT_SELM + 256, AT_BUCK = AT_BTAB + TABN * 16, AT_OUT = AT_BUCK + 512, AT_END = AT_OUT + 8 * 8192;
constexpr float LOG2E = 1.4426950408889634f;
__device__ __forceinline__ unsigned pk2(float a, float b) { const f32x2 v = {a, b}; return __builtin_bit_cast(unsigned, __builtin_convertvector(v, bf16x2_t)); }
__device__ __forceinline__ int crow16(int i) { return (i & 3) + 8 * (i >> 2); }

__device__ __forceinline__ float xor32f(float v, int xaddr) { return __builtin_bit_cast(float, __builtin_amdgcn_ds_bpermute(xaddr, __builtin_bit_cast(int, v))); }
template <int CTRL> __device__ __forceinline__ unsigned dppu(unsigned v) { return (unsigned)__builtin_amdgcn_update_dpp(0, (int)v, CTRL, 0xf, 0xf, true); }
struct AttnState { f32x16 O[2]; float m, l; int xaddr; };

template <int BR, bool PASS2>
__device__ __forceinline__ void attn_block(LAS unsigned char* lds, int Kt, int Vt, int kpos0, bool selbit, const bf16x8 (&qf)[4], AttnState& st, int hh, int tq, int lane,
                                           float inv, LAS float* improw, float& eprev, int blk, bool win) {
    const int h = lane >> 5, l31 = lane & 31;
    const int tq0 = __builtin_amdgcn_readfirstlane(tq - l31);
    if (BR != 0) { if (tq0 + 31 < kpos0) return; if (win && tq0 - (kpos0 + 63) >= 512) return; }
    f32x16 S[2];
#pragma unroll
    for (int kb = 0; kb < 2; ++kb) {
#pragma unroll
        for (int i = 0; i < 16; ++i) S[kb][i] = 0.f;
#pragma unroll
        for (int s = 0; s < 4; ++s) { const bf16x8 kf = *(const LAS bf16x8*)(lds + Kt + (32 * kb + l31) * TP + (16 * s + 8 * h) * 2); S[kb] = MFMA32(kf, qf[s], S[kb]); }
    }
    const LAS float* btab = (const LAS float*)(lds + AT_BTAB);
    const bool fast = (BR != 0) && (tq0 - (kpos0 + 63) >= 113) && (!win || (tq0 + 31 - kpos0) <= 511);
    float mx = -INFINITY, cb = 0.f; const bool okl = (BR == 1) ? (selbit || win) : true;
    const bool nearp = (BR == 1) && !fast && (tq0 + 31 - kpos0) <= 271;
    if (fast) { cb = btab[(127 + 64) * 4 + hh]; float mr = S[0][0];
#pragma unroll
        for (int kb = 0; kb < 2; ++kb)
#pragma unroll
            for (int i = 0; i < 16; ++i) mr = fmaxf(mr, S[kb][i]);
        mx = okl ? __builtin_fmaf(mr, LOG2E, cb) : -INFINITY;
    } else if (nearp) {
        const LAS float* tb = btab + (tq - kpos0 - 4 * h + 64 - 59) * 4 + hh;
#pragma unroll
        for (int kb = 0; kb < 2; ++kb)
#pragma unroll
            for (int i0 = 0; i0 < 16; i0 += 8) { float bv[8];
#pragma unroll
                for (int e = 0; e < 8; ++e) bv[e] = tb[(59 - 32 * kb - crow16(i0 + e)) * 4];
                __builtin_amdgcn_sched_barrier(0);
#pragma unroll
                for (int e = 0; e < 8; ++e) { const float v = __builtin_fmaf(S[kb][i0 + e], LOG2E, bv[e]); S[kb][i0 + e] = v; mx = fmaxf(mx, v); }
                __builtin_amdgcn_sched_barrier(0); }
        mx = okl ? mx : -INFINITY;
    } else {
#pragma unroll
        for (int kb = 0; kb < 2; ++kb)
#pragma unroll
            for (int i0 = 0; i0 < 16; i0 += 8) {
                float bv[8]; float pen[8];
#pragma unroll
                for (int e = 0; e < 8; ++e) { const int i = i0 + e; const int kidx = kpos0 + 32 * kb + 4 * h + crow16(i); const int dist = tq - ((BR == 0) ? (16 * kidx + 31) : kidx);
                    const int dc = dist < -1 ? -1 : (dist > 127 ? 127 : dist);
                    bv[e] = btab[(dc + 64) * 4 + hh]; pen[e] = (BR == 1 && win && dist >= 512) ? -INFINITY : 0.f; }
                __builtin_amdgcn_sched_barrier(0);
#pragma unroll
                for (int e = 0; e < 8; ++e) { const int i = i0 + e; float v = __builtin_fmaf(S[kb][i], LOG2E, bv[e]); if (BR == 1) v += pen[e]; S[kb][i] = v; mx = fmaxf(mx, v); }
                __builtin_amdgcn_sched_barrier(0);
            }
        if (BR == 1) mx = okl ? mx : -INFINITY;
    }
    __builtin_amdgcn_sched_barrier(0);
    if (!PASS2) {
        mx = fmaxf(mx, xor32f(mx, st.xaddr));
        const float mnew = fmaxf(st.m, mx), muse = (mnew == -INFINITY) ? 0.f : mnew, alpha = __builtin_amdgcn_exp2f(st.m - muse);
        float ls = 0.f;
        if (fast) { const float cbm = okl ? (cb - muse) : -INFINITY;
#pragma unroll
            for (int kb = 0; kb < 2; ++kb)
#pragma unroll
                for (int i = 0; i < 16; ++i) { const float pv = __builtin_amdgcn_exp2f(__builtin_fmaf(S[kb][i], LOG2E, cbm)); S[kb][i] = pv; ls += pv; }
        } else { const float musel = (BR == 1 && !okl) ? INFINITY : muse;
#pragma unroll
            for (int kb = 0; kb < 2; ++kb)
#pragma unroll
                for (int i = 0; i < 16; ++i) { const float pv = __builtin_amdgcn_exp2f(S[kb][i] - musel); S[kb][i] = pv; ls += pv; }
        }
        st.l = st.l * alpha + ls; st.m = mnew;
        if (__builtin_amdgcn_ballot_w64(alpha != 1.0f) != 0ull) {
#pragma unroll
            for (int db = 0; db < 2; ++db)
#pragma unroll
                for (int i = 0; i < 16; ++i) st.O[db][i] *= alpha; }
        const int i16 = lane & 15, q4 = i16 >> 2, p4 = i16 & 3, b16 = (lane >> 4) & 1;
        LAS unsigned char* vbase = lds + Vt + (4 * h + q4) * TP + 32 * b16 + 8 * p4;
#pragma unroll
        for (int kb = 0; kb < 2; ++kb) {
            bf16x8 vf[2][2];
#pragma unroll
            for (int s2 = 0; s2 < 2; ++s2)
#pragma unroll
                for (int db = 0; db < 2; ++db) { LAS unsigned char* va = vbase + (32 * kb + 16 * s2) * TP + db * 64;
                    const s16x4 lo = __builtin_bit_cast(s16x4, __builtin_amdgcn_ds_read_tr16_b64_v4i16((LAS s16x4*)va));
                    const s16x4 hi = __builtin_bit_cast(s16x4, __builtin_amdgcn_ds_read_tr16_b64_v4i16((LAS s16x4*)(va + 8 * TP)));
                    vf[s2][db] = __builtin_shufflevector(lo, hi, 0, 1, 2, 3, 4, 5, 6, 7); }
            __builtin_amdgcn_sched_barrier(0);
#pragma unroll
            for (int s2 = 0; s2 < 2; ++s2) {
                u32x4 pw; pw.x = pk2(S[kb][8 * s2 + 0], S[kb][8 * s2 + 1]); pw.y = pk2(S[kb][8 * s2 + 2], S[kb][8 * s2 + 3]); pw.z = pk2(S[kb][8 * s2 + 4], S[kb][8 * s2 + 5]); pw.w = pk2(S[kb][8 * s2 + 6], S[kb][8 * s2 + 7]);
                const bf16x8 pf = __builtin_bit_cast(bf16x8, pw);
#pragma unroll
                for (int db = 0; db < 2; ++db) st.O[db] = MFMA32(vf[s2][db], pf, st.O[db]);
            }
            __builtin_amdgcn_sched_barrier(0);
        }
    } else {
        const float muse = (st.m == -INFINITY) ? 0.f : st.m;
#pragma unroll
        for (int kb = 0; kb < 2; ++kb)
#pragma unroll
            for (int gq = 0; gq < 4; ++gq) {
                const float p0 = __builtin_amdgcn_exp2f(S[kb][4 * gq] - muse) * inv, p1 = __builtin_amdgcn_exp2f(S[kb][4 * gq + 1] - muse) * inv,
                            p2 = __builtin_amdgcn_exp2f(S[kb][4 * gq + 2] - muse) * inv, p3 = __builtin_amdgcn_exp2f(S[kb][4 * gq + 3] - muse) * inv;
                const float esw = xor32f(p3, st.xaddr);
                const float val = ((p0 + p1) + (p2 + p3)) + (h ? esw : eprev);
                improw[16 * blk + 8 * kb + 2 * gq + h] = val; eprev = esw; }
    }
}

__device__ __forceinline__ void attn_mfma_phase(const Args& a, LAS unsigned char* lds) {
    const bf16_t* kv = (const bf16_t*)(a.ws + WS_KV); const bf16_t* qb_ = (const bf16_t*)(a.ws + WS_Q); const float* gate = (const float*)(a.ws + WS_GATE);
    const bf16_t* kcb = (const bf16_t*)(a.ws + WS_KCB); bf16_t* yo = (bf16_t*)(a.ws + WS_Y); const float* relb = a.in[17];
    int tid_ = threadIdx.x; asm volatile("" : "+v"(tid_));
    const int tid = tid_, wid = __builtin_amdgcn_readfirstlane(tid >> 6), lane = tid & 63, hh = wid >> 1, qh = wid & 1, h = lane >> 5, l31 = lane & 31;
    const int lkey = tid >> 3, lch = tid & 7;
    LAS int* buck = (LAS int*)(lds + AT_BUCK); LAS float* btab = (LAS float*)(lds + AT_BTAB); LAS unsigned* selm = (LAS unsigned*)(lds + AT_SELM); LAS float* imp = (LAS float*)(lds + AT_IMP);
    if (tid < 128) buck[tid] = rel_bucket(tid);
    __syncthreads();
    const int nitems = NB * 32 * 4;
    for (int it = blockIdx.x; it < nitems; it += gridDim.x) {
        const int qb = it >> 7, b = (it >> 2) & 31, g = it & 3, qs = 64 * qb, head = g * 4 + hh, tq = qs + 32 * qh + l31;
        const size_t rowq = (size_t)b * SEQ + tq;
        bf16x8 qf[4];
#pragma unroll
        for (int s = 0; s < 4; ++s) qf[s] = *(const bf16x8*)(qb_ + rowq * DM + head * 64 + 16 * s + 8 * h);
        const float* gp = gate + rowq * 48 + head * 3; const float g0 = gp[0], g1 = gp[1], g2 = gp[2];
        __syncthreads();
        for (int e = tid; e < TABN * 4; e += NTHREADS) { const int d = (e >> 2) - 64; btab[e] = d < 0 ? -INFINITY : relb[buck[d > 127 ? 127 : d] * 16 + g * 4 + (e & 3)] * LOG2E; }
        {
            const bf16_t* kc = kcb + (((size_t)b * 128) * 4 + g) * 64; const bf16_t* vc = kc + (size_t)NB * 128 * 4 * 64;
#pragma unroll
            for (int blk = 0; blk < 2; ++blk) { const u32x4 kx = *(const u32x4*)(kc + (size_t)(64 * blk + lkey) * 256 + lch * 8), vx = *(const u32x4*)(vc + (size_t)(64 * blk + lkey) * 256 + lch * 8);
                *(LAS u32x4*)(lds + blk * TILE_B + lkey * TP + lch * 16) = kx; *(LAS u32x4*)(lds + (2 + blk) * TILE_B + lkey * TP + lch * 16) = vx; }
        }
        __syncthreads();
        AttnState st; float edummy = 0.f; LAS unsigned char* outp = lds + AT_OUT + wid * 8192 + lane * 16;
#pragma unroll
        for (int db = 0; db < 2; ++db)
#pragma unroll
            for (int i = 0; i < 16; ++i) st.O[db][i] = 0.f;
        st.m = -INFINITY; st.l = 0.f; st.xaddr = (lane ^ 32) << 2;
#pragma nounroll
        for (int blk = 0; blk < (qb >= 16 ? 2 : 1); ++blk)
            attn_block<0, false>(lds, blk * TILE_B, (2 + blk) * TILE_B, 64 * blk, true, qf, st, hh, tq, lane, 0.f, nullptr, edummy, blk, false);
        {   const float lt = st.l + xor32f(st.l, st.xaddr), inv = lt > 0.f ? 1.0f / lt : 0.f, sc = g0 * inv;
#pragma unroll
            for (int db = 0; db < 2; ++db)
#pragma unroll
                for (int gq = 0; gq < 4; ++gq) { const f32x4 v = {st.O[db][4 * gq] * sc, st.O[db][4 * gq + 1] * sc, st.O[db][4 * gq + 2] * sc, st.O[db][4 * gq + 3] * sc};
                    *(LAS f32x4*)(outp + (db * 4 + gq) * 1024) = v; st.O[db][4 * gq] = 0.f; st.O[db][4 * gq + 1] = 0.f; st.O[db][4 * gq + 2] = 0.f; st.O[db][4 * gq + 3] = 0.f; }
            if (qb >= 16) { float ep = 0.f; LAS float* improw = imp + (hh * 64 + 32 * qh + l31) * 33;
#pragma nounroll
                for (int blk = 0; blk < 2; ++blk) attn_block<0, true>(lds, blk * TILE_B, (2 + blk) * TILE_B, 64 * blk, true, qf, st, hh, tq, lane, inv, improw, ep, blk, false); }
            st.m = -INFINITY; st.l = 0.f; }
        __syncthreads();
        if (qb >= 16) {
            {
                const int q = tid >> 3, j0 = (tid & 7) * 4;
#pragma unroll
                for (int u = 0; u < 4; ++u) { const int j = j0 + u; imp[q * 33 + j] = (imp[(0 * 64 + q) * 33 + j] + imp[(1 * 64 + q) * 33 + j]) + (imp[(2 * 64 + q) * 33 + j] + imp[(3 * 64 + q) * 33 + j]); }
            }
            __syncthreads();
            const int q = tid >> 3, sub = tid & 7; unsigned mk = 0u;
            for (int u = 0; u < 4; ++u) { const int s = 4 * sub + u; const float mine = imp[q * 33 + s];
                int rank = 0;
                for (int j = 1; j < 32; ++j) { const float ij = imp[q * 33 + j]; const bool cj = (j < qb - 1); if (cj && (ij > mine || (ij == mine && j < s))) ++rank; }
                const bool forced = (s == 0) || (s == qb) || (s == qb - 1); if (forced || (s <= qb && rank < 13)) mk |= 1u << s; }
            mk |= dppu<0xB1>(mk); mk |= dppu<0x4E>(mk); mk |= dppu<0x141>(mk);
            if (sub == 0) selm[q] = mk;
        } else if (tid < 64) selm[tid] = (qb >= 31) ? 0xffffffffu : ((2u << qb) - 1u);
        __syncthreads();
        const unsigned mysel = selm[32 * qh + l31];
        const int nsel = qb + 1, wlo = qb > 8 ? qb - 8 : 0, nstep = nsel + (qb - wlo + 1);
        const bf16_t* kvb = kv + (size_t)b * SEQ * NKV + g * 64;
        u32x4 kx, vx;
        { const bf16_t* r0 = kvb + (size_t)(0 + lkey) * NKV + lch * 8; kx = *(const u32x4*)(r0 + 2 * 256); vx = *(const u32x4*)(r0 + 3 * 256); }
        *(LAS u32x4*)(lds + 0 * TILE_B + lkey * TP + lch * 16) = kx; *(LAS u32x4*)(lds + 2 * TILE_B + lkey * TP + lch * 16) = vx;
        __syncthreads();
        for (int k = 0; k < nstep; ++k) {
            const int buf = k & 1;
            if (k + 1 < nstep) { const int k1 = k + 1, isw = k1 >= nsel, jb1 = isw ? wlo + (k1 - nsel) : k1; const bf16_t* r0 = kvb + (size_t)(64 * jb1 + lkey) * NKV + lch * 8 + (isw ? 4 * 256 : 2 * 256);
                kx = *(const u32x4*)r0; vx = *(const u32x4*)(r0 + 256); }
            if (k == nsel) {
                const float lt = st.l + xor32f(st.l, st.xaddr), sc = g1 / lt;
#pragma unroll
                for (int db = 0; db < 2; ++db)
#pragma unroll
                    for (int gq = 0; gq < 4; ++gq) { f32x4 v = *(LAS f32x4*)(outp + (db * 4 + gq) * 1024);
                        v[0] += st.O[db][4 * gq] * sc; v[1] += st.O[db][4 * gq + 1] * sc; v[2] += st.O[db][4 * gq + 2] * sc; v[3] += st.O[db][4 * gq + 3] * sc;
                        *(LAS f32x4*)(outp + (db * 4 + gq) * 1024) = v; st.O[db][4 * gq] = 0.f; st.O[db][4 * gq + 1] = 0.f; st.O[db][4 * gq + 2] = 0.f; st.O[db][4 * gq + 3] = 0.f; }
                st.m = -INFINITY; st.l = 0.f; }
            { const bool isw = k >= nsel; const int jbk = isw ? wlo + k - nsel : k;
              attn_block<1, false>(lds, buf * TILE_B, (2 + buf) * TILE_B, 64 * jbk, (mysel >> (jbk & 31)) & 1u, qf, st, hh, tq, lane, 0.f, nullptr, edummy, 0, isw); }
            if (k + 1 < nstep) { *(LAS u32x4*)(lds + (buf ^ 1) * TILE_B + lkey * TP + lch * 16) = kx; *(LAS u32x4*)(lds + (2 + (buf ^ 1)) * TILE_B + lkey * TP + lch * 16) = vx; }
            __syncthreads();
        }
        {   const float lt = st.l + xor32f(st.l, st.xaddr), sc = g2 / lt;
            u32x2 w[2][4];
#pragma unroll
            for (int db = 0; db < 2; ++db)
#pragma unroll
                for (int gq = 0; gq < 4; ++gq) { const f32x4 v = *(LAS f32x4*)(outp + (db * 4 + gq) * 1024);
                    w[db][gq].x = pk2(v[0] + st.O[db][4 * gq] * sc, v[1] + st.O[db][4 * gq + 1] * sc); w[db][gq].y = pk2(v[2] + st.O[db][4 * gq + 2] * sc, v[3] + st.O[db][4 * gq + 3] * sc); }
            LAS unsigned char* tp = lds + AT_OUT + wid * 8192;
#pragma unroll
            for (int db = 0; db < 2; ++db)
#pragma unroll
                for (int gq = 0; gq < 4; ++gq) *(LAS u32x2*)(tp + l31 * TP + (32 * db + 8 * gq + 4 * h) * 2) = w[db][gq];
            asm volatile("s_waitcnt lgkmcnt(0)" ::: "memory");
            bf16_t* obase = yo + ((size_t)b * SEQ + qs + 32 * qh) * DM + head * 64;
#pragma unroll
            for (int it = 0; it < 4; ++it) { const int r = (lane >> 3) + 8 * it, ch = lane & 7; const u32x4 v = *(const LAS u32x4*)(tp + r * TP + ch * 16); *(u32x4*)(obase + (size_t)r * DM + ch * 8) = v; }
        }
    }
    __syncthreads();
}

#define XB_TMO      128
#define XB_XCNT(j)  (256  + 64 * (j))
#define XB_XSUB(j)  (1280 + 64 * (j))
#define XB_XGEN(j)  (2304 + 64 * (j))
#define XB_TOP      3328
#define XB_TOPGEN   3392
#define XCD_BAR_WORDS 3456
#define XB_SPIN_CAP (1u << 18)
__device__ __forceinline__ unsigned xb_ld(unsigned* p)              { return __hip_atomic_load(p, __ATOMIC_RELAXED, __HIP_MEMORY_SCOPE_AGENT); }
__device__ __forceinline__ unsigned xb_add(unsigned* p, unsigned v) { return __hip_atomic_fetch_add(p, v, __ATOMIC_RELAXED, __HIP_MEMORY_SCOPE_AGENT); }
__device__ __forceinline__ unsigned xb_xcc_id() { return (unsigned)__builtin_amdgcn_s_getreg((3 << 11) | 20) & 0xFu; }
#define XB_SPIN(cond, bar) do { unsigned _sp = 0; while (cond) { __builtin_amdgcn_s_sleep(1); \
    if ((++_sp & 255u) == 0u) { if (xb_ld(&(bar)[XB_TMO])) break; if (_sp > XB_SPIN_CAP) { atomicAdd(&(bar)[XB_TMO], 1u); break; } } } } while (0)
struct XcdBarrier { unsigned* bar; unsigned x; volatile LAS unsigned* st; };
__device__ __forceinline__ XcdBarrier xcd_barrier_post(unsigned* bar, volatile LAS unsigned* st) {
    XcdBarrier b; b.bar = bar; b.x = xb_xcc_id(); b.st = st;
    if (threadIdx.x == 0) (void)xb_add(&bar[XB_XCNT(b.x)], 1u);
    return b;
}
__device__ __forceinline__ void xcd_barrier_complete(unsigned* bar, unsigned x, unsigned& nloc, unsigned& nx) {
    const unsigned G = gridDim.x * gridDim.y * gridDim.z;
    unsigned sum, cnt, mine, sp = 0u;
    for (;;) {
        sum = 0u; cnt = 0u; mine = 0u;
#pragma unroll
        for (unsigned j = 0; j < 16; ++j) { const unsigned c = xb_ld(&bar[XB_XCNT(j)]); sum += c; cnt += (c > 0u) ? 1u : 0u; mine = (j == x) ? c : mine; }
        if (sum == G) break;
        __builtin_amdgcn_s_sleep(1);
        if ((++sp & 255u) == 0u) { if (xb_ld(&bar[XB_TMO])) break; if (sp > XB_SPIN_CAP) { atomicAdd(&bar[XB_TMO], 1u); break; } }
    }
    nloc = mine > 0u ? mine : 1u; nx = cnt > 0u ? cnt : 1u;
}
__device__ __forceinline__ void xcd_barrier(const XcdBarrier& b) {
    asm volatile("s_waitcnt vmcnt(0)" ::: "memory");
    __syncthreads();
    if (threadIdx.x == 0) {
        unsigned* bar = b.bar;
        __builtin_amdgcn_s_waitcnt(0);
        unsigned nloc = b.st[0], nx = b.st[1];
        if (nloc == 0u) { xcd_barrier_complete(bar, b.x, nloc, nx); b.st[0] = nloc; b.st[1] = nx; }
        const unsigned old = xb_add(&bar[XB_XSUB(b.x)], 1u);
        const unsigned gen = old / nloc;
        if (old + 1u == (gen + 1u) * nloc) {
            __builtin_amdgcn_fence(__ATOMIC_RELEASE, "agent");
            asm volatile("s_waitcnt vmcnt(0)" ::: "memory");
            const unsigned og = xb_add(&bar[XB_TOP], 1u);
            const unsigned tg = og / nx;
            if (og + 1u == (tg + 1u) * nx) xb_add(&bar[XB_TOPGEN], 1u);
            else XB_SPIN(xb_ld(&bar[XB_TOPGEN]) == tg, bar);
            __builtin_amdgcn_fence(__ATOMIC_ACQUIRE, "agent");
            xb_add(&bar[XB_XGEN(b.x)], 1u);
            asm volatile("s_waitcnt vmcnt(0)" ::: "memory");
        } else {
            XB_SPIN(xb_ld(&bar[XB_XGEN(b.x)]) == gen, bar);
            __builtin_amdgcn_fence(__ATOMIC_ACQUIRE, "agent");
            asm volatile("s_waitcnt vmcnt(0)" ::: "memory");
        }
    }
    __syncthreads();
}

enum { PH_WPREP = 0, PH_XPREP, PH_INCV, PH_INB, PH_OUTPROJ, PH_UP0, PH_DN0, PH_KVQG, PH_CMP, PH_CMP2, PH_ATTN, PH_WO, PH_UP1, PH_DN1, PH_FINAL, PH_COUNT };

__global__ void __launch_bounds__(NTHREADS, 2) mk_fwd(Args a) {
    extern __shared__ __attribute__((aligned(16))) unsigned char lds_raw[];
    LAS unsigned char* lds = (LAS unsigned char*)lds_raw;
    LAS float* exch = (LAS float*)(lds + 131072); LAS float* epc = (LAS float*)(lds + EPC_OFF);
    unsigned char* ws = a.ws;
    const int G = gridDim.x, bx = blockIdx.x;
    const float* x_in = a.in[0]; float* xo = a.out;
    bf16_t* HB = (bf16_t*)(ws + WS_HB); bf16_t* ACT = (bf16_t*)(ws + WS_BIG); bf16_t* Y = (bf16_t*)(ws + WS_Y); bf16_t* CVC = (bf16_t*)(ws + WS_RAW);
    float* RS = (float*)(ws + WS_RS); float* SSP = (float*)(ws + WS_SSP);
    const int lo = a.ph_lo, hi = a.ph_hi;
#define IN(k) (lo <= (k) && (k) < hi)
    volatile LAS unsigned* xst = (volatile LAS unsigned*)(lds + 147456);
    if (threadIdx.x < 4) xst[threadIdx.x] = 0u;
    __syncthreads();
    const XcdBarrier xbar = xcd_barrier_post((unsigned*)(ws + WS_BAR), xst);
#define SEAM(k) do { if (IN(k) && IN((k) + 1)) xcd_barrier(xbar); } while (0)
    if (hi < 0) cg::this_grid().sync();

    if (IN(PH_WPREP)) wprep_phase(a, lds);
    if (IN(PH_XPREP)) rowstat_phase(x_in, HB, RS, 0, MROWS);
    SEAM(PH_XPREP);
    if (IN(PH_INCV)) { pg8::Gemm g = pg8::dense(HB, (const bf16_t*)(ws + WS_WIN), MROWS, 2048, 1024); g.aperm = 1; pg8::ChainOrder S; S.init(8, G, bx);
        pg8::EpiConvPair<1, false> E{RS, a.in[3], DM, 0, CVC, DM, exch, epc}; pg8::gemm_phase(lds, g, S, E); }
    SEAM(PH_INCV);
    if (IN(PH_INB)) { const pg8::Gemm g = pg8::dense(HB, (const bf16_t*)(ws + WS_WIN) + (size_t)2048 * 1024, MROWS, 1024, 1024); pg8::StaticOrder S; S.init(MROWS, 1024, G, bx);
        pg8::EpiMulB E{RS, CVC, Y}; pg8::gemm_phase(lds, g, S, E); }
    SEAM(PH_INB);
    if (IN(PH_OUTPROJ)) { const pg8::Gemm g = pg8::dense(Y, (const bf16_t*)(ws + WS_WOUT), MROWS, 1024, 1024); pg8::StaticOrder S; S.init(MROWS, 1024, G, bx);
        pg8::EpiResid<true, false> E{x_in, HB, nullptr, SSP}; pg8::gemm_phase(lds, g, S, E); }
    SEAM(PH_OUTPROJ);
    if (IN(PH_UP0)) { pg8::Gemm g = pg8::dense(HB, (const bf16_t*)(ws + WS_WUP0), MROWS, 5632, 1024); g.aperm = 1; pg8::ChainOrder S; S.init(22, G, bx);
        pg8::EpiConvPair<0, true> E{SSP, a.in[7], 5632, DFF, ACT, DFF, exch, epc}; pg8::gemm_phase(lds, g, S, E); }
    SEAM(PH_UP0);
    if (IN(PH_DN0)) { const pg8::Gemm g = pg8::dense(ACT, (const bf16_t*)(ws + WS_WDN0), MROWS, 1024, 2816); pg8::StaticOrder S; S.init(MROWS, 1024, G, bx);
        pg8::EpiResid<false, false> E{nullptr, HB, nullptr, SSP}; pg8::gemm_phase(lds, g, S, E); }
    SEAM(PH_DN0);
    if (IN(PH_KVQG)) { const pg8::Gemm g = pg8::dense(HB, (const bf16_t*)(ws + WS_WKVQG), MROWS, NKVQG, 1024); pg8::StaticOrder S; S.init(MROWS, NKVQG, G, bx);
        pg8::EpiKVQG E{SSP, (bf16_t*)(ws + WS_KV), (bf16_t*)(ws + WS_Q), (float*)(ws + WS_GATE)}; pg8::gemm_phase(lds, g, S, E); }
    SEAM(PH_KVQG);
    if (IN(PH_CMP)) { pg8::Gemm g = pg8::dense((const bf16_t*)(ws + WS_KV), (const bf16_t*)(ws + WS_W1T), 16384, 512, 2048);
        g.amode = 1; g.a_kstep = (size_t)NKV * 2; g.a_hstep = (size_t)32 * 16 * NKV * 2; g.a_tstep = (size_t)1024 * NKV * 2; g.a_pnstep = 512;
        pg8::StaticOrder S; S.init(16384, 512, G, bx); pg8::EpiCmpHidden E{(const float*)(ws + WS_B1F), (float*)(ws + WS_HID)}; pg8::gemm_phase(lds, g, S, E); }
    SEAM(PH_CMP);
    if (IN(PH_CMP2)) compress_out_phase(a, lds);
    SEAM(PH_CMP2);
    if (IN(PH_ATTN)) attn_mfma_phase(a, lds);
    SEAM(PH_ATTN);
    if (IN(PH_WO)) { const pg8::Gemm g = pg8::dense(Y, (const bf16_t*)(ws + WS_WO), MROWS, 1024, 1024); pg8::StaticOrder S; S.init(MROWS, 1024, G, bx);
        pg8::EpiResid<false, false> E{nullptr, HB, nullptr, SSP}; pg8::gemm_phase(lds, g, S, E); }
    SEAM(PH_WO);
    if (IN(PH_UP1)) { pg8::Gemm g = pg8::dense(HB, (const bf16_t*)(ws + WS_WUP1), MROWS, 5632, 1024); g.aperm = 1; pg8::ChainOrder S; S.init(22, G, bx);
        pg8::EpiConvPair<0, true> E{SSP, a.in[7] + 3 * 5632, 5632, DFF, ACT, DFF, exch, epc}; pg8::gemm_phase(lds, g, S, E); }
    SEAM(PH_UP1);
    if (IN(PH_DN1)) { const pg8::Gemm g = pg8::dense(ACT, (const bf16_t*)(ws + WS_WDN1), MROWS, 1024, 2816); pg8::StaticOrder S; S.init(MROWS, 1024, G, bx);
        pg8::EpiResid<false, false> E{nullptr, HB, nullptr, SSP}; pg8::gemm_phase(lds, g, S, E); }
    SEAM(PH_DN1);
    if (IN(PH_FINAL)) final_phase(xo, HB, SSP, a.in[18], 0, MROWS);
#undef IN
#undef SEAM
}

extern "C" void kernel_launch(void* const* d_in, const int* in_sizes, int n_in, void* d_out, int out_size, void* d_ws, size_t ws_size, hipStream_t stream) {
    static int grid = 0;
    if (grid == 0) {
        if (n_in != 19 || ws_size < WS_END) { fprintf(stderr, "kernel_launch: unexpected shapes (n_in %d, ws %zu < %zu)\n", n_in, ws_size, (size_t)WS_END); grid = -1; return; }
        int dev = 0, cus = 0;
        (void)hipGetDevice(&dev); (void)hipDeviceGetAttribute(&cus, hipDeviceAttributeMultiprocessorCount, dev);
        if (hipFuncSetAttribute((const void*)mk_fwd, hipFuncAttributeMaxDynamicSharedMemorySize, LDS_BYTES) != hipSuccess) { fprintf(stderr, "kernel_launch: hipFuncSetAttribute failed\n"); grid = -1; return; }
        int per_cu = 0;
        if (hipOccupancyMaxActiveBlocksPerMultiprocessor(&per_cu, (const void*)mk_fwd, NTHREADS, LDS_BYTES) != hipSuccess || per_cu < 1) per_cu = 1;
        (void)hipGetLastError();
        grid = (cus > 0 ? cus : 256) * per_cu;
    }
    if (grid < 0) return;
    Args a{};
    for (int i = 0; i < 19; ++i) a.in[i] = (const float*)d_in[i];
    a.out = (float*)d_out; a.ws = (unsigned char*)d_ws;
    (void)hipMemsetAsync((unsigned char*)d_ws + WS_BAR, 0, 16384, stream);
    a.ph_lo = 0; a.ph_hi = PH_COUNT;
    void* kargs[] = {&a};
    hipError_t e = hipLaunchCooperativeKernel((const void*)mk_fwd, dim3(grid), dim3(NTHREADS), kargs, LDS_BYTES, stream);
    if (e != hipSuccess) fprintf(stderr, "cooperative launch failed: %s (grid %d)\n", hipGetErrorString(e), grid);
}
```

```cpp
#include <hip/hip_runtime.h>
#include <hip/hip_cooperative_groups.h>
#include <cstdio>
#include <type_traits>
namespace cg = cooperative_groups;

#define LAS __attribute__((address_space(3)))
typedef unsigned short bf16_t;
typedef short bf16x8 __attribute__((ext_vector_type(8)));
typedef float f32x4 __attribute__((ext_vector_type(4)));
typedef float f32x2 __attribute__((ext_vector_type(2)));
typedef unsigned u32x4 __attribute__((ext_vector_type(4)));
typedef unsigned u32x2 __attribute__((ext_vector_type(2)));

constexpr int NB = 32, SEQ = 2048, DM = 1024, DFF = 2816, MROWS = NB * SEQ;
constexpr int NKV = 1536, NQG = 1072, NKVQG = 2816, NCMP = 127;
constexpr int NTHREADS = 512;
constexpr int EPC_OFF = 147456 + 16, LDS_BYTES = EPC_OFF + 8192;

constexpr size_t WS_WIN = 0;
constexpr size_t WS_WOUT = WS_WIN + (size_t)3072 * 1024 * 2;
constexpr size_t WS_WUP0 = WS_WOUT + (size_t)1024 * 1024 * 2;
constexpr size_t WS_WUP1 = WS_WUP0 + (size_t)5632 * 1024 * 2;
constexpr size_t WS_WDN0 = WS_WUP1 + (size_t)5632 * 1024 * 2;
constexpr size_t WS_WDN1 = WS_WDN0 + (size_t)1024 * 2816 * 2;
constexpr size_t WS_WKVQG = WS_WDN1 + (size_t)1024 * 2816 * 2;
constexpr size_t WS_WO = WS_WKVQG + (size_t)2816 * 1024 * 2;
constexpr size_t WS_W1T = WS_WO + (size_t)1024 * 1024 * 2;
constexpr size_t WS_B1F = WS_W1T + (size_t)2 * 256 * 2048 * 2;
constexpr size_t WS_HB = 56ull << 20;
constexpr size_t WS_BIG = WS_HB + (size_t)MROWS * 1024 * 2;
constexpr size_t WS_KV = WS_BIG;
constexpr size_t WS_Q = WS_BIG + (size_t)MROWS * NKV * 2;
constexpr size_t WS_Y = WS_BIG + (size_t)MROWS * DFF * 2;
constexpr size_t WS_RAW = WS_Y + (size_t)MROWS * 1024 * 2;
constexpr size_t WS_GATE = WS_RAW + (size_t)16384 * 5632 * 2;
constexpr size_t WS_KCMP = WS_GATE + (size_t)MROWS * 48 * 4;
constexpr size_t WS_RS = WS_KCMP + (size_t)2 * 32 * 128 * 4 * 64 * 4;
constexpr size_t WS_KCB = WS_RS + (size_t)MROWS * 4;
constexpr size_t WS_HID = WS_KCB + (size_t)2 * 32 * 128 * 4 * 64 * 2;
constexpr size_t WS_SSP = WS_HID + (size_t)2 * 16384 * 128 * 4;
constexpr size_t WS_BAR = WS_SSP + (size_t)MROWS * 16 * 4;
constexpr size_t WS_END = WS_BAR + 16384;

__device__ __forceinline__ float bf2f(bf16_t b) { return __uint_as_float(((unsigned)b) << 16); }
__device__ __forceinline__ bf16_t f2bf(float f) { unsigned u = __float_as_uint(f); u += 0x7fffu + ((u >> 16) & 1u); return (bf16_t)(u >> 16); }
__device__ __forceinline__ unsigned cvt_pk_bf16(float lo, float hi) { unsigned r; asm volatile("v_cvt_pk_bf16_f32 %0, %1, %2" : "=v"(r) : "v"(lo), "v"(hi)); return r; }
__device__ __forceinline__ float wave_sum(float v) { for (int o = 32; o >= 1; o >>= 1) v += __shfl_xor(v, o); return v; }
__device__ __forceinline__ float wave_max(float v) { for (int o = 32; o >= 1; o >>= 1) v = fmaxf(v, __shfl_xor(v, o)); return v; }

__device__ __forceinline__ float gelu_tanh(float x) { const float u = 0.7978845608028654f * (x + 0.044715f * x * x * x); return 0.5f * x * (1.0f + tanhf(u)); }
struct Args { const float* in[19]; float* out; unsigned char* ws; int ph_lo, ph_hi, seq0, nseq, nchunk, pad; };

namespace pg8 {
constexpr int BM = 256, BK = 64, HALF = 128, HTB = HALF * BK * 2, STAGE_BYTES = 8 * HTB, NXCD = 8, WGM = 8;
__host__ __device__ __forceinline__ int lds_byte(int r, int c) { const int st = (r >> 4) * 2 + (c >> 5), rr = r & 15, cc = c & 31, ob = rr * 64 + cc * 2; return st * 1024 + (ob ^ (((ob >> 9) & 1) << 5)); }
__host__ __device__ __forceinline__ void stage_rc(int b, int& R, int& C) { const int st = b / 1024, sb = b % 1024, swz = sb ^ (((sb >> 9) & 1) << 5); R = (st >> 1) * 16 + swz / 64; C = (st & 1) * 32 + (swz % 64) / 2; }
__host__ __device__ __forceinline__ int perm32(int rho) { const int n = rho >> 4, i = rho & 15; return 8 * (i >> 2) + 4 * n + (i & 3); }
struct Unit { int pm, pn; };
struct Gemm { const bf16_t* A; const bf16_t* Bt; int M, N, K; int amode, aperm; size_t a_kstep, a_hstep, a_tstep, a_pnstep; };
__device__ __forceinline__ Gemm dense(const bf16_t* A, const bf16_t* Bt, int M, int N, int K) { Gemm g; g.A = A; g.Bt = Bt; g.M = M; g.N = N; g.K = K; g.amode = 0; g.aperm = 0; g.a_kstep = 128; g.a_hstep = (size_t)128 * K * 2; g.a_tstep = (size_t)256 * K * 2; g.a_pnstep = 0; return g; }
struct StaticOrder {
    int nM, nN, nwg, G, c;
    __device__ void init(int M, int N, int G_, int c_) { nM = M / BM; nN = N / BM; nwg = nM * nN; G = G_; c = c_; }
    __device__ bool next(int i, Unit& u) const {
        const long L = (long)i * G + c; if (L >= nwg) return false;
        int wgid = (int)L; { const int q = nwg / NXCD, r = nwg % NXCD, xcd = wgid % NXCD, off = wgid / NXCD; wgid = (xcd < r ? xcd * (q + 1) : r * (q + 1) + (xcd - r) * q) + off; }
        const int nig = WGM * nN, gid = wgid / nig, fm = gid * WGM, gsz = (nM - fm) < WGM ? (nM - fm) : WGM;
        u.pm = fm + ((wgid % nig) % gsz); u.pn = (wgid % nig) / gsz; return true;
    }
};

__device__ __forceinline__ float row_scale16(const float* ssp, int row, int fq) {
    const f32x4 p = *(const f32x4*)(ssp + (size_t)row * 16 + 4 * fq); float s = (p[0] + p[1]) + (p[2] + p[3]);
    s += __shfl_xor(s, 16); s += __shfl_xor(s, 32); return rsqrtf(s * (1.0f / DM) + 1e-6f); }
template <bool BASE_F32, bool OUT_F32> struct EpiResid {
    static constexpr bool PERM = true;
    const float* base32; bf16_t* xb; float* out32; float* ssp;
    __device__ __forceinline__ void operator()(f32x4 (&acc)[2][2][4][2], const Unit& u, int ui, int wr, int wc, int fr, int fq) const {
        const int row0 = u.pm * BM + wr * 64 + fr, col0 = u.pn * BM + wc * 32 + 8 * fq;
#pragma unroll
        for (int ai = 0; ai < 2; ++ai) {
            u32x4 bb[4][2]; f32x4 bf[4][2][2];
#pragma unroll
            for (int m = 0; m < 4; ++m)
#pragma unroll
                for (int bj = 0; bj < 2; ++bj) { const size_t o = (size_t)(row0 + ai * HALF + m * 16) * DM + col0 + bj * HALF;
                    if (BASE_F32) { bf[m][bj][0] = *(const f32x4*)(base32 + o); bf[m][bj][1] = *(const f32x4*)(base32 + o + 4); } else bb[m][bj] = *(const u32x4*)(xb + o); }
            __builtin_amdgcn_sched_barrier(0);
#pragma unroll
            for (int m = 0; m < 4; ++m) { const int row = row0 + ai * HALF + m * 16; const size_t off = (size_t)row * DM + col0; float ss = 0.f;
#pragma unroll
                for (int bj = 0; bj < 2; ++bj) { const size_t o = off + bj * HALF; f32x4 v0, v1;
                    if (BASE_F32) { v0 = bf[m][bj][0]; v1 = bf[m][bj][1]; }
                    else { const u32x4 b = bb[m][bj];
                        v0 = (f32x4){__uint_as_float(b.x << 16), __uint_as_float(b.x & 0xffff0000u), __uint_as_float(b.y << 16), __uint_as_float(b.y & 0xffff0000u)};
                        v1 = (f32x4){__uint_as_float(b.z << 16), __uint_as_float(b.z & 0xffff0000u), __uint_as_float(b.w << 16), __uint_as_float(b.w & 0xffff0000u)}; }
                    v0 += acc[ai][bj][m][0]; v1 += acc[ai][bj][m][1];
                    ss += ((v0[0] * v0[0] + v0[1] * v0[1]) + (v0[2] * v0[2] + v0[3] * v0[3])) + ((v1[0] * v1[0] + v1[1] * v1[1]) + (v1[2] * v1[2] + v1[3] * v1[3]));
                    if (OUT_F32) { *(f32x4*)(out32 + o) = v0; *(f32x4*)(out32 + o + 4) = v1; }
                    else { u32x4 w; w.x = cvt_pk_bf16(v0[0], v0[1]); w.y = cvt_pk_bf16(v0[2], v0[3]); w.z = cvt_pk_bf16(v1[0], v1[1]); w.w = cvt_pk_bf16(v1[2], v1[3]); *(u32x4*)(xb + o) = w; } }
                if (!OUT_F32) { ss += __shfl_xor(ss, 16); ss += __shfl_xor(ss, 32); if (fq == 0) ssp[(size_t)row * 16 + u.pn * 4 + wc] = ss; } }
        }
    }
};
struct EpiKVQG {
    static constexpr bool PERM = true;
    const float* ssp; bf16_t* kv; bf16_t* q; float* gate;
    __device__ __forceinline__ void operator()(f32x4 (&acc)[2][2][4][2], const Unit& u, int ui, int wr, int wc, int fr, int fq) const {
        const int row0 = u.pm * BM + wr * 64 + fr, cin = wc * 32 + 8 * fq;
        float rsc[2][4];
#pragma unroll
        for (int ai = 0; ai < 2; ++ai)
#pragma unroll
            for (int m = 0; m < 4; ++m) rsc[ai][m] = row_scale16(ssp, row0 + ai * HALF + m * 16, fq);
#pragma unroll
        for (int ai = 0; ai < 2; ++ai)
#pragma unroll
            for (int m = 0; m < 4; ++m) { const int row = row0 + ai * HALF + m * 16; const float s = rsc[ai][m];
#pragma unroll
                for (int bj = 0; bj < 2; ++bj) { f32x4 v0 = acc[ai][bj][m][0] * s, v1 = acc[ai][bj][m][1] * s; const int col = cin + bj * HALF;
                    if (u.pn < 6) { u32x4 w; w.x = cvt_pk_bf16(v0[0], v0[1]); w.y = cvt_pk_bf16(v0[2], v0[3]); w.z = cvt_pk_bf16(v1[0], v1[1]); w.w = cvt_pk_bf16(v1[2], v1[3]);
                        *(u32x4*)(kv + (size_t)row * NKV + u.pn * BM + col) = w; }
                    else if (u.pn < 10) { v0 *= 0.125f; v1 *= 0.125f; u32x4 w; w.x = cvt_pk_bf16(v0[0], v0[1]); w.y = cvt_pk_bf16(v0[2], v0[3]); w.z = cvt_pk_bf16(v1[0], v1[1]); w.w = cvt_pk_bf16(v1[2], v1[3]);
                        *(u32x4*)(q + (size_t)row * DM + (u.pn - 6) * BM + col) = w; }
                    else if (col < 48) { f32x4 g0, g1;
#pragma unroll
                        for (int j = 0; j < 4; ++j) { g0[j] = 1.0f / (1.0f + __expf(-v0[j])); g1[j] = 1.0f / (1.0f + __expf(-v1[j])); }
                        *(f32x4*)(gate + (size_t)row * 48 + col) = g0; *(f32x4*)(gate + (size_t)row * 48 + col + 4) = g1; } } }
    }
};

struct ChainOrder {
    int nP, nchain_x, G8, xcd, slot; bool live;
    __device__ void init(int nP_, int G, int c) { nP = nP_; G8 = G / 8; xcd = c % 8; slot = c / 8; nchain_x = (NB / 8) * nP; live = c < 8 * G8; }
    __device__ bool next(int i, Unit& u) const {
        const int ci = i >> 3, w = i & 7, Lx = ci * G8 + slot; if (!live || Lx >= nchain_x) return false;
        const int seq = (Lx & 3) * 8 + xcd; u.pn = Lx >> 2; u.pm = seq * 8 + w; return true; }
};
template <int CTRL> __device__ __forceinline__ float dppf(float old, float src) {
    return __builtin_bit_cast(float, __builtin_amdgcn_update_dpp(__builtin_bit_cast(int, old), __builtin_bit_cast(int, src), CTRL, 0xf, 0xf, false)); }

template <int MODE, bool SSP> struct EpiConvPair {
    static constexpr bool PERM = true;
    const float* rs; const float* cw; int cw_ld, goff; bf16_t* O; int ldo; LAS float* exch; LAS float* cache;
    struct Pref { f32x4 w; f32x4 p0, p1; };
    __device__ __forceinline__ void issue(const Unit& nu, Pref& r) const {
        const int tid = threadIdx.x; r.w = (f32x4){0.f, 0.f, 0.f, 0.f};
        if (tid < (MODE == 0 ? 192 : 96)) { const int tt = tid >> 5, type = tt / 3, tap = tt % 3; r.w = *(const f32x4*)(cw + (size_t)tap * cw_ld + type * goff + nu.pn * HALF + (tid & 31) * 4); }
        const size_t row = (size_t)nu.pm * BM + (tid >> 1);
        if (SSP) { r.p0 = *(const f32x4*)(rs + row * 16 + 8 * (tid & 1)); r.p1 = *(const f32x4*)(rs + row * 16 + 8 * (tid & 1) + 4); } else { r.p0 = (f32x4){rs[row], 0.f, 0.f, 0.f}; r.p1 = r.p0; }
    }
    __device__ __forceinline__ void commit(int par, const Pref& r) const {
        const int tid = threadIdx.x; LAS float* c = cache + par * 1024;
        if (tid < (MODE == 0 ? 192 : 96)) *(LAS f32x4*)(c + (tid >> 5) * 128 + (tid & 31) * 4) = r.w;
        float sc;
        if (SSP) { float ss = ((r.p0[0] + r.p0[1]) + (r.p0[2] + r.p0[3])) + ((r.p1[0] + r.p1[1]) + (r.p1[2] + r.p1[3])); ss += dppf<0xB1>(0.f, ss); sc = rsqrtf(ss * (1.0f / DM) + 1e-6f); } else sc = r.p0[0];
        if ((tid & 1) == 0) c[768 + (tid >> 1)] = sc;
    }
    __device__ __forceinline__ void pre(const Unit& u) const { Pref r; issue(u, r); commit(0, r); }
    __device__ __forceinline__ void run(f32x4 (&acc)[2][2][4][2], const Unit& u, int ui, int wr, int wc, int fr, int fq, bool has_next, const Unit& nu) const {
        Pref pf; if (has_next) issue(nu, pf);
        const LAS float* cc = cache + (ui & 1) * 1024;
        const int row0 = u.pm * BM + wr * 64 + 4 * fr, lcol = wc * 32 + 8 * fq, lrow0 = wr * 64 + 4 * fr;
#pragma unroll
        for (int ai = 0; ai < 2; ++ai)
#pragma unroll
            for (int m = 0; m < 4; ++m) { const float sc = cc[768 + lrow0 + ai * HALF + m];
#pragma unroll
                for (int n = 0; n < 2; ++n) { if (MODE == 0) { acc[ai][0][m][n] *= sc; acc[ai][1][m][n] *= sc; } else acc[ai][0][m][n] = (acc[ai][0][m][n] * sc) * (acc[ai][1][m][n] * sc); } }
        LAS float* ex = exch + (ui & 1) * 2048;
        if (fr == 15) {
#pragma unroll
            for (int ai = 0; ai < 2; ++ai)
#pragma unroll
                for (int r = 0; r < 2; ++r) { LAS float* p = ex + ((ai * 2 + wr) * 2 + r) * 256 + lcol;
                    *(LAS f32x4*)p = acc[ai][0][2 + r][0]; *(LAS f32x4*)(p + 4) = acc[ai][0][2 + r][1];
                    if (MODE == 0) { *(LAS f32x4*)(p + 128) = acc[ai][1][2 + r][0]; *(LAS f32x4*)(p + 132) = acc[ai][1][2 + r][1]; } } }
        asm volatile("s_waitcnt lgkmcnt(0)" ::: "memory"); __builtin_amdgcn_s_barrier(); asm volatile("" ::: "memory"); __builtin_amdgcn_s_barrier(); asm volatile("" ::: "memory");
        const int f = u.pn * HALF + lcol;
        u32x2 keep[2][4];
#pragma unroll
        for (int n = 0; n < 2; ++n) {
            f32x4 wa[3], wg[3];
#pragma unroll
            for (int k = 0; k < 3; ++k) { wa[k] = *(const LAS f32x4*)(cc + k * 128 + lcol + 4 * n); if (MODE == 0) wg[k] = *(const LAS f32x4*)(cc + (3 + k) * 128 + lcol + 4 * n); }
#pragma unroll
            for (int ai = 0; ai < 2; ++ai) {
                const int blk = ai * 2 + wr;
                f32x4 ba2 = (f32x4){0.f, 0.f, 0.f, 0.f}, ba3 = ba2, bg2 = ba2, bg3 = ba2;
                const LAS float* src = nullptr;
                if (blk > 0) src = ex + (blk - 1) * 512; else if ((u.pm & 7) != 0) src = exch + ((ui & 1) ^ 1) * 2048 + 3 * 512;
                if (src != nullptr) { const LAS float* p = src + lcol + 4 * n; ba2 = *(const LAS f32x4*)p; ba3 = *(const LAS f32x4*)(p + 256);
                    if (MODE == 0) { bg2 = *(const LAS f32x4*)(p + 128); bg3 = *(const LAS f32x4*)(p + 256 + 128); } }
                float o[4][4];
#pragma unroll
                for (int j = 0; j < 4; ++j) {
                    const float v0 = acc[ai][0][0][n][j], v1 = acc[ai][0][1][n][j], v2 = acc[ai][0][2][n][j], v3 = acc[ai][0][3][n][j];
                    const float p2 = dppf<0x111>(ba2[j], v2), p3 = dppf<0x111>(ba3[j], v3);
                    const float w0 = wa[0][j], w1 = wa[1][j], w2 = wa[2][j];
                    float y[4] = {w2 * v0 + w1 * p3 + w0 * p2, w2 * v1 + w1 * v0 + w0 * p3, w2 * v2 + w1 * v1 + w0 * v0, w2 * v3 + w1 * v2 + w0 * v1};
                    if (MODE == 0) {
                        const float g0 = acc[ai][1][0][n][j], g1 = acc[ai][1][1][n][j], g2 = acc[ai][1][2][n][j], g3 = acc[ai][1][3][n][j];
                        const float q2 = dppf<0x111>(bg2[j], g2), q3 = dppf<0x111>(bg3[j], g3);
                        const float x0 = wg[0][j], x1 = wg[1][j], x2 = wg[2][j];
                        const float z[4] = {x2 * g0 + x1 * q3 + x0 * q2, x2 * g1 + x1 * g0 + x0 * q3, x2 * g2 + x1 * g1 + x0 * g0, x2 * g3 + x1 * g2 + x0 * g1};
#pragma unroll
                        for (int m = 0; m < 4; ++m) o[m][j] = y[m] * __builtin_amdgcn_rcpf(1.0f + __expf(-y[m])) * z[m];
                    } else {
#pragma unroll
                        for (int m = 0; m < 4; ++m) o[m][j] = y[m];
                    }
                }
#pragma unroll
                for (int m = 0; m < 4; ++m) { u32x2 w; w.x = cvt_pk_bf16(o[m][0], o[m][1]); w.y = cvt_pk_bf16(o[m][2], o[m][3]);
                    if (n == 0) keep[ai][m] = w;
                    else { u32x4 w4; w4.x = keep[ai][m].x; w4.y = keep[ai][m].y; w4.z = w.x; w4.w = w.y; __builtin_nontemporal_store(w4, (u32x4*)(O + (size_t)(row0 + ai * HALF + m) * ldo + f)); } }
            }
            __builtin_amdgcn_sched_barrier(0);
        }
        if (has_next) commit((ui & 1) ^ 1, pf);
    }
};
template <class T, class = void> struct has_pre : std::false_type {};
template <class T> struct has_pre<T, std::void_t<decltype(&T::pre)>> : std::true_type {};
struct EpiCmpHidden {
    static constexpr bool PERM = true;
    const float* b1f; float* H;
    __device__ __forceinline__ void operator()(f32x4 (&acc)[2][2][4][2], const Unit& u, int ui, int wr, int wc, int fr, int fq) const {
        const int row0 = u.pm * BM + wr * 64 + fr, col = wc * 32 + 8 * fq;
        const f32x4 b0 = *(const f32x4*)(b1f + u.pn * 128 + col), b1 = *(const f32x4*)(b1f + u.pn * 128 + col + 4);
#pragma unroll
        for (int ai = 0; ai < 2; ++ai)
#pragma unroll
            for (int m = 0; m < 4; ++m) { const int row = row0 + ai * HALF + m * 16; f32x4 v0 = acc[ai][0][m][0] + b0, v1 = acc[ai][0][m][1] + b1;
#pragma unroll
                for (int j = 0; j < 4; ++j) { v0[j] = gelu_tanh(v0[j]); v1[j] = gelu_tanh(v1[j]); }
                float* hp = H + ((size_t)u.pn * 16384 + row) * 128 + col; *(f32x4*)hp = v0; *(f32x4*)(hp + 4) = v1; }
    }
};
struct EpiMulB {
    static constexpr bool PERM = true;
    const float* rs; const bf16_t* other; bf16_t* Yo;
    __device__ __forceinline__ void operator()(f32x4 (&acc)[2][2][4][2], const Unit& u, int ui, int wr, int wc, int fr, int fq) const {
        const int row0 = u.pm * BM + wr * 64 + fr, col0 = u.pn * BM + wc * 32 + 8 * fq;
#pragma unroll
        for (int ai = 0; ai < 2; ++ai) {
            float sc[4]; bf16x8 ov[4][2];
#pragma unroll
            for (int m = 0; m < 4; ++m) { const int row = row0 + ai * HALF + m * 16; sc[m] = rs[row];
#pragma unroll
                for (int bj = 0; bj < 2; ++bj) ov[m][bj] = *(const bf16x8*)(other + (size_t)row * DM + col0 + bj * HALF); }
            __builtin_amdgcn_sched_barrier(0);
#pragma unroll
            for (int m = 0; m < 4; ++m) { const int row = row0 + ai * HALF + m * 16;
#pragma unroll
                for (int bj = 0; bj < 2; ++bj) { const size_t o = (size_t)row * DM + col0 + bj * HALF; const bf16x8 q = ov[m][bj];
                    const f32x4 v0 = acc[ai][bj][m][0] * sc[m], v1 = acc[ai][bj][m][1] * sc[m]; u32x4 w;
                    w.x = cvt_pk_bf16(v0[0] * bf2f((bf16_t)q[0]), v0[1] * bf2f((bf16_t)q[1])); w.y = cvt_pk_bf16(v0[2] * bf2f((bf16_t)q[2]), v0[3] * bf2f((bf16_t)q[3]));
                    w.z = cvt_pk_bf16(v1[0] * bf2f((bf16_t)q[4]), v1[1] * bf2f((bf16_t)q[5])); w.w = cvt_pk_bf16(v1[2] * bf2f((bf16_t)q[6]), v1[3] * bf2f((bf16_t)q[7]));
                    *(u32x4*)(Yo + o) = w; } }
        }
    }
};

template <class Epi, class Sched>
__device__ __forceinline__ void gemm_phase(LAS unsigned char* lds, const Gemm g, const Sched& S, const Epi& E) {
    int tid_ = threadIdx.x; asm volatile("" : "+v"(tid_));
    const int tid = tid_, wid = __builtin_amdgcn_readfirstlane(tid >> 6), lane = tid & 63, wr = wid >> 2, wc = wid & 3, fr = lane & 15, fq = lane >> 4;
    const int K = g.K, nt = K / BK;
    unsigned voffA[2], voffB[2];
#pragma unroll
    for (int i = 0; i < 2; ++i) { int R, C; stage_rc(tid * 16 + i * 8192, R, C); const int Rb = Epi::PERM ? ((R & ~31) + perm32(R & 31)) : R;
        const int Ra = g.aperm ? ((R & ~63) | ((R & 15) << 2) | ((R >> 4) & 3)) : R;
        voffA[i] = g.amode ? (unsigned)((R >> 2) * (16 * NKV) + (R & 3) * 64 + C) * 2u : (unsigned)(Ra * K + C) * 2u; voffB[i] = (unsigned)(Rb * K + C) * 2u; }
    const size_t kstep = (size_t)(BK * 2), hstep = (size_t)HALF * K * 2, tstep = 2 * hstep;
    const size_t akstep = g.a_kstep, ahstep = g.a_hstep, atstep = g.a_tstep;
    const unsigned ldsw = (unsigned)wid * 1024u;
    const int aoff = lds_byte(wr * 64 + fr, fq * 8), boff = lds_byte(wc * 32 + fr, fq * 8);
#define PG8_SA(b, h) (((b) * 2 + (h)) * HTB)
#define PG8_SB(b, h) ((4 + (b) * 2 + (h)) * HTB)
#define PG8_STAGE(bufoff, gbase, voff) do { _Pragma("unroll") for (int _i = 0; _i < 2; ++_i) \
        __builtin_amdgcn_global_load_lds((const unsigned*)((const char*)(gbase) + (voff)[_i]), (LAS unsigned*)(lds + (bufoff) + ldsw + _i * 8192), 16, 0, 0); } while (0)
#define PG8_LDA(dst, b, h) do { _Pragma("unroll") for (int m = 0; m < 4; ++m) _Pragma("unroll") for (int k = 0; k < 2; ++k) dst[m][k] = *(const LAS bf16x8*)(lds + PG8_SA(b, h) + aoff + m * 2048 + k * 1024); } while (0)
#define PG8_LDB(dst, b, h) do { _Pragma("unroll") for (int n = 0; n < 2; ++n) _Pragma("unroll") for (int k = 0; k < 2; ++k) dst[n][k] = *(const LAS bf16x8*)(lds + PG8_SB(b, h) + boff + n * 2048 + k * 1024); } while (0)
#define PG8_MMA(ai, bj, At, Bt) do { __builtin_amdgcn_s_setprio(1); _Pragma("unroll") for (int m = 0; m < 4; ++m) _Pragma("unroll") for (int n = 0; n < 2; ++n) _Pragma("unroll") for (int k = 0; k < 2; ++k) \
        acc[ai][bj][m][n] = __builtin_amdgcn_mfma_f32_16x16x32_bf16(Bt[n][k], At[m][k], acc[ai][bj][m][n], 0, 0, 0); __builtin_amdgcn_s_setprio(0); } while (0)
#define PG8_WAIT_V(n) asm volatile("s_waitcnt vmcnt(" #n ")" ::: "memory")
#define PG8_WAIT_L(n) asm volatile("s_waitcnt lgkmcnt(" #n ")" ::: "memory")
#define PG8_BAR __builtin_amdgcn_s_barrier()
#define PG8_SCHED __builtin_amdgcn_sched_barrier(0)
    Unit cur, nxt; int ui = 0;
    if (!S.next(0, cur)) return;
    if constexpr (has_pre<Epi>::value) E.pre(cur);
    f32x4 acc[2][2][4][2];
#pragma unroll
    for (int a = 0; a < 2; ++a)
#pragma unroll
        for (int b = 0; b < 2; ++b)
#pragma unroll
            for (int m = 0; m < 4; ++m)
#pragma unroll
                for (int n = 0; n < 2; ++n) acc[a][b][m][n] = (f32x4){0.f, 0.f, 0.f, 0.f};
    bf16x8 At[4][2], B0[2][2], B1[2][2];
    const char* cA = (const char*)g.A + (size_t)cur.pm * atstep + (size_t)cur.pn * g.a_pnstep; const char* cB = (const char*)g.Bt + (size_t)cur.pn * tstep;
    PG8_STAGE(PG8_SB(0, 0), cB, voffB); PG8_STAGE(PG8_SA(0, 0), cA, voffA); PG8_STAGE(PG8_SB(0, 1), cB + hstep, voffB); PG8_STAGE(PG8_SA(0, 1), cA + ahstep, voffA);
    if (wr == 1) PG8_BAR;
    PG8_WAIT_V(4); PG8_BAR;
    PG8_STAGE(PG8_SB(1, 0), cB + kstep, voffB); PG8_STAGE(PG8_SA(1, 0), cA + akstep, voffA); PG8_STAGE(PG8_SB(1, 1), cB + hstep + kstep, voffB);
    PG8_WAIT_V(6); PG8_BAR;
    for (;;) {
        const bool has_next = S.next(ui + 1, nxt);
        const char* nA = has_next ? (const char*)g.A + (size_t)nxt.pm * atstep + (size_t)nxt.pn * g.a_pnstep : cA; const char* nB = has_next ? (const char*)g.Bt + (size_t)nxt.pn * tstep : cB;
        for (int t = 0; t < nt; t += 2) {
            const bool last = (t == nt - 2);
            const char* a1 = cA + (size_t)(t + 1) * akstep;
            const char* a2 = last ? nA : cA + (size_t)(t + 2) * akstep; const char* b2 = last ? nB : cB + (size_t)(t + 2) * kstep;
            const char* a3 = a2 + akstep; const char* b3 = b2 + kstep;
            PG8_LDB(B0, 0, 0); PG8_SCHED; PG8_LDA(At, 0, 0); PG8_STAGE(PG8_SA(1, 1), a1 + ahstep, voffA);
            PG8_WAIT_L(8); PG8_BAR; PG8_WAIT_L(0); PG8_MMA(0, 0, At, B0); PG8_BAR; PG8_SCHED;
            PG8_LDB(B1, 0, 1); PG8_STAGE(PG8_SB(0, 0), b2, voffB);
            PG8_BAR; PG8_WAIT_L(0); PG8_MMA(0, 1, At, B1); PG8_BAR;
            PG8_LDA(At, 0, 1); PG8_STAGE(PG8_SA(0, 0), a2, voffA);
            PG8_BAR; PG8_WAIT_L(0); PG8_MMA(1, 0, At, B0); PG8_BAR; PG8_SCHED;
            PG8_STAGE(PG8_SB(0, 1), b2 + hstep, voffB);
            PG8_WAIT_V(6); PG8_BAR; PG8_MMA(1, 1, At, B1); PG8_BAR;
            PG8_LDB(B0, 1, 0); PG8_SCHED; PG8_LDA(At, 1, 0); PG8_STAGE(PG8_SA(0, 1), a2 + ahstep, voffA);
            PG8_WAIT_L(8); PG8_BAR; PG8_WAIT_L(0); PG8_MMA(0, 0, At, B0); PG8_BAR; PG8_SCHED;
            PG8_LDB(B1, 1, 1); PG8_STAGE(PG8_SB(1, 0), b3, voffB);
            PG8_BAR; PG8_WAIT_L(0); PG8_MMA(0, 1, At, B1); PG8_BAR;
            PG8_LDA(At, 1, 1); PG8_STAGE(PG8_SA(1, 0), a3, voffA);
            PG8_BAR; PG8_WAIT_L(0); PG8_MMA(1, 0, At, B0); PG8_BAR; PG8_SCHED;
            PG8_STAGE(PG8_SB(1, 1), b3 + hstep, voffB);
            PG8_WAIT_V(6); PG8_BAR; PG8_MMA(1, 1, At, B1); PG8_BAR;
        }
        if constexpr (has_pre<Epi>::value) E.run(acc, cur, ui, wr, wc, fr, fq, has_next, nxt); else E(acc, cur, ui, wr, wc, fr, fq);
        if (!has_next) break;
#pragma unroll
        for (int a = 0; a < 2; ++a)
#pragma unroll
            for (int b = 0; b < 2; ++b)
#pragma unroll
                for (int m = 0; m < 4; ++m)
#pragma unroll
                    for (int n = 0; n < 2; ++n) acc[a][b][m][n] = (f32x4){0.f, 0.f, 0.f, 0.f};
        cur = nxt; cA = nA; cB = nB; ++ui;
    }
    PG8_WAIT_V(0);
    if (wr == 0) PG8_BAR;
    PG8_BAR;
#undef PG8_SA
#undef PG8_SB
#undef PG8_STAGE
#undef PG8_LDA
#undef PG8_LDB
#undef PG8_MMA
#undef PG8_WAIT_V
#undef PG8_WAIT_L
#undef PG8_BAR
#undef PG8_SCHED
}
}

struct TrJob { const float* W0; int ld0, n0; const float* W1; int ld1, n1; const float* g0; const float* g1; int mode, pb0, pb1; bf16_t* Wt; int K, Nout; };
__device__ __forceinline__ TrJob get_job(int j, const Args& a) {
    unsigned char* ws = a.ws; TrJob t{}; t.W1 = nullptr; t.ld1 = 0; t.n1 = 0; t.g0 = nullptr; t.g1 = nullptr; t.mode = 0; t.pb0 = 0; t.pb1 = 0;
    switch (j) {
    case 0: t.W0 = a.in[2]; t.ld0 = 3072; t.n0 = 0; t.g0 = a.in[1]; t.mode = 1; t.pb0 = 1024; t.pb1 = 2048; t.Wt = (bf16_t*)(ws + WS_WIN); t.K = 1024; t.Nout = 2048; break;
    case 1: t.W0 = a.in[2]; t.ld0 = 3072; t.n0 = 1024; t.g0 = a.in[1]; t.Wt = (bf16_t*)(ws + WS_WIN) + (size_t)2048 * 1024; t.K = 1024; t.Nout = 1024; break;
    case 2: t.W0 = a.in[4]; t.ld0 = 1024; t.n0 = 1024; t.Wt = (bf16_t*)(ws + WS_WOUT); t.K = 1024; t.Nout = 1024; break;
    case 3: t.W0 = a.in[6]; t.ld0 = 5632; t.g0 = a.in[5]; t.mode = 1; t.pb0 = 0; t.pb1 = 2816; t.Wt = (bf16_t*)(ws + WS_WUP0); t.K = 1024; t.Nout = 5632; break;
    case 4: t.W0 = a.in[6] + (size_t)1024 * 5632; t.ld0 = 5632; t.g0 = a.in[5] + 1024; t.mode = 1; t.pb0 = 0; t.pb1 = 2816; t.Wt = (bf16_t*)(ws + WS_WUP1); t.K = 1024; t.Nout = 5632; break;
    case 5: t.W0 = a.in[8]; t.ld0 = 1024; t.n0 = 1024; t.Wt = (bf16_t*)(ws + WS_WDN0); t.K = 2816; t.Nout = 1024; break;
    case 6: t.W0 = a.in[8] + (size_t)2816 * 1024; t.ld0 = 1024; t.n0 = 1024; t.Wt = (bf16_t*)(ws + WS_WDN1); t.K = 2816; t.Nout = 1024; break;
    case 7: t.W0 = a.in[10]; t.ld0 = 1536; t.n0 = 1536; t.g0 = a.in[9]; t.W1 = a.in[15]; t.ld1 = 1072; t.n1 = 1072; t.g1 = a.in[1] + 1024; t.Wt = (bf16_t*)(ws + WS_WKVQG); t.K = 1024; t.Nout = 2816; break;
    case 8: t.W0 = a.in[16]; t.ld0 = 1024; t.n0 = 1024; t.Wt = (bf16_t*)(ws + WS_WO); t.K = 1024; t.Nout = 1024; break;
    case 9: t.W0 = a.in[12]; t.ld0 = 128; t.n0 = 128; t.Wt = (bf16_t*)(ws + WS_W1T); t.K = 2048; t.Nout = 256; break;
    default: t.W0 = a.in[12] + (size_t)2048 * 128; t.ld0 = 128; t.n0 = 128; t.Wt = (bf16_t*)(ws + WS_W1T) + (size_t)256 * 2048; t.K = 2048; t.Nout = 256; break;
    }
    return t;
}
__device__ __forceinline__ void wprep_phase(const Args& a, LAS unsigned char* lds) {
    LAS float* tile = (LAS float*)lds;
    const int tid = threadIdx.x, tx = tid & 63, ty = tid >> 6;
    int jstart = 0;
    for (int j = 0; j < 11; ++j) {
        const TrJob t = get_job(j, a);
        const int nkt = t.K / 64, nnt = t.Nout / 64, ntile = nkt * nnt;
        int first = ((int)blockIdx.x - jstart % (int)gridDim.x + (int)gridDim.x) % (int)gridDim.x;
        for (int ti = first; ti < ntile; ti += gridDim.x) {
            const int kt = ti % nkt, ntl = ti / nkt, k0 = kt * 64, n0 = ntl * 64;
            const int n = n0 + tx; const float* src = nullptr; int ld = 0; const float* gp = t.g0;
            if (t.mode == 1) { const int p = n >> 8, half = (n >> 7) & 1, c = n & 127; src = t.W0 + (half ? t.pb1 : t.pb0) + 128 * p + c; ld = t.ld0; }
            else if (n < t.n0) { src = t.W0 + n; ld = t.ld0; }
            else if (n - t.n0 < t.n1) { src = t.W1 + (n - t.n0); ld = t.ld1; gp = t.g1; }
            __syncthreads();
#pragma unroll
            for (int i = 0; i < 8; ++i) { const int k = k0 + ty + 8 * i; float v = 0.f; if (src) { v = src[(size_t)k * ld]; if (gp) v *= gp[k]; } tile[(ty + 8 * i) * 65 + tx] = v; }
            __syncthreads();
            { const int nn = tid >> 3, kc = (tid & 7) * 8; u32x4 w;
                w.x = cvt_pk_bf16(tile[(kc + 0) * 65 + nn], tile[(kc + 1) * 65 + nn]); w.y = cvt_pk_bf16(tile[(kc + 2) * 65 + nn], tile[(kc + 3) * 65 + nn]);
                w.z = cvt_pk_bf16(tile[(kc + 4) * 65 + nn], tile[(kc + 5) * 65 + nn]); w.w = cvt_pk_bf16(tile[(kc + 6) * 65 + nn], tile[(kc + 7) * 65 + nn]);
                *(u32x4*)(t.Wt + (size_t)(n0 + nn) * t.K + k0 + kc) = w; }
        }
        jstart += ntile;
    }
    if (tid < 64) for (int idx = blockIdx.x; idx < 256; idx += gridDim.x) { const int j = idx >> 7, n = idx & 127; float sacc = 0.f;
            for (int k = tid; k < 2048; k += 64) sacc += a.in[11][j * 2048 + k] * a.in[12][((size_t)j * 2048 + k) * 128 + n];
            sacc = wave_sum(sacc); if (tid == 0) ((float*)(a.ws + WS_B1F))[idx] = sacc + a.in[13][idx]; }
    __syncthreads();
}

__device__ __forceinline__ void rowstat_phase(const float* src, bf16_t* dstb, float* rs, int row0, int nrows) {
    const int wave = threadIdx.x >> 6, lane = threadIdx.x & 63;
    for (int r = blockIdx.x * 8 + wave; r < nrows; r += gridDim.x * 8) {
        const size_t row = (size_t)(row0 + r); const float* p = src + row * DM; float ss = 0.f;
#pragma unroll
        for (int i = 0; i < 2; ++i) { const int c = i * 512 + lane * 8; const f32x4 v0 = *(const f32x4*)(p + c), v1 = *(const f32x4*)(p + c + 4);
            ss += ((v0[0] * v0[0] + v0[1] * v0[1]) + (v0[2] * v0[2] + v0[3] * v0[3])) + ((v1[0] * v1[0] + v1[1] * v1[1]) + (v1[2] * v1[2] + v1[3] * v1[3]));
            if (dstb) { u32x4 w; w.x = cvt_pk_bf16(v0[0], v0[1]); w.y = cvt_pk_bf16(v0[2], v0[3]); w.z = cvt_pk_bf16(v1[0], v1[1]); w.w = cvt_pk_bf16(v1[2], v1[3]); *(u32x4*)(dstb + row * DM + c) = w; } }
        ss = wave_sum(ss);
        if (lane == 0) rs[row] = rsqrtf(ss * (1.0f / DM) + 1e-6f);
    }
}
__device__ __forceinline__ void final_phase(float* out, const bf16_t* xb, const float* ssp, const float* gain, int row0, int nrows) {
    const int wave = threadIdx.x >> 6, lane = threadIdx.x & 63;
    for (int r = blockIdx.x * 8 + wave; r < nrows; r += gridDim.x * 8) {
        const size_t row = (size_t)(row0 + r);
        float ss = lane < 16 ? ssp[row * 16 + lane] : 0.f; ss = wave_sum(ss);
        const float sc = rsqrtf(ss * (1.0f / DM) + 1e-6f);
#pragma unroll
        for (int i = 0; i < 2; ++i) { const int c = i * 512 + lane * 8; const bf16x8 v = *(const bf16x8*)(xb + row * DM + c);
            const f32x4 g0 = *(const f32x4*)(gain + c), g1 = *(const f32x4*)(gain + c + 4);
            f32x4 o0, o1;
#pragma unroll
            for (int j = 0; j < 4; ++j) { o0[j] = bf2f((bf16_t)v[j]) * sc * g0[j]; o1[j] = bf2f((bf16_t)v[4 + j]) * sc * g1[j]; }
            __builtin_nontemporal_store(o0, (f32x4*)(out + row * DM + c)); __builtin_nontemporal_store(o1, (f32x4*)(out + row * DM + c + 4)); }
    }
}
__device__ __forceinline__ void compress_out_phase(const Args& a, LAS unsigned char* lds) {
    const float* H = (const float*)(a.ws + WS_HID); bf16_t* kcb = (bf16_t*)(a.ws + WS_KCB); const float* w2 = a.in[14];
    LAS float* w2s = (LAS float*)lds;
    const int tid = threadIdx.x, wave = tid >> 6, lane = tid & 63;
    LAS float* hrow = w2s + 2 * 128 * 64 + wave * 128;
    for (int e = tid; e < 2 * 128 * 64; e += NTHREADS) w2s[e] = w2[e];
    __syncthreads();
    for (int r = blockIdx.x * 8 + wave; r < 2 * 16384; r += gridDim.x * 8) {
        const int j = r >> 14, row = r & 16383, i = (row >> 2) & 127;
        hrow[lane] = H[(size_t)r * 128 + lane]; hrow[lane + 64] = H[(size_t)r * 128 + 64 + lane];
        asm volatile("s_waitcnt lgkmcnt(0)" ::: "memory");
        float o = 0.f;
#pragma unroll 8
        for (int n = 0; n < 128; ++n) o += hrow[n] * w2s[(j * 128 + n) * 64 + lane];
        kcb[(size_t)r * 64 + lane] = (i == 127) ? (bf16_t)0 : f2bf(o);
        asm volatile("s_waitcnt lgkmcnt(0)" ::: "memory");
    }
    __syncthreads();
}
__device__ __forceinline__ int rel_bucket(int d) { if (d < 16) return d; const int l = 16 + (int)(logf((float)d / 16.0f) / 2.0794415416798357f * 16.0f); return l < 31 ? l : 31; }

typedef float f32x16 __attribute__((ext_vector_type(16)));
typedef short s16x4 __attribute__((ext_vector_type(4)));
typedef __bf16 bf16x2_t __attribute__((ext_vector_type(2)));
#define MFMA32(a, b, c) __builtin_amdgcn_mfma_f32_32x32x16_bf16((a), (b), (c), 0, 0, 0)
constexpr int TP = 144, TILE_B = 64 * TP;
constexpr int TABN = 336;
constexpr int AT_IMP = 4 * TILE_B, AT_SELM = AT_IMP + 4 * 64 * 33 * 4, AT_BTAB = AT_SELM + 256, AT_BUCK = AT_BTAB + TABN * 16, AT_OUT = AT_BUCK + 512, AT_END = AT_OUT + 8 * 8192;
constexpr float LOG2E = 1.4426950408889634f;
__device__ __forceinline__ unsigned pk2(float a, float b) { const f32x2 v = {a, b}; return __builtin_bit_cast(unsigned, __builtin_convertvector(v, bf16x2_t)); }
__device__ __forceinline__ int crow16(int i) { return (i & 3) + 8 * (i >> 2); }

__device__ __forceinline__ float xor32f(float v, int xaddr) { return __builtin_bit_cast(float, __builtin_amdgcn_ds_bpermute(xaddr, __builtin_bit_cast(int, v))); }
template <int CTRL> __device__ __forceinline__ unsigned dppu(unsigned v) { return (unsigned)__builtin_amdgcn_update_dpp(0, (int)v, CTRL, 0xf, 0xf, true); }
struct AttnState { f32x16 O[2]; float m, l; int xaddr; };

template <int BR, bool PASS2>
__device__ __forceinline__ void attn_block(LAS unsigned char* lds, int Kt, int Vt, int kpos0, bool selbit, const bf16x8 (&qf)[4], AttnState& st, int hh, int tq, int lane,
                                           float inv, LAS float* improw, float& eprev, int blk, bool win) {
    const int h = lane >> 5, l31 = lane & 31;
    const int tq0 = __builtin_amdgcn_readfirstlane(tq - l31);
    if (BR != 0) { if (tq0 + 31 < kpos0) return; if (win && tq0 - (kpos0 + 63) >= 512) return; }
    f32x16 S[2];
#pragma unroll
    for (int kb = 0; kb < 2; ++kb) {
#pragma unroll
        for (int i = 0; i < 16; ++i) S[kb][i] = 0.f;
#pragma unroll
        for (int s = 0; s < 4; ++s) { const bf16x8 kf = *(const LAS bf16x8*)(lds + Kt + (32 * kb + l31) * TP + (16 * s + 8 * h) * 2); S[kb] = MFMA32(kf, qf[s], S[kb]); }
    }
    const LAS float* btab = (const LAS float*)(lds + AT_BTAB);
    const bool fast = (BR != 0) && (tq0 - (kpos0 + 63) >= 113) && (!win || (tq0 + 31 - kpos0) <= 511);
    float mx = -INFINITY, cb = 0.f; const bool okl = (BR == 1) ? (selbit || win) : true;
    const bool nearp = (BR == 1) && !fast && (tq0 + 31 - kpos0) <= 271;
    if (fast) { cb = btab[(127 + 64) * 4 + hh]; float mr = S[0][0];
#pragma unroll
        for (int kb = 0; kb < 2; ++kb)
#pragma unroll
            for (int i = 0; i < 16; ++i) mr = fmaxf(mr, S[kb][i]);
        mx = okl ? __builtin_fmaf(mr, LOG2E, cb) : -INFINITY;
    } else if (nearp) {
        const LAS float* tb = btab + (tq - kpos0 - 4 * h + 64 - 59) * 4 + hh;
#pragma unroll
        for (int kb = 0; kb < 2; ++kb)
#pragma unroll
            for (int i0 = 0; i0 < 16; i0 += 8) { float bv[8];
#pragma unroll
                for (int e = 0; e < 8; ++e) bv[e] = tb[(59 - 32 * kb - crow16(i0 + e)) * 4];
                __builtin_amdgcn_sched_barrier(0);
#pragma unroll
                for (int e = 0; e < 8; ++e) { const float v = __builtin_fmaf(S[kb][i0 + e], LOG2E, bv[e]); S[kb][i0 + e] = v; mx = fmaxf(mx, v); }
                __builtin_amdgcn_sched_barrier(0); }
        mx = okl ? mx : -INFINITY;
    } else {
#pragma unroll
        for (int kb = 0; kb < 2; ++kb)
#pragma unroll
            for (int i0 = 0; i0 < 16; i0 += 8) {
                float bv[8]; float pen[8];
#pragma unroll
                for (int e = 0; e < 8; ++e) { const int i = i0 + e; const int kidx = kpos0 + 32 * kb + 4 * h + crow16(i); const int dist = tq - ((BR == 0) ? (16 * kidx + 31) : kidx);
                    const int dc = dist < -1 ? -1 : (dist > 127 ? 127 : dist);
                    bv[e] = btab[(dc + 64) * 4 + hh]; pen[e] = (BR == 1 && win && dist >= 512) ? -INFINITY : 0.f; }
                __builtin_amdgcn_sched_barrier(0);
#pragma unroll
                for (int e = 0; e < 8; ++e) { const int i = i0 + e; float v = __builtin_fmaf(S[kb][i], LOG2E, bv[e]); if (BR == 1) v += pen[e]; S[kb][i] = v; mx = fmaxf(mx, v); }
                __builtin_amdgcn_sched_barrier(0);
            }
        if (BR == 1) mx = okl ? mx : -INFINITY;
    }
    __builtin_amdgcn_sched_barrier(0);
    if (!PASS2) {
        mx = fmaxf(mx, xor32f(mx, st.xaddr));
        const float mnew = fmaxf(st.m, mx), muse = (mnew == -INFINITY) ? 0.f : mnew, alpha = __builtin_amdgcn_exp2f(st.m - muse);
        float ls = 0.f;
        if (fast) { const float cbm = okl ? (cb - muse) : -INFINITY;
#pragma unroll
            for (int kb = 0; kb < 2; ++kb)
#pragma unroll
                for (int i = 0; i < 16; ++i) { const float pv = __builtin_amdgcn_exp2f(__builtin_fmaf(S[kb][i], LOG2E, cbm)); S[kb][i] = pv; ls += pv; }
        } else { const float musel = (BR == 1 && !okl) ? INFINITY : muse;
#pragma unroll
            for (int kb = 0; kb < 2; ++kb)
#pragma unroll
                for (int i = 0; i < 16; ++i) { const float pv = __builtin_amdgcn_exp2f(S[kb][i] - musel); S[kb][i] = pv; ls += pv; }
        }
        st.l = st.l * alpha + ls; st.m = mnew;
        if (__builtin_amdgcn_ballot_w64(alpha != 1.0f) != 0ull) {
#pragma unroll
            for (int db = 0; db < 2; ++db)
#pragma unroll
                for (int i = 0; i < 16; ++i) st.O[db][i] *= alpha; }
        const int i16 = lane & 15, q4 = i16 >> 2, p4 = i16 & 3, b16 = (lane >> 4) & 1;
        LAS unsigned char* vbase = lds + Vt + (4 * h + q4) * TP + 32 * b16 + 8 * p4;
#pragma unroll
        for (int kb = 0; kb < 2; ++kb) {
            bf16x8 vf[2][2];
#pragma unroll
            for (int s2 = 0; s2 < 2; ++s2)
#pragma unroll
                for (int db = 0; db < 2; ++db) { LAS unsigned char* va = vbase + (32 * kb + 16 * s2) * TP + db * 64;
                    const s16x4 lo = __builtin_bit_cast(s16x4, __builtin_amdgcn_ds_read_tr16_b64_v4i16((LAS s16x4*)va));
                    const s16x4 hi = __builtin_bit_cast(s16x4, __builtin_amdgcn_ds_read_tr16_b64_v4i16((LAS s16x4*)(va + 8 * TP)));
                    vf[s2][db] = __builtin_shufflevector(lo, hi, 0, 1, 2, 3, 4, 5, 6, 7); }
            __builtin_amdgcn_sched_barrier(0);
#pragma unroll
            for (int s2 = 0; s2 < 2; ++s2) {
                u32x4 pw; pw.x = pk2(S[kb][8 * s2 + 0], S[kb][8 * s2 + 1]); pw.y = pk2(S[kb][8 * s2 + 2], S[kb][8 * s2 + 3]); pw.z = pk2(S[kb][8 * s2 + 4], S[kb][8 * s2 + 5]); pw.w = pk2(S[kb][8 * s2 + 6], S[kb][8 * s2 + 7]);
                const bf16x8 pf = __builtin_bit_cast(bf16x8, pw);
#pragma unroll
                for (int db = 0; db < 2; ++db) st.O[db] = MFMA32(vf[s2][db], pf, st.O[db]);
            }
            __builtin_amdgcn_sched_barrier(0);
        }
    } else {
        const float muse = (st.m == -INFINITY) ? 0.f : st.m;
#pragma unroll
        for (int kb = 0; kb < 2; ++kb)
#pragma unroll
            for (int gq = 0; gq < 4; ++gq) {
                const float p0 = __builtin_amdgcn_exp2f(S[kb][4 * gq] - muse) * inv, p1 = __builtin_amdgcn_exp2f(S[kb][4 * gq + 1] - muse) * inv,
                            p2 = __builtin_amdgcn_exp2f(S[kb][4 * gq + 2] - muse) * inv, p3 = __builtin_amdgcn_exp2f(S[kb][4 * gq + 3] - muse) * inv;
                const float esw = xor32f(p3, st.xaddr);
                const float val = ((p0 + p1) + (p2 + p3)) + (h ? esw : eprev);
                improw[16 * blk + 8 * kb + 2 * gq + h] = val; eprev = esw; }
    }
}

__device__ __forceinline__ void attn_mfma_phase(const Args& a, LAS unsigned char* lds) {
    const bf16_t* kv = (const bf16_t*)(a.ws + WS_KV); const bf16_t* qb_ = (const bf16_t*)(a.ws + WS_Q); const float* gate = (const float*)(a.ws + WS_GATE);
    const bf16_t* kcb = (const bf16_t*)(a.ws + WS_KCB); bf16_t* yo = (bf16_t*)(a.ws + WS_Y); const float* relb = a.in[17];
    int tid_ = threadIdx.x; asm volatile("" : "+v"(tid_));
    const int tid = tid_, wid = __builtin_amdgcn_readfirstlane(tid >> 6), lane = tid & 63, hh = wid >> 1, qh = wid & 1, h = lane >> 5, l31 = lane & 31;
    const int lkey = tid >> 3, lch = tid & 7;
    LAS int* buck = (LAS int*)(lds + AT_BUCK); LAS float* btab = (LAS float*)(lds + AT_BTAB); LAS unsigned* selm = (LAS unsigned*)(lds + AT_SELM); LAS float* imp = (LAS float*)(lds + AT_IMP);
    if (tid < 128) buck[tid] = rel_bucket(tid);
    __syncthreads();
    const int nitems = NB * 32 * 4;
    for (int it = blockIdx.x; it < nitems; it += gridDim.x) {
        const int qb = it >> 7, b = (it >> 2) & 31, g = it & 3, qs = 64 * qb, head = g * 4 + hh, tq = qs + 32 * qh + l31;
        const size_t rowq = (size_t)b * SEQ + tq;
        bf16x8 qf[4];
#pragma unroll
        for (int s = 0; s < 4; ++s) qf[s] = *(const bf16x8*)(qb_ + rowq * DM + head * 64 + 16 * s + 8 * h);
        const float* gp = gate + rowq * 48 + head * 3; const float g0 = gp[0], g1 = gp[1], g2 = gp[2];
        __syncthreads();
        for (int e = tid; e < TABN * 4; e += NTHREADS) { const int d = (e >> 2) - 64; btab[e] = d < 0 ? -INFINITY : relb[buck[d > 127 ? 127 : d] * 16 + g * 4 + (e & 3)] * LOG2E; }
        {
            const bf16_t* kc = kcb + (((size_t)b * 128) * 4 + g) * 64; const bf16_t* vc = kc + (size_t)NB * 128 * 4 * 64;
#pragma unroll
            for (int blk = 0; blk < 2; ++blk) { const u32x4 kx = *(const u32x4*)(kc + (size_t)(64 * blk + lkey) * 256 + lch * 8), vx = *(const u32x4*)(vc + (size_t)(64 * blk + lkey) * 256 + lch * 8);
                *(LAS u32x4*)(lds + blk * TILE_B + lkey * TP + lch * 16) = kx; *(LAS u32x4*)(lds + (2 + blk) * TILE_B + lkey * TP + lch * 16) = vx; }
        }
        __syncthreads();
        AttnState st; float edummy = 0.f; LAS unsigned char* outp = lds + AT_OUT + wid * 8192 + lane * 16;
#pragma unroll
        for (int db = 0; db < 2; ++db)
#pragma unroll
            for (int i = 0; i < 16; ++i) st.O[db][i] = 0.f;
        st.m = -INFINITY; st.l = 0.f; st.xaddr = (lane ^ 32) << 2;
#pragma nounroll
        for (int blk = 0; blk < (qb >= 16 ? 2 : 1); ++blk)
            attn_block<0, false>(lds, blk * TILE_B, (2 + blk) * TILE_B, 64 * blk, true, qf, st, hh, tq, lane, 0.f, nullptr, edummy, blk, false);
        {   const float lt = st.l + xor32f(st.l, st.xaddr), inv = lt > 0.f ? 1.0f / lt : 0.f, sc = g0 * inv;
#pragma unroll
            for (int db = 0; db < 2; ++db)
#pragma unroll
                for (int gq = 0; gq < 4; ++gq) { const f32x4 v = {st.O[db][4 * gq] * sc, st.O[db][4 * gq + 1] * sc, st.O[db][4 * gq + 2] * sc, st.O[db][4 * gq + 3] * sc};
                    *(LAS f32x4*)(outp + (db * 4 + gq) * 1024) = v; st.O[db][4 * gq] = 0.f; st.O[db][4 * gq + 1] = 0.f; st.O[db][4 * gq + 2] = 0.f; st.O[db][4 * gq + 3] = 0.f; }
            if (qb >= 16) { float ep = 0.f; LAS float* improw = imp + (hh * 64 + 32 * qh + l31) * 33;
#pragma nounroll
                for (int blk = 0; blk < 2; ++blk) attn_block<0, true>(lds, blk * TILE_B, (2 + blk) * TILE_B, 64 * blk, true, qf, st, hh, tq, lane, inv, improw, ep, blk, false); }
            st.m = -INFINITY; st.l = 0.f; }
        __syncthreads();
        if (qb >= 16) {
            {
                const int q = tid >> 3, j0 = (tid & 7) * 4;
#pragma unroll
                for (int u = 0; u < 4; ++u) { const int j = j0 + u; imp[q * 33 + j] = (imp[(0 * 64 + q) * 33 + j] + imp[(1 * 64 + q) * 33 + j]) + (imp[(2 * 64 + q) * 33 + j] + imp[(3 * 64 + q) * 33 + j]); }
            }
            __syncthreads();
            const int q = tid >> 3, sub = tid & 7; unsigned mk = 0u;
            for (int u = 0; u < 4; ++u) { const int s = 4 * sub + u; const float mine = imp[q * 33 + s];
                int rank = 0;
                for (int j = 1; j < 32; ++j) { const float ij = imp[q * 33 + j]; const bool cj = (j < qb - 1); if (cj && (ij > mine || (ij == mine && j < s))) ++rank; }
                const bool forced = (s == 0) || (s == qb) || (s == qb - 1); if (forced || (s <= qb && rank < 13)) mk |= 1u << s; }
            mk |= dppu<0xB1>(mk); mk |= dppu<0x4E>(mk); mk |= dppu<0x141>(mk);
            if (sub == 0) selm[q] = mk;
        } else if (tid < 64) selm[tid] = (qb >= 31) ? 0xffffffffu : ((2u << qb) - 1u);
        __syncthreads();
        const unsigned mysel = selm[32 * qh + l31];
        const int nsel = qb + 1, wlo = qb > 8 ? qb - 8 : 0, nstep = nsel + (qb - wlo + 1);
        const bf16_t* kvb = kv + (size_t)b * SEQ * NKV + g * 64;
        u32x4 kx, vx;
        { const bf16_t* r0 = kvb + (size_t)(0 + lkey) * NKV + lch * 8; kx = *(const u32x4*)(r0 + 2 * 256); vx = *(const u32x4*)(r0 + 3 * 256); }
        *(LAS u32x4*)(lds + 0 * TILE_B + lkey * TP + lch * 16) = kx; *(LAS u32x4*)(lds + 2 * TILE_B + lkey * TP + lch * 16) = vx;
        __syncthreads();
        for (int k = 0; k < nstep; ++k) {
            const int buf = k & 1;
            if (k + 1 < nstep) { const int k1 = k + 1, isw = k1 >= nsel, jb1 = isw ? wlo + (k1 - nsel) : k1; const bf16_t* r0 = kvb + (size_t)(64 * jb1 + lkey) * NKV + lch * 8 + (isw ? 4 * 256 : 2 * 256);
                kx = *(const u32x4*)r0; vx = *(const u32x4*)(r0 + 256); }
            if (k == nsel) {
                const float lt = st.l + xor32f(st.l, st.xaddr), sc = g1 / lt;
#pragma unroll
                for (int db = 0; db < 2; ++db)
#pragma unroll
                    for (int gq = 0; gq < 4; ++gq) { f32x4 v = *(LAS f32x4*)(outp + (db * 4 + gq) * 1024);
                        v[0] += st.O[db][4 * gq] * sc; v[1] += st.O[db][4 * gq + 1] * sc; v[2] += st.O[db][4 * gq + 2] * sc; v[3] += st.O[db][4 * gq + 3] * sc;
                        *(LAS f32x4*)(outp + (db * 4 + gq) * 1024) = v; st.O[db][4 * gq] = 0.f; st.O[db][4 * gq + 1] = 0.f; st.O[db][4 * gq + 2] = 0.f; st.O[db][4 * gq + 3] = 0.f; }
                st.m = -INFINITY; st.l = 0.f; }
            { const bool isw = k >= nsel; const int jbk = isw ? wlo + k - nsel : k;
              attn_block<1, false>(lds, buf * TILE_B, (2 + buf) * TILE_B, 64 * jbk, (mysel >> (jbk & 31)) & 1u, qf, st, hh, tq, lane, 0.f, nullptr, edummy, 0, isw); }
            if (k + 1 < nstep) { *(LAS u32x4*)(lds + (buf ^ 1) * TILE_B + lkey * TP + lch * 16) = kx; *(LAS u32x4*)(lds + (2 + (buf ^ 1)) * TILE_B + lkey * TP + lch * 16) = vx; }
            __syncthreads();
        }
        {   const float lt = st.l + xor32f(st.l, st.xaddr), sc = g2 / lt;
            u32x2 w[2][4];
#pragma unroll
            for (int db = 0; db < 2; ++db)
#pragma unroll
                for (int gq = 0; gq < 4; ++gq) { const f32x4 v = *(LAS f32x4*)(outp + (db * 4 + gq) * 1024);
                    w[db][gq].x = pk2(v[0] + st.O[db][4 * gq] * sc, v[1] + st.O[db][4 * gq + 1] * sc); w[db][gq].y = pk2(v[2] + st.O[db][4 * gq + 2] * sc, v[3] + st.O[db][4 * gq + 3] * sc); }
            LAS unsigned char* tp = lds + AT_OUT + wid * 8192;
#pragma unroll
            for (int db = 0; db < 2; ++db)
#pragma unroll
                for (int gq = 0; gq < 4; ++gq) *(LAS u32x2*)(tp + l31 * TP + (32 * db + 8 * gq + 4 * h) * 2) = w[db][gq];
            asm volatile("s_waitcnt lgkmcnt(0)" ::: "memory");
            bf16_t* obase = yo + ((size_t)b * SEQ + qs + 32 * qh) * DM + head * 64;
#pragma unroll
            for (int it = 0; it < 4; ++it) { const int r = (lane >> 3) + 8 * it, ch = lane & 7; const u32x4 v = *(const LAS u32x4*)(tp + r * TP + ch * 16); *(u32x4*)(obase + (size_t)r * DM + ch * 8) = v; }
        }
    }
    __syncthreads();
}

#define XB_TMO      128
#define XB_XCNT(j)  (256  + 64 * (j))
#define XB_XSUB(j)  (1280 + 64 * (j))
#define XB_XGEN(j)  (2304 + 64 * (j))
#define XB_TOP      3328
#define XB_TOPGEN   3392
#define XCD_BAR_WORDS 3456
#define XB_SPIN_CAP (1u << 18)
__device__ __forceinline__ unsigned xb_ld(unsigned* p)              { return __hip_atomic_load(p, __ATOMIC_RELAXED, __HIP_MEMORY_SCOPE_AGENT); }
__device__ __forceinline__ unsigned xb_add(unsigned* p, unsigned v) { return __hip_atomic_fetch_add(p, v, __ATOMIC_RELAXED, __HIP_MEMORY_SCOPE_AGENT); }
__device__ __forceinline__ unsigned xb_xcc_id() { return (unsigned)__builtin_amdgcn_s_getreg((3 << 11) | 20) & 0xFu; }
#define XB_SPIN(cond, bar) do { unsigned _sp = 0; while (cond) { __builtin_amdgcn_s_sleep(1); \
    if ((++_sp & 255u) == 0u) { if (xb_ld(&(bar)[XB_TMO])) break; if (_sp > XB_SPIN_CAP) { atomicAdd(&(bar)[XB_TMO], 1u); break; } } } } while (0)
struct XcdBarrier { unsigned* bar; unsigned x; volatile LAS unsigned* st; };
__device__ __forceinline__ XcdBarrier xcd_barrier_post(unsigned* bar, volatile LAS unsigned* st) {
    XcdBarrier b; b.bar = bar; b.x = xb_xcc_id(); b.st = st;
    if (threadIdx.x == 0) (void)xb_add(&bar[XB_XCNT(b.x)], 1u);
    return b;
}
__device__ __forceinline__ void xcd_barrier_complete(unsigned* bar, unsigned x, unsigned& nloc, unsigned& nx) {
    const unsigned G = gridDim.x * gridDim.y * gridDim.z;
    unsigned sum, cnt, mine, sp = 0u;
    for (;;) {
        sum = 0u; cnt = 0u; mine = 0u;
#pragma unroll
        for (unsigned j = 0; j < 16; ++j) { const unsigned c = xb_ld(&bar[XB_XCNT(j)]); sum += c; cnt += (c > 0u) ? 1u : 0u; mine = (j == x) ? c : mine; }
        if (sum == G) break;
        __builtin_amdgcn_s_sleep(1);
        if ((++sp & 255u) == 0u) { if (xb_ld(&bar[XB_TMO])) break; if (sp > XB_SPIN_CAP) { atomicAdd(&bar[XB_TMO], 1u); break; } }
    }
    nloc = mine > 0u ? mine : 1u; nx = cnt > 0u ? cnt : 1u;
}
__device__ __forceinline__ void xcd_barrier(const XcdBarrier& b) {
    asm volatile("s_waitcnt vmcnt(0)" ::: "memory");
    __syncthreads();
    if (threadIdx.x == 0) {
        unsigned* bar = b.bar;
        __builtin_amdgcn_s_waitcnt(0);
        unsigned nloc = b.st[0], nx = b.st[1];
        if (nloc == 0u) { xcd_barrier_complete(bar, b.x, nloc, nx); b.st[0] = nloc; b.st[1] = nx; }
        const unsigned old = xb_add(&bar[XB_XSUB(b.x)], 1u);
        const unsigned gen = old / nloc;
        if (old + 1u == (gen + 1u) * nloc) {
            __builtin_amdgcn_fence(__ATOMIC_RELEASE, "agent");
            asm volatile("s_waitcnt vmcnt(0)" ::: "memory");
            const unsigned og = xb_add(&bar[XB_TOP], 1u);
            const unsigned tg = og / nx;
            if (og + 1u == (tg + 1u) * nx) xb_add(&bar[XB_TOPGEN], 1u);
            else XB_SPIN(xb_ld(&bar[XB_TOPGEN]) == tg, bar);
            __builtin_amdgcn_fence(__ATOMIC_ACQUIRE, "agent");
            xb_add(&bar[XB_XGEN(b.x)], 1u);
            asm volatile("s_waitcnt vmcnt(0)" ::: "memory");
        } else {
            XB_SPIN(xb_ld(&bar[XB_XGEN(b.x)]) == gen, bar);
            __builtin_amdgcn_fence(__ATOMIC_ACQUIRE, "agent");
            asm volatile("s_waitcnt vmcnt(0)" ::: "memory");
        }
    }
    __syncthreads();
}

enum { PH_WPREP = 0, PH_XPREP, PH_INCV, PH_INB, PH_OUTPROJ, PH_UP0, PH_DN0, PH_KVQG, PH_CMP, PH_CMP2, PH_ATTN, PH_WO, PH_UP1, PH_DN1, PH_FINAL, PH_COUNT };

__global__ void __launch_bounds__(NTHREADS, 2) mk_fwd(Args a) {
    extern __shared__ __attribute__((aligned(16))) unsigned char lds_raw[];
    LAS unsigned char* lds = (LAS unsigned char*)lds_raw;
    LAS float* exch = (LAS float*)(lds + 131072); LAS float* epc = (LAS float*)(lds + EPC_OFF);
    unsigned char* ws = a.ws;
    const int G = gridDim.x, bx = blockIdx.x;
    const float* x_in = a.in[0]; float* xo = a.out;
    bf16_t* HB = (bf16_t*)(ws + WS_HB); bf16_t* ACT = (bf16_t*)(ws + WS_BIG); bf16_t* Y = (bf16_t*)(ws + WS_Y); bf16_t* CVC = (bf16_t*)(ws + WS_RAW);
    float* RS = (float*)(ws + WS_RS); float* SSP = (float*)(ws + WS_SSP);
    const int lo = a.ph_lo, hi = a.ph_hi;
#define IN(k) (lo <= (k) && (k) < hi)
    volatile LAS unsigned* xst = (volatile LAS unsigned*)(lds + 147456);
    if (threadIdx.x < 4) xst[threadIdx.x] = 0u;
    __syncthreads();
    const XcdBarrier xbar = xcd_barrier_post((unsigned*)(ws + WS_BAR), xst);
#define SEAM(k) do { if (IN(k) && IN((k) + 1)) xcd_barrier(xbar); } while (0)
    if (hi < 0) cg::this_grid().sync();

    if (IN(PH_WPREP)) wprep_phase(a, lds);
    if (IN(PH_XPREP)) rowstat_phase(x_in, HB, RS, 0, MROWS);
    SEAM(PH_XPREP);
    if (IN(PH_INCV)) { pg8::Gemm g = pg8::dense(HB, (const bf16_t*)(ws + WS_WIN), MROWS, 2048, 1024); g.aperm = 1; pg8::ChainOrder S; S.init(8, G, bx);
        pg8::EpiConvPair<1, false> E{RS, a.in[3], DM, 0, CVC, DM, exch, epc}; pg8::gemm_phase(lds, g, S, E); }
    SEAM(PH_INCV);
    if (IN(PH_INB)) { const pg8::Gemm g = pg8::dense(HB, (const bf16_t*)(ws + WS_WIN) + (size_t)2048 * 1024, MROWS, 1024, 1024); pg8::StaticOrder S; S.init(MROWS, 1024, G, bx);
        pg8::EpiMulB E{RS, CVC, Y}; pg8::gemm_phase(lds, g, S, E); }
    SEAM(PH_INB);
    if (IN(PH_OUTPROJ)) { const pg8::Gemm g = pg8::dense(Y, (const bf16_t*)(ws + WS_WOUT), MROWS, 1024, 1024); pg8::StaticOrder S; S.init(MROWS, 1024, G, bx);
        pg8::EpiResid<true, false> E{x_in, HB, nullptr, SSP}; pg8::gemm_phase(lds, g, S, E); }
    SEAM(PH_OUTPROJ);
    if (IN(PH_UP0)) { pg8::Gemm g = pg8::dense(HB, (const bf16_t*)(ws + WS_WUP0), MROWS, 5632, 1024); g.aperm = 1; pg8::ChainOrder S; S.init(22, G, bx);
        pg8::EpiConvPair<0, true> E{SSP, a.in[7], 5632, DFF, ACT, DFF, exch, epc}; pg8::gemm_phase(lds, g, S, E); }
    SEAM(PH_UP0);
    if (IN(PH_DN0)) { const pg8::Gemm g = pg8::dense(ACT, (const bf16_t*)(ws + WS_WDN0), MROWS, 1024, 2816); pg8::StaticOrder S; S.init(MROWS, 1024, G, bx);
        pg8::EpiResid<false, false> E{nullptr, HB, nullptr, SSP}; pg8::gemm_phase(lds, g, S, E); }
    SEAM(PH_DN0);
    if (IN(PH_KVQG)) { const pg8::Gemm g = pg8::dense(HB, (const bf16_t*)(ws + WS_WKVQG), MROWS, NKVQG, 1024); pg8::StaticOrder S; S.init(MROWS, NKVQG, G, bx);
        pg8::EpiKVQG E{SSP, (bf16_t*)(ws + WS_KV), (bf16_t*)(ws + WS_Q), (float*)(ws + WS_GATE)}; pg8::gemm_phase(lds, g, S, E); }
    SEAM(PH_KVQG);
    if (IN(PH_CMP)) { pg8::Gemm g = pg8::dense((const bf16_t*)(ws + WS_KV), (const bf16_t*)(ws + WS_W1T), 16384, 512, 2048);
        g.amode = 1; g.a_kstep = (size_t)NKV * 2; g.a_hstep = (size_t)32 * 16 * NKV * 2; g.a_tstep = (size_t)1024 * NKV * 2; g.a_pnstep = 512;
        pg8::StaticOrder S; S.init(16384, 512, G, bx); pg8::EpiCmpHidden E{(const float*)(ws + WS_B1F), (float*)(ws + WS_HID)}; pg8::gemm_phase(lds, g, S, E); }
    SEAM(PH_CMP);
    if (IN(PH_CMP2)) compress_out_phase(a, lds);
    SEAM(PH_CMP2);
    if (IN(PH_ATTN)) attn_mfma_phase(a, lds);
    SEAM(PH_ATTN);
    if (IN(PH_WO)) { const pg8::Gemm g = pg8::dense(Y, (const bf16_t*)(ws + WS_WO), MROWS, 1024, 1024); pg8::StaticOrder S; S.init(MROWS, 1024, G, bx);
        pg8::EpiResid<false, false> E{nullptr, HB, nullptr, SSP}; pg8::gemm_phase(lds, g, S, E); }
    SEAM(PH_WO);
    if (IN(PH_UP1)) { pg8::Gemm g = pg8::dense(HB, (const bf16_t*)(ws + WS_WUP1), MROWS, 5632, 1024); g.aperm = 1; pg8::ChainOrder S; S.init(22, G, bx);
        pg8::EpiConvPair<0, true> E{SSP, a.in[7] + 3 * 5632, 5632, DFF, ACT, DFF, exch, epc}; pg8::gemm_phase(lds, g, S, E); }
    SEAM(PH_UP1);
    if (IN(PH_DN1)) { const pg8::Gemm g = pg8::dense(ACT, (const bf16_t*)(ws + WS_WDN1), MROWS, 1024, 2816); pg8::StaticOrder S; S.init(MROWS, 1024, G, bx);
        pg8::EpiResid<false, false> E{nullptr, HB, nullptr, SSP}; pg8::gemm_phase(lds, g, S, E); }
    SEAM(PH_DN1);
    if (IN(PH_FINAL)) final_phase(xo, HB, SSP, a.in[18], 0, MROWS);
#undef IN
#undef SEAM
}

extern "C" void kernel_launch(void* const* d_in, const int* in_sizes, int n_in, void* d_out, int out_size, void* d_ws, size_t ws_size, hipStream_t stream) {
    static int grid = 0;
    if (grid == 0) {
        if (n_in != 19 || ws_size < WS_END) { fprintf(stderr, "kernel_launch: unexpected shapes (n_in %d, ws %zu < %zu)\n", n_in, ws_size, (size_t)WS_END); grid = -1; return; }
        int dev = 0, cus = 0;
        (void)hipGetDevice(&dev); (void)hipDeviceGetAttribute(&cus, hipDeviceAttributeMultiprocessorCount, dev);
        if (hipFuncSetAttribute((const void*)mk_fwd, hipFuncAttributeMaxDynamicSharedMemorySize, LDS_BYTES) != hipSuccess) { fprintf(stderr, "kernel_launch: hipFuncSetAttribute failed\n"); grid = -1; return; }
        int per_cu = 0;
        if (hipOccupancyMaxActiveBlocksPerMultiprocessor(&per_cu, (const void*)mk_fwd, NTHREADS, LDS_BYTES) != hipSuccess || per_cu < 1) per_cu = 1;
        (void)hipGetLastError();
        grid = (cus > 0 ? cus : 256) * per_cu;
    }
    if (grid < 0) return;
    Args a{};
    for (int i = 0; i < 19; ++i) a.in[i] = (const float*)d_in[i];
    a.out = (float*)d_out; a.ws = (unsigned char*)d_ws;
    (void)hipMemsetAsync((unsigned char*)d_ws + WS_BAR, 0, 16384, stream);
    a.ph_lo = 0; a.ph_hi = PH_COUNT;
    void* kargs[] = {&a};
    hipError_t e = hipLaunchCooperativeKernel((const void*)mk_fwd, dim3(grid), dim3(NTHREADS), kargs, LDS_BYTES, stream);
    if (e != hipSuccess) fprintf(stderr, "cooperative launch failed: %s (grid %d)\n", hipGetErrorString(e), grid);
}
```

```cpp
#include <hip/hip_runtime.h>
#include <hip/hip_cooperative_groups.h>
#include <cstdio>
#include <type_traits>
namespace cg = cooperative_groups;

#define LAS __attribute__((address_space(3)))
typedef unsigned short bf16_t;
typedef short bf16x8 __attribute__((ext_vector_type(8)));
typedef float f32x4 __attribute__((ext_vector_type(4)));
typedef float f32x2 __attribute__((ext_vector_type(2)));
typedef unsigned u32x4 __attribute__((ext_vector_type(4)));
typedef unsigned u32x2 __attribute__((ext_vector_type(2)));

constexpr int NB = 32, SEQ = 2048, DM = 1024, DFF = 2816, MROWS = NB * SEQ;
constexpr int NKV = 1536, NQG = 1072, NKVQG = 2816, NCMP = 127;
constexpr int NTHREADS = 512;
constexpr int EPC_OFF = 147456 + 16, LDS_BYTES = EPC_OFF + 8192;

constexpr size_t WS_WIN = 0;
constexpr size_t WS_WOUT = WS_WIN + (size_t)3072 * 1024 * 2;
constexpr size_t WS_WUP0 = WS_WOUT + (size_t)1024 * 1024 * 2;
constexpr size_t WS_WUP1 = WS_WUP0 + (size_t)5632 * 1024 * 2;
constexpr size_t WS_WDN0 = WS_WUP1 + (size_t)5632 * 1024 * 2;
constexpr size_t WS_WDN1 = WS_WDN0 + (size_t)1024 * 2816 * 2;
constexpr size_t WS_WKVQG = WS_WDN1 + (size_t)1024 * 2816 * 2;
constexpr size_t WS_WO = WS_WKVQG + (size_t)2816 * 1024 * 2;
constexpr size_t WS_W1T = WS_WO + (size_t)1024 * 1024 * 2;
constexpr size_t WS_B1F = WS_W1T + (size_t)2 * 256 * 2048 * 2;
constexpr size_t WS_HB = 56ull << 20;
constexpr size_t WS_BIG = WS_HB + (size_t)MROWS * 1024 * 2;
constexpr size_t WS_KV = WS_BIG;
constexpr size_t WS_Q = WS_BIG + (size_t)MROWS * NKV * 2;
constexpr size_t WS_Y = WS_BIG + (size_t)MROWS * DFF * 2;
constexpr size_t WS_RAW = WS_Y + (size_t)MROWS * 1024 * 2;
constexpr size_t WS_GATE = WS_RAW + (size_t)16384 * 5632 * 2;
constexpr size_t WS_KCMP = WS_GATE + (size_t)MROWS * 48 * 4;
constexpr size_t WS_RS = WS_KCMP + (size_t)2 * 32 * 128 * 4 * 64 * 4;
constexpr size_t WS_KCB = WS_RS + (size_t)MROWS * 4;
constexpr size_t WS_HID = WS_KCB + (size_t)2 * 32 * 128 * 4 * 64 * 2;
constexpr size_t WS_SSP = WS_HID + (size_t)2 * 16384 * 128 * 4;
constexpr size_t WS_BAR = WS_SSP + (size_t)MROWS * 16 * 4;
constexpr size_t WS_END = WS_BAR + 16384;

__device__ __forceinline__ float bf2f(bf16_t b) { return __uint_as_float(((unsigned)b) << 16); }
__device__ __forceinline__ bf16_t f2bf(float f) { unsigned u = __float_as_uint(f); u += 0x7fffu + ((u >> 16) & 1u); return (bf16_t)(u >> 16); }
__device__ __forceinline__ unsigned cvt_pk_bf16(float lo, float hi) { unsigned r; asm volatile("v_cvt_pk_bf16_f32 %0, %1, %2" : "=v"(r) : "v"(lo), "v"(hi)); return r; }
__device__ __forceinline__ float wave_sum(float v) { for (int o = 32; o >= 1; o >>= 1) v += __shfl_xor(v, o); return v; }
__device__ __forceinline__ float wave_max(float v) { for (int o = 32; o >= 1; o >>= 1) v = fmaxf(v, __shfl_xor(v, o)); return v; }

__device__ __forceinline__ float gelu_tanh(float x) { const float u = 0.7978845608028654f * (x + 0.044715f * x * x * x); return 0.5f * x * (1.0f + tanhf(u)); }
struct Args { const float* in[19]; float* out; unsigned char* ws; int ph_lo, ph_hi, seq0, nseq, nchunk, pad; };

namespace pg8 {
constexpr int BM = 256, BK = 64, HALF = 128, HTB = HALF * BK * 2, STAGE_BYTES = 8 * HTB, NXCD = 8, WGM = 8;
__host__ __device__ __forceinline__ int lds_byte(int r, int c) { const int st = (r >> 4) * 2 + (c >> 5), rr = r & 15, cc = c & 31, ob = rr * 64 + cc * 2; return st * 1024 + (ob ^ (((ob >> 9) & 1) << 5)); }
__host__ __device__ __forceinline__ void stage_rc(int b, int& R, int& C) { const int st = b / 1024, sb = b % 1024, swz = sb ^ (((sb >> 9) & 1) << 5); R = (st >> 1) * 16 + swz / 64; C = (st & 1) * 32 + (swz % 64) / 2; }
__host__ __device__ __forceinline__ int perm32(int rho) { const int n = rho >> 4, i = rho & 15; return 8 * (i >> 2) + 4 * n + (i & 3); }
struct Unit { int pm, pn; };
struct Gemm { const bf16_t* A; const bf16_t* Bt; int M, N, K; int amode, aperm; size_t a_kstep, a_hstep, a_tstep, a_pnstep; };
__device__ __forceinline__ Gemm dense(const bf16_t* A, const bf16_t* Bt, int M, int N, int K) { Gemm g; g.A = A; g.Bt = Bt; g.M = M; g.N = N; g.K = K; g.amode = 0; g.aperm = 0; g.a_kstep = 128; g.a_hstep = (size_t)128 * K * 2; g.a_tstep = (size_t)256 * K * 2; g.a_pnstep = 0; return g; }
struct StaticOrder {
    int nM, nN, nwg, G, c;
    __device__ void init(int M, int N, int G_, int c_) { nM = M / BM; nN = N / BM; nwg = nM * nN; G = G_; c = c_; }
    __device__ bool next(int i, Unit& u) const {
        const long L = (long)i * G + c; if (L >= nwg) return false;
        int wgid = (int)L; { const int q = nwg / NXCD, r = nwg % NXCD, xcd = wgid % NXCD, off = wgid / NXCD; wgid = (xcd < r ? xcd * (q + 1) : r * (q + 1) + (xcd - r) * q) + off; }
        const int nig = WGM * nN, gid = wgid / nig, fm = gid * WGM, gsz = (nM - fm) < WGM ? (nM - fm) : WGM;
        u.pm = fm + ((wgid % nig) % gsz); u.pn = (wgid % nig) / gsz; return true;
    }
};

__device__ __forceinline__ float row_scale16(const float* ssp, int row, int fq) {
    const f32x4 p = *(const f32x4*)(ssp + (size_t)row * 16 + 4 * fq); float s = (p[0] + p[1]) + (p[2] + p[3]);
    s += __shfl_xor(s, 16); s += __shfl_xor(s, 32); return rsqrtf(s * (1.0f / DM) + 1e-6f); }
template <bool BASE_F32, bool OUT_F32> struct EpiResid {
    static constexpr bool PERM = true;
    const float* base32; bf16_t* xb; float* out32; float* ssp;
    __device__ __forceinline__ void operator()(f32x4 (&acc)[2][2][4][2], const Unit& u, int ui, int wr, int wc, int fr, int fq) const {
        const int row0 = u.pm * BM + wr * 64 + fr, col0 = u.pn * BM + wc * 32 + 8 * fq;
#pragma unroll
        for (int ai = 0; ai < 2; ++ai) {
            u32x4 bb[4][2]; f32x4 bf[4][2][2];
#pragma unroll
            for (int m = 0; m < 4; ++m)
#pragma unroll
                for (int bj = 0; bj < 2; ++bj) { const size_t o = (size_t)(row0 + ai * HALF + m * 16) * DM + col0 + bj * HALF;
                    if (BASE_F32) { bf[m][bj][0] = *(const f32x4*)(base32 + o); bf[m][bj][1] = *(const f32x4*)(base32 + o + 4); } else bb[m][bj] = *(const u32x4*)(xb + o); }
            __builtin_amdgcn_sched_barrier(0);
#pragma unroll
            for (int m = 0; m < 4; ++m) { const int row = row0 + ai * HALF + m * 16; const size_t off = (size_t)row * DM + col0; float ss = 0.f;
#pragma unroll
                for (int bj = 0; bj < 2; ++bj) { const size_t o = off + bj * HALF; f32x4 v0, v1;
                    if (BASE_F32) { v0 = bf[m][bj][0]; v1 = bf[m][bj][1]; }
                    else { const u32x4 b = bb[m][bj];
                        v0 = (f32x4){__uint_as_float(b.x << 16), __uint_as_float(b.x & 0xffff0000u), __uint_as_float(b.y << 16), __uint_as_float(b.y & 0xffff0000u)};
                        v1 = (f32x4){__uint_as_float(b.z << 16), __uint_as_float(b.z & 0xffff0000u), __uint_as_float(b.w << 16), __uint_as_float(b.w & 0xffff0000u)}; }
                    v0 += acc[ai][bj][m][0]; v1 += acc[ai][bj][m][1];
                    ss += ((v0[0] * v0[0] + v0[1] * v0[1]) + (v0[2] * v0[2] + v0[3] * v0[3])) + ((v1[0] * v1[0] + v1[1] * v1[1]) + (v1[2] * v1[2] + v1[3] * v1[3]));
                    if (OUT_F32) { *(f32x4*)(out32 + o) = v0; *(f32x4*)(out32 + o + 4) = v1; }
                    else { u32x4 w; w.x = cvt_pk_bf16(v0[0], v0[1]); w.y = cvt_pk_bf16(v0[2], v0[3]); w.z = cvt_pk_bf16(v1[0], v1[1]); w.w = cvt_pk_bf16(v1[2], v1[3]); *(u32x4*)(xb + o) = w; } }
                if (!OUT_F32) { ss += __shfl_xor(ss, 16); ss += __shfl_xor(ss, 32); if (fq == 0) ssp[(size_t)row * 16 + u.pn * 4 + wc] = ss; } }
        }
    }
};
struct EpiKVQG {
    static constexpr bool PERM = true;
    const float* ssp; bf16_t* kv; bf16_t* q; float* gate;
    __device__ __forceinline__ void operator()(f32x4 (&acc)[2][2][4][2], const Unit& u, int ui, int wr, int wc, int fr, int fq) const {
        const int row0 = u.pm * BM + wr * 64 + fr, cin = wc * 32 + 8 * fq;
        float rsc[2][4];
#pragma unroll
        for (int ai = 0; ai < 2; ++ai)
#pragma unroll
            for (int m = 0; m < 4; ++m) rsc[ai][m] = row_scale16(ssp, row0 + ai * HALF + m * 16, fq);
#pragma unroll
        for (int ai = 0; ai < 2; ++ai)
#pragma unroll
            for (int m = 0; m < 4; ++m) { const int row = row0 + ai * HALF + m * 16; const float s = rsc[ai][m];
#pragma unroll
                for (int bj = 0; bj < 2; ++bj) { f32x4 v0 = acc[ai][bj][m][0] * s, v1 = acc[ai][bj][m][1] * s; const int col = cin + bj * HALF;
                    if (u.pn < 6) { u32x4 w; w.x = cvt_pk_bf16(v0[0], v0[1]); w.y = cvt_pk_bf16(v0[2], v0[3]); w.z = cvt_pk_bf16(v1[0], v1[1]); w.w = cvt_pk_bf16(v1[2], v1[3]);
                        *(u32x4*)(kv + (size_t)row * NKV + u.pn * BM + col) = w; }
                    else if (u.pn < 10) { v0 *= 0.125f; v1 *= 0.125f; u32x4 w; w.x = cvt_pk_bf16(v0[0], v0[1]); w.y = cvt_pk_bf16(v0[2], v0[3]); w.z = cvt_pk_bf16(v1[0], v1[1]); w.w = cvt_pk_bf16(v1[2], v1[3]);
                        *(u32x4*)(q + (size_t)row * DM + (u.pn - 6) * BM + col) = w; }
                    else if (col < 48) { f32x4 g0, g1;
#pragma unroll
                        for (int j = 0; j < 4; ++j) { g0[j] = 1.0f / (1.0f + __expf(-v0[j])); g1[j] = 1.0f / (1.0f + __expf(-v1[j])); }
                        *(f32x4*)(gate + (size_t)row * 48 + col) = g0; *(f32x4*)(gate + (size_t)row * 48 + col + 4) = g1; } } }
    }
};

struct ChainOrder {
    int nP, nchain_x, G8, xcd, slot; bool live;
    __device__ void init(int nP_, int G, int c) { nP = nP_; G8 = G / 8; xcd = c % 8; slot = c / 8; nchain_x = (NB / 8) * nP; live = c < 8 * G8; }
    __device__ bool next(int i, Unit& u) const {
        const int ci = i >> 3, w = i & 7, Lx = ci * G8 + slot; if (!live || Lx >= nchain_x) return false;
        const int seq = (Lx & 3) * 8 + xcd; u.pn = Lx >> 2; u.pm = seq * 8 + w; return true; }
};
template <int CTRL> __device__ __forceinline__ float dppf(float old, float src) {
    return __builtin_bit_cast(float, __builtin_amdgcn_update_dpp(__builtin_bit_cast(int, old), __builtin_bit_cast(int, src), CTRL, 0xf, 0xf, false)); }

template <int MODE, bool SSP> struct EpiConvPair {
    static constexpr bool PERM = true;
    const float* rs; const float* cw; int cw_ld, goff; bf16_t* O; int ldo; LAS float* exch; LAS float* cache;
    struct Pref { f32x4 w; f32x4 p0, p1; };
    __device__ __forceinline__ void issue(const Unit& nu, Pref& r) const {
        const int tid = threadIdx.x; r.w = (f32x4){0.f, 0.f, 0.f, 0.f};
        if (tid < (MODE == 0 ? 192 : 96)) { const int tt = tid >> 5, type = tt / 3, tap = tt % 3; r.w = *(const f32x4*)(cw + (size_t)tap * cw_ld + type * goff + nu.pn * HALF + (tid & 31) * 4); }
        const size_t row = (size_t)nu.pm * BM + (tid >> 1);
        if (SSP) { r.p0 = *(const f32x4*)(rs + row * 16 + 8 * (tid & 1)); r.p1 = *(const f32x4*)(rs + row * 16 + 8 * (tid & 1) + 4); } else { r.p0 = (f32x4){rs[row], 0.f, 0.f, 0.f}; r.p1 = r.p0; }
    }
    __device__ __forceinline__ void commit(int par, const Pref& r) const {
        const int tid = threadIdx.x; LAS float* c = cache + par * 1024;
        if (tid < (MODE == 0 ? 192 : 96)) *(LAS f32x4*)(c + (tid >> 5) * 128 + (tid & 31) * 4) = r.w;
        float sc;
        if (SSP) { float ss = ((r.p0[0] + r.p0[1]) + (r.p0[2] + r.p0[3])) + ((r.p1[0] + r.p1[1]) + (r.p1[2] + r.p1[3])); ss += dppf<0xB1>(0.f, ss); sc = rsqrtf(ss * (1.0f / DM) + 1e-6f); } else sc = r.p0[0];
        if ((tid & 1) == 0) c[768 + (tid >> 1)] = sc;
    }
    __device__ __forceinline__ void pre(const Unit& u) const { Pref r; issue(u, r); commit(0, r); }
    __device__ __forceinline__ void run(f32x4 (&acc)[2][2][4][2], const Unit& u, int ui, int wr, int wc, int fr, int fq, bool has_next, const Unit& nu) const {
        Pref pf; if (has_next) issue(nu, pf);
        const LAS float* cc = cache + (ui & 1) * 1024;
        const int row0 = u.pm * BM + wr * 64 + 4 * fr, lcol = wc * 32 + 8 * fq, lrow0 = wr * 64 + 4 * fr;
#pragma unroll
        for (int ai = 0; ai < 2; ++ai)
#pragma unroll
            for (int m = 0; m < 4; ++m) { const float sc = cc[768 + lrow0 + ai * HALF + m];
#pragma unroll
                for (int n = 0; n < 2; ++n) { if (MODE == 0) { acc[ai][0][m][n] *= sc; acc[ai][1][m][n] *= sc; } else acc[ai][0][m][n] = (acc[ai][0][m][n] * sc) * (acc[ai][1][m][n] * sc); } }
        LAS float* ex = exch + (ui & 1) * 2048;
        if (fr == 15) {
#pragma unroll
            for (int ai = 0; ai < 2; ++ai)
#pragma unroll
                for (int r = 0; r < 2; ++r) { LAS float* p = ex + ((ai * 2 + wr) * 2 + r) * 256 + lcol;
                    *(LAS f32x4*)p = acc[ai][0][2 + r][0]; *(LAS f32x4*)(p + 4) = acc[ai][0][2 + r][1];
                    if (MODE == 0) { *(LAS f32x4*)(p + 128) = acc[ai][1][2 + r][0]; *(LAS f32x4*)(p + 132) = acc[ai][1][2 + r][1]; } } }
        asm volatile("s_waitcnt lgkmcnt(0)" ::: "memory"); __builtin_amdgcn_s_barrier(); asm volatile("" ::: "memory"); __builtin_amdgcn_s_barrier(); asm volatile("" ::: "memory");
        const int f = u.pn * HALF + lcol;
        u32x2 keep[2][4];
#pragma unroll
        for (int n = 0; n < 2; ++n) {
            f32x4 wa[3], wg[3];
#pragma unroll
            for (int k = 0; k < 3; ++k) { wa[k] = *(const LAS f32x4*)(cc + k * 128 + lcol + 4 * n); if (MODE == 0) wg[k] = *(const LAS f32x4*)(cc + (3 + k) * 128 + lcol + 4 * n); }
#pragma unroll
            for (int ai = 0; ai < 2; ++ai) {
                const int blk = ai * 2 + wr;
                f32x4 ba2 = (f32x4){0.f, 0.f, 0.f, 0.f}, ba3 = ba2, bg2 = ba2, bg3 = ba2;
                const LAS float* src = nullptr;
                if (blk > 0) src = ex + (blk - 1) * 512; else if ((u.pm & 7) != 0) src = exch + ((ui & 1) ^ 1) * 2048 + 3 * 512;
                if (src != nullptr) { const LAS float* p = src + lcol + 4 * n; ba2 = *(const LAS f32x4*)p; ba3 = *(const LAS f32x4*)(p + 256);
                    if (MODE == 0) { bg2 = *(const LAS f32x4*)(p + 128); bg3 = *(const LAS f32x4*)(p + 256 + 128); } }
                float o[4][4];
#pragma unroll
                for (int j = 0; j < 4; ++j) {
                    const float v0 = acc[ai][0][0][n][j], v1 = acc[ai][0][1][n][j], v2 = acc[ai][0][2][n][j], v3 = acc[ai][0][3][n][j];
                    const float p2 = dppf<0x111>(ba2[j], v2), p3 = dppf<0x111>(ba3[j], v3);
                    const float w0 = wa[0][j], w1 = wa[1][j], w2 = wa[2][j];
                    float y[4] = {w2 * v0 + w1 * p3 + w0 * p2, w2 * v1 + w1 * v0 + w0 * p3, w2 * v2 + w1 * v1 + w0 * v0, w2 * v3 + w1 * v2 + w0 * v1};
                    if (MODE == 0) {
                        const float g0 = acc[ai][1][0][n][j], g1 = acc[ai][1][1][n][j], g2 = acc[ai][1][2][n][j], g3 = acc[ai][1][3][n][j];
                        const float q2 = dppf<0x111>(bg2[j], g2), q3 = dppf<0x111>(bg3[j], g3);
                        const float x0 = wg[0][j], x1 = wg[1][j], x2 = wg[2][j];
                        const float z[4] = {x2 * g0 + x1 * q3 + x0 * q2, x2 * g1 + x1 * g0 + x0 * q3, x2 * g2 + x1 * g1 + x0 * g0, x2 * g3 + x1 * g2 + x0 * g1};
#pragma unroll
                        for (int m = 0; m < 4; ++m) o[m][j] = y[m] * __builtin_amdgcn_rcpf(1.0f + __expf(-y[m])) * z[m];
                    } else {
#pragma unroll
                        for (int m = 0; m < 4; ++m) o[m][j] = y[m];
                    }
                }
#pragma unroll
                for (int m = 0; m < 4; ++m) { u32x2 w; w.x = cvt_pk_bf16(o[m][0], o[m][1]); w.y = cvt_pk_bf16(o[m][2], o[m][3]);
                    if (n == 0) keep[ai][m] = w;
                    else { u32x4 w4; w4.x = keep[ai][m].x; w4.y = keep[ai][m].y; w4.z = w.x; w4.w = w.y; __builtin_nontemporal_store(w4, (u32x4*)(O + (size_t)(row0 + ai * HALF + m) * ldo + f)); } }
            }
            __builtin_amdgcn_sched_barrier(0);
        }
        if (has_next) commit((ui & 1) ^ 1, pf);
    }
};
template <class T, class = void> struct has_pre : std::false_type {};
template <class T> struct has_pre<T, std::void_t<decltype(&T::pre)>> : std::true_type {};
struct EpiCmpHidden {
    static constexpr bool PERM = true;
    const float* b1f; float* H;
    __device__ __forceinline__ void operator()(f32x4 (&acc)[2][2][4][2], const Unit& u, int ui, int wr, int wc, int fr, int fq) const {
        const int row0 = u.pm * BM + wr * 64 + fr, col = wc * 32 + 8 * fq;
        const f32x4 b0 = *(const f32x4*)(b1f + u.pn * 128 + col), b1 = *(const f32x4*)(b1f + u.pn * 128 + col + 4);
#pragma unroll
        for (int ai = 0; ai < 2; ++ai)
#pragma unroll
            for (int m = 0; m < 4; ++m) { const int row = row0 + ai * HALF + m * 16; f32x4 v0 = acc[ai][0][m][0] + b0, v1 = acc[ai][0][m][1] + b1;
#pragma unroll
                for (int j = 0; j < 4; ++j) { v0[j] = gelu_tanh(v0[j]); v1[j] = gelu_tanh(v1[j]); }
                float* hp = H + ((size_t)u.pn * 16384 + row) * 128 + col; *(f32x4*)hp = v0; *(f32x4*)(hp + 4) = v1; }
    }
};
struct EpiMulB {
    static constexpr bool PERM = true;
    const float* rs; const bf16_t* other; bf16_t* Yo;
    __device__ __forceinline__ void operator()(f32x4 (&acc)[2][2][4][2], const Unit& u, int ui, int wr, int wc, int fr, int fq) const {
        const int row0 = u.pm * BM + wr * 64 + fr, col0 = u.pn * BM + wc * 32 + 8 * fq;
#pragma unroll
        for (int ai = 0; ai < 2; ++ai) {
            float sc[4]; bf16x8 ov[4][2];
#pragma unroll
            for (int m = 0; m < 4; ++m) { const int row = row0 + ai * HALF + m * 16; sc[m] = rs[row];
#pragma unroll
                for (int bj = 0; bj < 2; ++bj) ov[m][bj] = *(const bf16x8*)(other + (size_t)row * DM + col0 + bj * HALF); }
            __builtin_amdgcn_sched_barrier(0);
#pragma unroll
            for (int m = 0; m < 4; ++m) { const int row = row0 + ai * HALF + m * 16;
#pragma unroll
                for (int bj = 0; bj < 2; ++bj) { const size_t o = (size_t)row * DM + col0 + bj * HALF; const bf16x8 q = ov[m][bj];
                    const f32x4 v0 = acc[ai][bj][m][0] * sc[m], v1 = acc[ai][bj][m][1] * sc[m]; u32x4 w;
                    w.x = cvt_pk_bf16(v0[0] * bf2f((bf16_t)q[0]), v0[1] * bf2f((bf16_t)q[1])); w.y = cvt_pk_bf16(v0[2] * bf2f((bf16_t)q[2]), v0[3] * bf2f((bf16_t)q[3]));
                    w.z = cvt_pk_bf16(v1[0] * bf2f((bf16_t)q[4]), v1[1] * bf2f((bf16_t)q[5])); w.w = cvt_pk_bf16(v1[2] * bf2f((bf16_t)q[6]), v1[3] * bf2f((bf16_t)q[7]));
                    *(u32x4*)(Yo + o) = w; } }
        }
    }
};

template <class Epi, class Sched>
__device__ __forceinline__ void gemm_phase(LAS unsigned char* lds, const Gemm g, const Sched& S, const Epi& E) {
    int tid_ = threadIdx.x; asm volatile("" : "+v"(tid_));
    const int tid = tid_, wid = __builtin_amdgcn_readfirstlane(tid >> 6), lane = tid & 63, wr = wid >> 2, wc = wid & 3, fr = lane & 15, fq = lane >> 4;
    const int K = g.K, nt = K / BK;
    unsigned voffA[2], voffB[2];
#pragma unroll
    for (int i = 0; i < 2; ++i) { int R, C; stage_rc(tid * 16 + i * 8192, R, C); const int Rb = Epi::PERM ? ((R & ~31) + perm32(R & 31)) : R;
        const int Ra = g.aperm ? ((R & ~63) | ((R & 15) << 2) | ((R >> 4) & 3)) : R;
        voffA[i] = g.amode ? (unsigned)((R >> 2) * (16 * NKV) + (R & 3) * 64 + C) * 2u : (unsigned)(Ra * K + C) * 2u; voffB[i] = (unsigned)(Rb * K + C) * 2u; }
    const size_t kstep = (size_t)(BK * 2), hstep = (size_t)HALF * K * 2, tstep = 2 * hstep;
    const size_t akstep = g.a_kstep, ahstep = g.a_hstep, atstep = g.a_tstep;
    const unsigned ldsw = (unsigned)wid * 1024u;
    const int aoff = lds_byte(wr * 64 + fr, fq * 8), boff = lds_byte(wc * 32 + fr, fq * 8);
#define PG8_SA(b, h) (((b) * 2 + (h)) * HTB)
#define PG8_SB(b, h) ((4 + (b) * 2 + (h)) * HTB)
#define PG8_STAGE(bufoff, gbase, voff) do { _Pragma("unroll") for (int _i = 0; _i < 2; ++_i) \
        __builtin_amdgcn_global_load_lds((const unsigned*)((const char*)(gbase) + (voff)[_i]), (LAS unsigned*)(lds + (bufoff) + ldsw + _i * 8192), 16, 0, 0); } while (0)
#define PG8_LDA(dst, b, h) do { _Pragma("unroll") for (int m = 0; m < 4; ++m) _Pragma("unroll") for (int k = 0; k < 2; ++k) dst[m][k] = *(const LAS bf16x8*)(lds + PG8_SA(b, h) + aoff + m * 2048 + k * 1024); } while (0)
#define PG8_LDB(dst, b, h) do { _Pragma("unroll") for (int n = 0; n < 2; ++n) _Pragma("unroll") for (int k = 0; k < 2; ++k) dst[n][k] = *(const LAS bf16x8*)(lds + PG8_SB(b, h) + boff + n * 2048 + k * 1024); } while (0)
#define PG8_MMA(ai, bj, At, Bt) do { __builtin_amdgcn_s_setprio(1); _Pragma("unroll") for (int m = 0; m < 4; ++m) _Pragma("unroll") for (int n = 0; n < 2; ++n) _Pragma("unroll") for (int k = 0; k < 2; ++k) \
        acc[ai][bj][m][n] = __builtin_amdgcn_mfma_f32_16x16x32_bf16(Bt[n][k], At[m][k], acc[ai][bj][m][n], 0, 0, 0); __builtin_amdgcn_s_setprio(0); } while (0)
#define PG8_WAIT_V(n) asm volatile("s_waitcnt vmcnt(" #n ")" ::: "memory")
#define PG8_WAIT_L(n) asm volatile("s_waitcnt lgkmcnt(" #n ")" ::: "memory")
#define PG8_BAR __builtin_amdgcn_s_barrier()
#define PG8_SCHED __builtin_amdgcn_sched_barrier(0)
    Unit cur, nxt; int ui = 0;
    if (!S.next(0, cur)) return;
    if constexpr (has_pre<Epi>::value) E.pre(cur);
    f32x4 acc[2][2][4][2];
#pragma unroll
    for (int a = 0; a < 2; ++a)
#pragma unroll
        for (int b = 0; b < 2; ++b)
#pragma unroll
            for (int m = 0; m < 4; ++m)
#pragma unroll
                for (int n = 0; n < 2; ++n) acc[a][b][m][n] = (f32x4){0.f, 0.f, 0.f, 0.f};
    bf16x8 At[4][2], B0[2][2], B1[2][2];
    const char* cA = (const char*)g.A + (size_t)cur.pm * atstep + (size_t)cur.pn * g.a_pnstep; const char* cB = (const char*)g.Bt + (size_t)cur.pn * tstep;
    PG8_STAGE(PG8_SB(0, 0), cB, voffB); PG8_STAGE(PG8_SA(0, 0), cA, voffA); PG8_STAGE(PG8_SB(0, 1), cB + hstep, voffB); PG8_STAGE(PG8_SA(0, 1), cA + ahstep, voffA);
    if (wr == 1) PG8_BAR;
    PG8_WAIT_V(4); PG8_BAR;
    PG8_STAGE(PG8_SB(1, 0), cB + kstep, voffB); PG8_STAGE(PG8_SA(1, 0), cA + akstep, voffA); PG8_STAGE(PG8_SB(1, 1), cB + hstep + kstep, voffB);
    PG8_WAIT_V(6); PG8_BAR;
    for (;;) {
        const bool has_next = S.next(ui + 1, nxt);
        const char* nA = has_next ? (const char*)g.A + (size_t)nxt.pm * atstep + (size_t)nxt.pn * g.a_pnstep : cA; const char* nB = has_next ? (const char*)g.Bt + (size_t)nxt.pn * tstep : cB;
        for (int t = 0; t < nt; t += 2) {
            const bool last = (t == nt - 2);
            const char* a1 = cA + (size_t)(t + 1) * akstep;
            const char* a2 = last ? nA : cA + (size_t)(t + 2) * akstep; const char* b2 = last ? nB : cB + (size_t)(t + 2) * kstep;
            const char* a3 = a2 + akstep; const char* b3 = b2 + kstep;
            PG8_LDB(B0, 0, 0); PG8_SCHED; PG8_LDA(At, 0, 0); PG8_STAGE(PG8_SA(1, 1), a1 + ahstep, voffA);
            PG8_WAIT_L(8); PG8_BAR; PG8_WAIT_L(0); PG8_MMA(0, 0, At, B0); PG8_BAR; PG8_SCHED;
            PG8_LDB(B1, 0, 1); PG8_STAGE(PG8_SB(0, 0), b2, voffB);
            PG8_BAR; PG8_WAIT_L(0); PG8_MMA(0, 1, At, B1); PG8_BAR;
            PG8_LDA(At, 0, 1); PG8_STAGE(PG8_SA(0, 0), a2, voffA);
            PG8_BAR; PG8_WAIT_L(0); PG8_MMA(1, 0, At, B0); PG8_BAR; PG8_SCHED;
            PG8_STAGE(PG8_SB(0, 1), b2 + hstep, voffB);
            PG8_WAIT_V(6); PG8_BAR; PG8_MMA(1, 1, At, B1); PG8_BAR;
            PG8_LDB(B0, 1, 0); PG8_SCHED; PG8_LDA(At, 1, 0); PG8_STAGE(PG8_SA(0, 1), a2 + ahstep, voffA);
            PG8_WAIT_L(8); PG8_BAR; PG8_WAIT_L(0); PG8_MMA(0, 0, At, B0); PG8_BAR; PG8_SCHED;
            PG8_LDB(B1, 1, 1); PG8_STAGE(PG8_SB(1, 0), b3, voffB);
            PG8_BAR; PG8_WAIT_L(0); PG8_MMA(0, 1, At, B1); PG8_BAR;
            PG8_LDA(At, 1, 1); PG8_STAGE(PG8_SA(1, 0), a3, voffA);
            PG8_BAR; PG8_WAIT_L(0); PG8_MMA(1, 0, At, B0); PG8_BAR; PG8_SCHED;
            PG8_STAGE(PG8_SB(1, 1), b3 + hstep, voffB);
            PG8_WAIT_V(6); PG8_BAR; PG8_MMA(1, 1, At, B1); PG8_BAR;
        }
        if constexpr (has_pre<Epi>::value) E.run(acc, cur, ui, wr, wc, fr, fq, has_next, nxt); else E(acc, cur, ui, wr, wc, fr, fq);
        if (!has_next) break;
#pragma unroll
        for (int a = 0; a < 2; ++a)
#pragma unroll
            for (int b = 0; b < 2; ++b)
#pragma unroll
                for (int m = 0; m < 4; ++m)
#pragma unroll
                    for (int n = 0; n < 2; ++n) acc[a][b][m][n] = (f32x4){0.f, 0.f, 0.f, 0.f};
        cur = nxt; cA = nA; cB = nB; ++ui;
    }
    PG8_WAIT_V(0);
    if (wr == 0) PG8_BAR;
    PG8_BAR;
#undef PG8_SA
#undef PG8_SB
#undef PG8_STAGE
#undef PG8_LDA
#undef PG8_LDB
#undef PG8_MMA
#undef PG8_WAIT_V
#undef PG8_WAIT_L
#undef PG8_BAR
#undef PG8_SCHED
}
}

struct TrJob { const float* W0; int ld0, n0; const float* W1; int ld1, n1; const float* g0; const float* g1; int mode, pb0, pb1; bf16_t* Wt; int K, Nout; };
__device__ __forceinline__ TrJob get_job(int j, const Args& a) {
    unsigned char* ws = a.ws; TrJob t{}; t.W1 = nullptr; t.ld1 = 0; t.n1 = 0; t.g0 = nullptr; t.g1 = nullptr; t.mode = 0; t.pb0 = 0; t.pb1 = 0;
    switch (j) {
    case 0: t.W0 = a.in[2]; t.ld0 = 3072; t.n0 = 0; t.g0 = a.in[1]; t.mode = 1; t.pb0 = 1024; t.pb1 = 2048; t.Wt = (bf16_t*)(ws + WS_WIN); t.K = 1024; t.Nout = 2048; break;
    case 1: t.W0 = a.in[2]; t.ld0 = 3072; t.n0 = 1024; t.g0 = a.in[1]; t.Wt = (bf16_t*)(ws + WS_WIN) + (size_t)2048 * 1024; t.K = 1024; t.Nout = 1024; break;
    case 2: t.W0 = a.in[4]; t.ld0 = 1024; t.n0 = 1024; t.Wt = (bf16_t*)(ws + WS_WOUT); t.K = 1024; t.Nout = 1024; break;
    case 3: t.W0 = a.in[6]; t.ld0 = 5632; t.g0 = a.in[5]; t.mode = 1; t.pb0 = 0; t.pb1 = 2816; t.Wt = (bf16_t*)(ws + WS_WUP0); t.K = 1024; t.Nout = 5632; break;
    case 4: t.W0 = a.in[6] + (size_t)1024 * 5632; t.ld0 = 5632; t.g0 = a.in[5] + 1024; t.mode = 1; t.pb0 = 0; t.pb1 = 2816; t.Wt = (bf16_t*)(ws + WS_WUP1); t.K = 1024; t.Nout = 5632; break;
    case 5: t.W0 = a.in[8]; t.ld0 = 1024; t.n0 = 1024; t.Wt = (bf16_t*)(ws + WS_WDN0); t.K = 2816; t.Nout = 1024; break;
    case 6: t.W0 = a.in[8] + (size_t)2816 * 1024; t.ld0 = 1024; t.n0 = 1024; t.Wt = (bf16_t*)(ws + WS_WDN1); t.K = 2816; t.Nout = 1024; break;
    case 7: t.W0 = a.in[10]; t.ld0 = 1536; t.n0 = 1536; t.g0 = a.in[9]; t.W1 = a.in[15]; t.ld1 = 1072; t.n1 = 1072; t.g1 = a.in[1] + 1024; t.Wt = (bf16_t*)(ws + WS_WKVQG); t.K = 1024; t.Nout = 2816; break;
    case 8: t.W0 = a.in[16]; t.ld0 = 1024; t.n0 = 1024; t.Wt = (bf16_t*)(ws + WS_WO); t.K = 1024; t.Nout = 1024; break;
    case 9: t.W0 = a.in[12]; t.ld0 = 128; t.n0 = 128; t.Wt = (bf16_t*)(ws + WS_W1T); t.K = 2048; t.Nout = 256; break;
    default: t.W0 = a.in[12] + (size_t)2048 * 128; t.ld0 = 128; t.n0 = 128; t.Wt = (bf16_t*)(ws + WS_W1T) + (size_t)256 * 2048; t.K = 2048; t.Nout = 256; break;
    }
    return t;
}
__device__ __forceinline__ void wprep_phase(const Args& a, LAS unsigned char* lds) {
    LAS float* tile = (LAS float*)lds;
    const int tid = threadIdx.x, tx = tid & 63, ty = tid >> 6;
    int jstart = 0;
    for (int j = 0; j < 11; ++j) {
        const TrJob t = get_job(j, a);
        const int nkt = t.K / 64, nnt = t.Nout / 64, ntile = nkt * nnt;
        int first = ((int)blockIdx.x - jstart % (int)gridDim.x + (int)gridDim.x) % (int)gridDim.x;
        for (int ti = first; ti < ntile; ti += gridDim.x) {
            const int kt = ti % nkt, ntl = ti / nkt, k0 = kt * 64, n0 = ntl * 64;
            const int n = n0 + tx; const float* src = nullptr; int ld = 0; const float* gp = t.g0;
            if (t.mode == 1) { const int p = n >> 8, half = (n >> 7) & 1, c = n & 127; src = t.W0 + (half ? t.pb1 : t.pb0) + 128 * p + c; ld = t.ld0; }
            else if (n < t.n0) { src = t.W0 + n; ld = t.ld0; }
            else if (n - t.n0 < t.n1) { src = t.W1 + (n - t.n0); ld = t.ld1; gp = t.g1; }
            __syncthreads();
#pragma unroll
            for (int i = 0; i < 8; ++i) { const int k = k0 + ty + 8 * i; float v = 0.f; if (src) { v = src[(size_t)k * ld]; if (gp) v *= gp[k]; } tile[(ty + 8 * i) * 65 + tx] = v; }
            __syncthreads();
            { const int nn = tid >> 3, kc = (tid & 7) * 8; u32x4 w;
                w.x = cvt_pk_bf16(tile[(kc + 0) * 65 + nn], tile[(kc + 1) * 65 + nn]); w.y = cvt_pk_bf16(tile[(kc + 2) * 65 + nn], tile[(kc + 3) * 65 + nn]);
                w.z = cvt_pk_bf16(tile[(kc + 4) * 65 + nn], tile[(kc + 5) * 65 + nn]); w.w = cvt_pk_bf16(tile[(kc + 6) * 65 + nn], tile[(kc + 7) * 65 + nn]);
                *(u32x4*)(t.Wt + (size_t)(n0 + nn) * t.K + k0 + kc) = w; }
        }
        jstart += ntile;
    }
    if (tid < 64) for (int idx = blockIdx.x; idx < 256; idx += gridDim.x) { const int j = idx >> 7, n = idx & 127; float sacc = 0.f;
            for (int k = tid; k < 2048; k += 64) sacc += a.in[11][j * 2048 + k] * a.in[12][((size_t)j * 2048 + k) * 128 + n];
            sacc = wave_sum(sacc); if (tid == 0) ((float*)(a.ws + WS_B1F))[idx] = sacc + a.in[13][idx]; }
    __syncthreads();
}

__device__ __forceinline__ void rowstat_phase(const float* src, bf16_t* dstb, float* rs, int row0, int nrows) {
    const int wave = threadIdx.x >> 6, lane = threadIdx.x & 63;
    for (int r = blockIdx.x * 8 + wave; r < nrows; r += gridDim.x * 8) {
        const size_t row = (size_t)(row0 + r); const float* p = src + row * DM; float ss = 0.f;
#pragma unroll
        for (int i = 0; i < 2; ++i) { const int c = i * 512 + lane * 8; const f32x4 v0 = *(const f32x4*)(p + c), v1 = *(const f32x4*)(p + c + 4);
            ss += ((v0[0] * v0[0] + v0[1] * v0[1]) + (v0[2] * v0[2] + v0[3] * v0[3])) + ((v1[0] * v1[0] + v1[1] * v1[1]) + (v1[2] * v1[2] + v1[3] * v1[3]));
            if (dstb) { u32x4 w; w.x = cvt_pk_bf16(v0[0], v0[1]); w.y = cvt_pk_bf16(v0[2], v0[3]); w.z = cvt_pk_bf16(v1[0], v1[1]); w.w = cvt_pk_bf16(v1[2], v1[3]); *(u32x4*)(dstb + row * DM + c) = w; } }
        ss = wave_sum(ss);
        if (lane == 0) rs[row] = rsqrtf(ss * (1.0f / DM) + 1e-6f);
    }
}
__device__ __forceinline__ void final_phase(float* out, const bf16_t* xb, const float* ssp, const float* gain, int row0, int nrows) {
    const int wave = threadIdx.x >> 6, lane = threadIdx.x & 63;
    for (int r = blockIdx.x * 8 + wave; r < nrows; r += gridDim.x * 8) {
        const size_t row = (size_t)(row0 + r);
        float ss = lane < 16 ? ssp[row * 16 + lane] : 0.f; ss = wave_sum(ss);
        const float sc = rsqrtf(ss * (1.0f / DM) + 1e-6f);
#pragma unroll
        for (int i = 0; i < 2; ++i) { const int c = i * 512 + lane * 8; const bf16x8 v = *(const bf16x8*)(xb + row * DM + c);
            const f32x4 g0 = *(const f32x4*)(gain + c), g1 = *(const f32x4*)(gain + c + 4);
            f32x4 o0, o1;
#pragma unroll
            for (int j = 0; j < 4; ++j) { o0[j] = bf2f((bf16_t)v[j]) * sc * g0[j]; o1[j] = bf2f((bf16_t)v[4 + j]) * sc * g1[j]; }
            __builtin_nontemporal_store(o0, (f32x4*)(out + row * DM + c)); __builtin_nontemporal_store(o1, (f32x4*)(out + row * DM + c + 4)); }
    }
}
__device__ __forceinline__ void compress_out_phase(const Args& a, LAS unsigned char* lds) {
    const float* H = (const float*)(a.ws + WS_HID); bf16_t* kcb = (bf16_t*)(a.ws + WS_KCB); const float* w2 = a.in[14];
    LAS float* w2s = (LAS float*)lds;
    const int tid = threadIdx.x, wave = tid >> 6, lane = tid & 63;
    LAS float* hrow = w2s + 2 * 128 * 64 + wave * 128;
    for (int e = tid; e < 2 * 128 * 64; e += NTHREADS) w2s[e] = w2[e];
    __syncthreads();
    for (int r = blockIdx.x * 8 + wave; r < 2 * 16384; r += gridDim.x * 8) {
        const int j = r >> 14, row = r & 16383, i = (row >> 2) & 127;
        hrow[lane] = H[(size_t)r * 128 + lane]; hrow[lane + 64] = H[(size_t)r * 128 + 64 + lane];
        asm volatile("s_waitcnt lgkmcnt(0)" ::: "memory");
        float o = 0.f;
#pragma unroll 8
        for (int n = 0; n < 128; ++n) o += hrow[n] * w2s[(j * 128 + n) * 64 + lane];
        kcb[(size_t)r * 64 + lane] = (i == 127) ? (bf16_t)0 : f2bf(o);
        asm volatile("s_waitcnt lgkmcnt(0)" ::: "memory");
    }
    __syncthreads();
}
__device__ __forceinline__ int rel_bucket(int d) { if (d < 16) return d; const int l = 16 + (int)(logf((float)d / 16.0f) / 2.0794415416798357f * 16.0f); return l < 31 ? l : 31; }

typedef float f32x16 __attribute__((ext_vector_type(16)));
typedef short s16x4 __attribute__((ext_vector_type(4)));
typedef __bf16 bf16x2_t __attribute__((ext_vector_type(2)));
#define MFMA32(a, b, c) __builtin_amdgcn_mfma_f32_32x32x16_bf16((a), (b), (c), 0, 0, 0)
constexpr int TP = 144, TILE_B = 64 * TP;
constexpr int TABN = 336;
constexpr int AT_IMP = 4 * TILE_B, AT_SELM = AT_IMP + 4 * 64 * 33 * 4, AT_BTAB = AT_SELM + 256, AT_BUCK = AT_BTAB + TABN * 16, AT_OUT = AT_BUCK + 512, AT_END = AT_OUT + 8 * 8192;
constexpr float LOG2E = 1.4426950408889634f;
__device__ __forceinline__ unsigned pk2(float a, float b) { const f32x2 v = {a, b}; return __builtin_bit_cast(unsigned, __builtin_convertvector(v, bf16x2_t)); }
__device__ __forceinline__ int crow16(int i) { return (i & 3) + 8 * (i >> 2); }

__device__ __forceinline__ float xor32f(float v, int xaddr) { return __builtin_bit_cast(float, __builtin_amdgcn_ds_bpermute(xaddr, __builtin_bit_cast(int, v))); }
template <int CTRL> __device__ __forceinline__ unsigned dppu(unsigned v) { return (unsigned)__builtin_amdgcn_update_dpp(0, (int)v, CTRL, 0xf, 0xf, true); }
struct AttnState { f32x16 O[2]; float m, l; int xaddr; };

template <int BR, bool PASS2>
__device__ __forceinline__ void attn_block(LAS unsigned char* lds, int Kt, int Vt, int kpos0, bool selbit, const bf16x8 (&qf)[4], AttnState& st, int hh, int tq, int lane,
                                           float inv, LAS float* improw, float& eprev, int blk, bool win) {
    const int h = lane >> 5, l31 = lane & 31;
    const int tq0 = __builtin_amdgcn_readfirstlane(tq - l31);
    if (BR != 0) { if (tq0 + 31 < kpos0) return; if (win && tq0 - (kpos0 + 63) >= 512) return; }
    f32x16 S[2];
#pragma unroll
    for (int kb = 0; kb < 2; ++kb) {
#pragma unroll
        for (int i = 0; i < 16; ++i) S[kb][i] = 0.f;
#pragma unroll
        for (int s = 0; s < 4; ++s) { const bf16x8 kf = *(const LAS bf16x8*)(lds + Kt + (32 * kb + l31) * TP + (16 * s + 8 * h) * 2); S[kb] = MFMA32(kf, qf[s], S[kb]); }
    }
    const LAS float* btab = (const LAS float*)(lds + AT_BTAB);
    const bool fast = (BR != 0) && (tq0 - (kpos0 + 63) >= 113) && (!win || (tq0 + 31 - kpos0) <= 511);
    float mx = -INFINITY, cb = 0.f; const bool okl = (BR == 1) ? (selbit || win) : true;
    const bool nearp = (BR == 1) && !fast && (tq0 + 31 - kpos0) <= 271;
    if (fast) { cb = btab[(127 + 64) * 4 + hh]; float mr = S[0][0];
#pragma unroll
        for (int kb = 0; kb < 2; ++kb)
#pragma unroll
            for (int i = 0; i < 16; ++i) mr = fmaxf(mr, S[kb][i]);
        mx = okl ? __builtin_fmaf(mr, LOG2E, cb) : -INFINITY;
    } else if (nearp) {
        const LAS float* tb = btab + (tq - kpos0 - 4 * h + 64 - 59) * 4 + hh;
#pragma unroll
        for (int kb = 0; kb < 2; ++kb)
#pragma unroll
            for (int i0 = 0; i0 < 16; i0 += 8) { float bv[8];
#pragma unroll
                for (int e = 0; e < 8; ++e) bv[e] = tb[(59 - 32 * kb - crow16(i0 + e)) * 4];
                __builtin_amdgcn_sched_barrier(0);
#pragma unroll
                for (int e = 0; e < 8; ++e) { const float v = __builtin_fmaf(S[kb][i0 + e], LOG2E, bv[e]); S[kb][i0 + e] = v; mx = fmaxf(mx, v); }
                __builtin_amdgcn_sched_barrier(0); }
        mx = okl ? mx : -INFINITY;
    } else {
#pragma unroll
        for (int kb = 0; kb < 2; ++kb)
#pragma unroll
            for (int i0 = 0; i0 < 16; i0 += 8) {
                float bv[8]; float pen[8];
#pragma unroll
                for (int e = 0; e < 8; ++e) { const int i = i0 + e; const int kidx = kpos0 + 32 * kb + 4 * h + crow16(i); const int dist = tq - ((BR == 0) ? (16 * kidx + 31) : kidx);
                    const int dc = dist < -1 ? -1 : (dist > 127 ? 127 : dist);
                    bv[e] = btab[(dc + 64) * 4 + hh]; pen[e] = (BR == 1 && win && dist >= 512) ? -INFINITY : 0.f; }
                __builtin_amdgcn_sched_barrier(0);
#pragma unroll
                for (int e = 0; e < 8; ++e) { const int i = i0 + e; float v = __builtin_fmaf(S[kb][i], LOG2E, bv[e]); if (BR == 1) v += pen[e]; S[kb][i] = v; mx = fmaxf(mx, v); }
                __builtin_amdgcn_sched_barrier(0);
            }
        if (BR == 1) mx = okl ? mx : -INFINITY;
    }
    __builtin_amdgcn_sched_barrier(0);
    if (!PASS2) {
        mx = fmaxf(mx, xor32f(mx, st.xaddr));
        const float mnew = fmaxf(st.m, mx), muse = (mnew == -INFINITY) ? 0.f : mnew, alpha = __builtin_amdgcn_exp2f(st.m - muse);
        float ls = 0.f;
        if (fast) { const float cbm = okl ? (cb - muse) : -INFINITY;
#pragma unroll
            for (int kb = 0; kb < 2; ++kb)
#pragma unroll
                for (int i = 0; i < 16; ++i) { const float pv = __builtin_amdgcn_exp2f(__builtin_fmaf(S[kb][i], LOG2E, cbm)); S[kb][i] = pv; ls += pv; }
        } else { const float musel = (BR == 1 && !okl) ? INFINITY : muse;
#pragma unroll
            for (int kb = 0; kb < 2; ++kb)
#pragma unroll
                for (int i = 0; i < 16; ++i) { const float pv = __builtin_amdgcn_exp2f(S[kb][i] - musel); S[kb][i] = pv; ls += pv; }
        }
        st.l = st.l * alpha + ls; st.m = mnew;
        if (__builtin_amdgcn_ballot_w64(alpha != 1.0f) != 0ull) {
#pragma unroll
            for (int db = 0; db < 2; ++db)
#pragma unroll
                for (int i = 0; i < 16; ++i) st.O[db][i] *= alpha; }
        const int i16 = lane & 15, q4 = i16 >> 2, p4 = i16 & 3, b16 = (lane >> 4) & 1;
        LAS unsigned char* vbase = lds + Vt + (4 * h + q4) * TP + 32 * b16 + 8 * p4;
#pragma unroll
        for (int kb = 0; kb < 2; ++kb) {
            bf16x8 vf[2][2];
#pragma unroll
            for (int s2 = 0; s2 < 2; ++s2)
#pragma unroll
                for (int db = 0; db < 2; ++db) { LAS unsigned char* va = vbase + (32 * kb + 16 * s2) * TP + db * 64;
                    const s16x4 lo = __builtin_bit_cast(s16x4, __builtin_amdgcn_ds_read_tr16_b64_v4i16((LAS s16x4*)va));
                    const s16x4 hi = __builtin_bit_cast(s16x4, __builtin_amdgcn_ds_read_tr16_b64_v4i16((LAS s16x4*)(va + 8 * TP)));
                    vf[s2][db] = __builtin_shufflevector(lo, hi, 0, 1, 2, 3, 4, 5, 6, 7); }
            __builtin_amdgcn_sched_barrier(0);
#pragma unroll
            for (int s2 = 0; s2 < 2; ++s2) {
                u32x4 pw; pw.x = pk2(S[kb][8 * s2 + 0], S[kb][8 * s2 + 1]); pw.y = pk2(S[kb][8 * s2 + 2], S[kb][8 * s2 + 3]); pw.z = pk2(S[kb][8 * s2 + 4], S[kb][8 * s2 + 5]); pw.w = pk2(S[kb][8 * s2 + 6], S[kb][8 * s2 + 7]);
                const bf16x8 pf = __builtin_bit_cast(bf16x8, pw);
#pragma unroll
                for (int db = 0; db < 2; ++db) st.O[db] = MFMA32(vf[s2][db], pf, st.O[db]);
            }
            __builtin_amdgcn_sched_barrier(0);
        }
    } else {
        const float muse = (st.m == -INFINITY) ? 0.f : st.m;
#pragma unroll
        for (int kb = 0; kb < 2; ++kb)
#pragma unroll
            for (int gq = 0; gq < 4; ++gq) {
                const float p0 = __builtin_amdgcn_exp2f(S[kb][4 * gq] - muse) * inv, p1 = __builtin_amdgcn_exp2f(S[kb][4 * gq + 1] - muse) * inv,
                            p2 = __builtin_amdgcn_exp2f(S[kb][4 * gq + 2] - muse) * inv, p3 = __builtin_amdgcn_exp2f(S[kb][4 * gq + 3] - muse) * inv;
                const float esw = xor32f(p3, st.xaddr);
                const float val = ((p0 + p1) + (p2 + p3)) + (h ? esw : eprev);
                improw[16 * blk + 8 * kb + 2 * gq + h] = val; eprev = esw; }
    }
}

__device__ __forceinline__ void attn_mfma_phase(const Args& a, LAS unsigned char* lds) {
    const bf16_t* kv = (const bf16_t*)(a.ws + WS_KV); const bf16_t* qb_ = (const bf16_t*)(a.ws + WS_Q); const float* gate = (const float*)(a.ws + WS_GATE);
    const bf16_t* kcb = (const bf16_t*)(a.ws + WS_KCB); bf16_t* yo = (bf16_t*)(a.ws + WS_Y); const float* relb = a.in[17];
    int tid_ = threadIdx.x; asm volatile("" : "+v"(tid_));
    const int tid = tid_, wid = __builtin_amdgcn_readfirstlane(tid >> 6), lane = tid & 63, hh = wid >> 1, qh = wid & 1, h = lane >> 5, l31 = lane & 31;
    const int lkey = tid >> 3, lch = tid & 7;
    LAS int* buck = (LAS int*)(lds + AT_BUCK); LAS float* btab = (LAS float*)(lds + AT_BTAB); LAS unsigned* selm = (LAS unsigned*)(lds + AT_SELM); LAS float* imp = (LAS float*)(lds + AT_IMP);
    if (tid < 128) buck[tid] = rel_bucket(tid);
    __syncthreads();
    const int nitems = NB * 32 * 4;
    const bool swz = gridDim.x == 256; const int bx_ = blockIdx.x, sx = bx_ & 7, ss_ = bx_ >> 3, sgrp = ss_ >> 3, sq8 = ss_ & 7;
    const int nk = swz ? 16 : (nitems - bx_ + (int)gridDim.x - 1) / (int)gridDim.x;
    for (int kk = 0; kk < nk; ++kk) {
        int qb, b, g;
        if (swz) { const int bg = sx * 16 + (kk >> 2) * 4 + sgrp, t4 = kk & 3; qb = t4 == 0 ? sq8 : (t4 == 1 ? 15 - sq8 : (t4 == 2 ? 16 + sq8 : 31 - sq8)); b = bg >> 2; g = bg & 3; }
        else { const int it = bx_ + kk * (int)gridDim.x; qb = it >> 7; b = (it >> 2) & 31; g = it & 3; }
        const int qs = 64 * qb, head = g * 4 + hh, tq = qs + 32 * qh + l31;
        const size_t rowq = (size_t)b * SEQ + tq;
        bf16x8 qf[4];
#pragma unroll
        for (int s = 0; s < 4; ++s) qf[s] = *(const bf16x8*)(qb_ + rowq * DM + head * 64 + 16 * s + 8 * h);
        const float* gp = gate + rowq * 48 + head * 3; const float g0 = gp[0], g1 = gp[1], g2 = gp[2];
        __syncthreads();
        for (int e = tid; e < TABN * 4; e += NTHREADS) { const int d = (e >> 2) - 64; btab[e] = d < 0 ? -INFINITY : relb[buck[d > 127 ? 127 : d] * 16 + g * 4 + (e & 3)] * LOG2E; }
        {
            const bf16_t* kc = kcb + (((size_t)b * 128) * 4 + g) * 64; const bf16_t* vc = kc + (size_t)NB * 128 * 4 * 64;
#pragma unroll
            for (int blk = 0; blk < 2; ++blk) { const u32x4 kx = *(const u32x4*)(kc + (size_t)(64 * blk + lkey) * 256 + lch * 8), vx = *(const u32x4*)(vc + (size_t)(64 * blk + lkey) * 256 + lch * 8);
                *(LAS u32x4*)(lds + blk * TILE_B + lkey * TP + lch * 16) = kx; *(LAS u32x4*)(lds + (2 + blk) * TILE_B + lkey * TP + lch * 16) = vx; }
        }
        __syncthreads();
        AttnState st; float edummy = 0.f; LAS unsigned char* outp = lds + AT_OUT + wid * 8192 + lane * 16;
#pragma unroll
        for (int db = 0; db < 2; ++db)
#pragma unroll
            for (int i = 0; i < 16; ++i) st.O[db][i] = 0.f;
        st.m = -INFINITY; st.l = 0.f; st.xaddr = (lane ^ 32) << 2;
#pragma nounroll
        for (int blk = 0; blk < (qb >= 16 ? 2 : 1); ++blk)
            attn_block<0, false>(lds, blk * TILE_B, (2 + blk) * TILE_B, 64 * blk, true, qf, st, hh, tq, lane, 0.f, nullptr, edummy, blk, false);
        {   const float lt = st.l + xor32f(st.l, st.xaddr), inv = lt > 0.f ? 1.0f / lt : 0.f, sc = g0 * inv;
#pragma unroll
            for (int db = 0; db < 2; ++db)
#pragma unroll
                for (int gq = 0; gq < 4; ++gq) { const f32x4 v = {st.O[db][4 * gq] * sc, st.O[db][4 * gq + 1] * sc, st.O[db][4 * gq + 2] * sc, st.O[db][4 * gq + 3] * sc};
                    *(LAS f32x4*)(outp + (db * 4 + gq) * 1024) = v; st.O[db][4 * gq] = 0.f; st.O[db][4 * gq + 1] = 0.f; st.O[db][4 * gq + 2] = 0.f; st.O[db][4 * gq + 3] = 0.f; }
            if (qb >= 16) { float ep = 0.f; LAS float* improw = imp + (hh * 64 + 32 * qh + l31) * 33;
#pragma nounroll
                for (int blk = 0; blk < 2; ++blk) attn_block<0, true>(lds, blk * TILE_B, (2 + blk) * TILE_B, 64 * blk, true, qf, st, hh, tq, lane, inv, improw, ep, blk, false); }
            st.m = -INFINITY; st.l = 0.f; }
        __syncthreads();
        if (qb >= 16) {
            {
                const int q = tid >> 3, j0 = (tid & 7) * 4;
#pragma unroll
                for (int u = 0; u < 4; ++u) { const int j = j0 + u; imp[q * 33 + j] = (imp[(0 * 64 + q) * 33 + j] + imp[(1 * 64 + q) * 33 + j]) + (imp[(2 * 64 + q) * 33 + j] + imp[(3 * 64 + q) * 33 + j]); }
            }
            __syncthreads();
            const int q = tid >> 3, sub = tid & 7; unsigned mk = 0u;
            for (int u = 0; u < 4; ++u) { const int s = 4 * sub + u; const float mine = imp[q * 33 + s];
                int rank = 0;
                for (int j = 1; j < 32; ++j) { const float ij = imp[q * 33 + j]; const bool cj = (j < qb - 1); if (cj && (ij > mine || (ij == mine && j < s))) ++rank; }
                const bool forced = (s == 0) || (s == qb) || (s == qb - 1); if (forced || (s <= qb && rank < 13)) mk |= 1u << s; }
            mk |= dppu<0xB1>(mk); mk |= dppu<0x4E>(mk); mk |= dppu<0x141>(mk);
            if (sub == 0) selm[q] = mk;
        } else if (tid < 64) selm[tid] = (qb >= 31) ? 0xffffffffu : ((2u << qb) - 1u);
        __syncthreads();
        const unsigned mysel = selm[32 * qh + l31];
        const int nsel = qb + 1, wlo = qb > 8 ? qb - 8 : 0, nstep = nsel + (qb - wlo + 1);
        const bf16_t* kvb = kv + (size_t)b * SEQ * NKV + g * 64;
        u32x4 kx, vx;
        { const bf16_t* r0 = kvb + (size_t)(0 + lkey) * NKV + lch * 8; kx = *(const u32x4*)(r0 + 2 * 256); vx = *(const u32x4*)(r0 + 3 * 256); }
        *(LAS u32x4*)(lds + 0 * TILE_B + lkey * TP + lch * 16) = kx; *(LAS u32x4*)(lds + 2 * TILE_B + lkey * TP + lch * 16) = vx;
        __syncthreads();
        for (int k = 0; k < nstep; ++k) {
            const int buf = k & 1;
            if (k + 1 < nstep) { const int k1 = k + 1, isw = k1 >= nsel, jb1 = isw ? wlo + (k1 - nsel) : k1; const bf16_t* r0 = kvb + (size_t)(64 * jb1 + lkey) * NKV + lch * 8 + (isw ? 4 * 256 : 2 * 256);
                kx = *(const u32x4*)r0; vx = *(const u32x4*)(r0 + 256); }
            if (k == nsel) {
                const float lt = st.l + xor32f(st.l, st.xaddr), sc = g1 / lt;
#pragma unroll
                for (int db = 0; db < 2; ++db)
#pragma unroll
                    for (int gq = 0; gq < 4; ++gq) { f32x4 v = *(LAS f32x4*)(outp + (db * 4 + gq) * 1024);
                        v[0] += st.O[db][4 * gq] * sc; v[1] += st.O[db][4 * gq + 1] * sc; v[2] += st.O[db][4 * gq + 2] * sc; v[3] += st.O[db][4 * gq + 3] * sc;
                        *(LAS f32x4*)(outp + (db * 4 + gq) * 1024) = v; st.O[db][4 * gq] = 0.f; st.O[db][4 * gq + 1] = 0.f; st.O[db][4 * gq + 2] = 0.f; st.O[db][4 * gq + 3] = 0.f; }
                st.m = -INFINITY; st.l = 0.f; }
            { const bool isw = k >= nsel; const int jbk = isw ? wlo + k - nsel : k;
              attn_block<1, false>(lds, buf * TILE_B, (2 + buf) * TILE_B, 64 * jbk, (mysel >> (jbk & 31)) & 1u, qf, st, hh, tq, lane, 0.f, nullptr, edummy, 0, isw); }
            if (k + 1 < nstep) { *(LAS u32x4*)(lds + (buf ^ 1) * TILE_B + lkey * TP + lch * 16) = kx; *(LAS u32x4*)(lds + (2 + (buf ^ 1)) * TILE_B + lkey * TP + lch * 16) = vx; }
            __syncthreads();
        }
        {   const float lt = st.l + xor32f(st.l, st.xaddr), sc = g2 / lt;
            u32x2 w[2][4];
#pragma unroll
            for (int db = 0; db < 2; ++db)
#pragma unroll
                for (int gq = 0; gq < 4; ++gq) { const f32x4 v = *(LAS f32x4*)(outp + (db * 4 + gq) * 1024);
                    w[db][gq].x = pk2(v[0] + st.O[db][4 * gq] * sc, v[1] + st.O[db][4 * gq + 1] * sc); w[db][gq].y = pk2(v[2] + st.O[db][4 * gq + 2] * sc, v[3] + st.O[db][4 * gq + 3] * sc); }
            LAS unsigned char* tp = lds + AT_OUT + wid * 8192;
#pragma unroll
            for (int db = 0; db < 2; ++db)
#pragma unroll
                for (int gq = 0; gq < 4; ++gq) *(LAS u32x2*)(tp + l31 * TP + (32 * db + 8 * gq + 4 * h) * 2) = w[db][gq];
            asm volatile("s_waitcnt lgkmcnt(0)" ::: "memory");
            bf16_t* obase = yo + ((size_t)b * SEQ + qs + 32 * qh) * DM + head * 64;
#pragma unroll
            for (int it = 0; it < 4; ++it) { const int r = (lane >> 3) + 8 * it, ch = lane & 7; const u32x4 v = *(const LAS u32x4*)(tp + r * TP + ch * 16); *(u32x4*)(obase + (size_t)r * DM + ch * 8) = v; }
        }
    }
    __syncthreads();
}

#define XB_TMO      128
#define XB_XCNT(j)  (256  + 64 * (j))
#define XB_XSUB(j)  (1280 + 64 * (j))
#define XB_XGEN(j)  (2304 + 64 * (j))
#define XB_TOP      3328
#define XB_TOPGEN   3392
#define XCD_BAR_WORDS 3456
#define XB_SPIN_CAP (1u << 18)
__device__ __forceinline__ unsigned xb_ld(unsigned* p)              { return __hip_atomic_load(p, __ATOMIC_RELAXED, __HIP_MEMORY_SCOPE_AGENT); }
__device__ __forceinline__ unsigned xb_add(unsigned* p, unsigned v) { return __hip_atomic_fetch_add(p, v, __ATOMIC_RELAXED, __HIP_MEMORY_SCOPE_AGENT); }
__device__ __forceinline__ unsigned xb_xcc_id() { return (unsigned)__builtin_amdgcn_s_getreg((3 << 11) | 20) & 0xFu; }
#define XB_SPIN(cond, bar) do { unsigned _sp = 0; while (cond) { __builtin_amdgcn_s_sleep(1); \
    if ((++_sp & 255u) == 0u) { if (xb_ld(&(bar)[XB_TMO])) break; if (_sp > XB_SPIN_CAP) { atomicAdd(&(bar)[XB_TMO], 1u); break; } } } } while (0)
struct XcdBarrier { unsigned* bar; unsigned x; volatile LAS unsigned* st; };
__device__ __forceinline__ XcdBarrier xcd_barrier_post(unsigned* bar, volatile LAS unsigned* st) {
    XcdBarrier b; b.bar = bar; b.x = xb_xcc_id(); b.st = st;
    if (threadIdx.x == 0) (void)xb_add(&bar[XB_XCNT(b.x)], 1u);
    return b;
}
__device__ __forceinline__ void xcd_barrier_complete(unsigned* bar, unsigned x, unsigned& nloc, unsigned& nx) {
    const unsigned G = gridDim.x * gridDim.y * gridDim.z;
    unsigned sum, cnt, mine, sp = 0u;
    for (;;) {
        sum = 0u; cnt = 0u; mine = 0u;
#pragma unroll
        for (unsigned j = 0; j < 16; ++j) { const unsigned c = xb_ld(&bar[XB_XCNT(j)]); sum += c; cnt += (c > 0u) ? 1u : 0u; mine = (j == x) ? c : mine; }
        if (sum == G) break;
        __builtin_amdgcn_s_sleep(1);
        if ((++sp & 255u) == 0u) { if (xb_ld(&bar[XB_TMO])) break; if (sp > XB_SPIN_CAP) { atomicAdd(&bar[XB_TMO], 1u); break; } }
    }
    nloc = mine > 0u ? mine : 1u; nx = cnt > 0u ? cnt : 1u;
}
__device__ __forceinline__ void xcd_barrier(const XcdBarrier& b) {
    asm volatile("s_waitcnt vmcnt(0)" ::: "memory");
    __syncthreads();
    if (threadIdx.x == 0) {
        unsigned* bar = b.bar;
        __builtin_amdgcn_s_waitcnt(0);
        unsigned nloc = b.st[0], nx = b.st[1];
        if (nloc == 0u) { xcd_barrier_complete(bar, b.x, nloc, nx); b.st[0] = nloc; b.st[1] = nx; }
        const unsigned old = xb_add(&bar[XB_XSUB(b.x)], 1u);
        const unsigned gen = old / nloc;
        if (old + 1u == (gen + 1u) * nloc) {
            __builtin_amdgcn_fence(__ATOMIC_RELEASE, "agent");
            asm volatile("s_waitcnt vmcnt(0)" ::: "memory");
            const unsigned og = xb_add(&bar[XB_TOP], 1u);
            const unsigned tg = og / nx;
            if (og + 1u == (tg + 1u) * nx) xb_add(&bar[XB_TOPGEN], 1u);
            else XB_SPIN(xb_ld(&bar[XB_TOPGEN]) == tg, bar);
            __builtin_amdgcn_fence(__ATOMIC_ACQUIRE, "agent");
            xb_add(&bar[XB_XGEN(b.x)], 1u);
            asm volatile("s_waitcnt vmcnt(0)" ::: "memory");
        } else {
            XB_SPIN(xb_ld(&bar[XB_XGEN(b.x)]) == gen, bar);
            __builtin_amdgcn_fence(__ATOMIC_ACQUIRE, "agent");
            asm volatile("s_waitcnt vmcnt(0)" ::: "memory");
        }
    }
    __syncthreads();
}

enum { PH_WPREP = 0, PH_XPREP, PH_INCV, PH_INB, PH_OUTPROJ, PH_UP0, PH_DN0, PH_KVQG, PH_CMP, PH_CMP2, PH_ATTN, PH_WO, PH_UP1, PH_DN1, PH_FINAL, PH_COUNT };

__global__ void __launch_bounds__(NTHREADS, 2) mk_fwd(Args a) {
    extern __shared__ __attribute__((aligned(16))) unsigned char lds_raw[];
    LAS unsigned char* lds = (LAS unsigned char*)lds_raw;
    LAS float* exch = (LAS float*)(lds + 131072); LAS float* epc = (LAS float*)(lds + EPC_OFF);
    unsigned char* ws = a.ws;
    const int G = gridDim.x, bx = blockIdx.x;
    const float* x_in = a.in[0]; float* xo = a.out;
    bf16_t* HB = (bf16_t*)(ws + WS_HB); bf16_t* ACT = (bf16_t*)(ws + WS_BIG); bf16_t* Y = (bf16_t*)(ws + WS_Y); bf16_t* CVC = (bf16_t*)(ws + WS_RAW);
    float* RS = (float*)(ws + WS_RS); float* SSP = (float*)(ws + WS_SSP);
    const int lo = a.ph_lo, hi = a.ph_hi;
#define IN(k) (lo <= (k) && (k) < hi)
    volatile LAS unsigned* xst = (volatile LAS unsigned*)(lds + 147456);
    if (threadIdx.x < 4) xst[threadIdx.x] = 0u;
    __syncthreads();
    const XcdBarrier xbar = xcd_barrier_post((unsigned*)(ws + WS_BAR), xst);
#define SEAM(k) do { if (IN(k) && IN((k) + 1)) xcd_barrier(xbar); } while (0)
    if (hi < 0) cg::this_grid().sync();

    if (IN(PH_WPREP)) wprep_phase(a, lds);
    if (IN(PH_XPREP)) rowstat_phase(x_in, HB, RS, 0, MROWS);
    SEAM(PH_XPREP);
    if (IN(PH_INCV)) { pg8::Gemm g = pg8::dense(HB, (const bf16_t*)(ws + WS_WIN), MROWS, 2048, 1024); g.aperm = 1; pg8::ChainOrder S; S.init(8, G, bx);
        pg8::EpiConvPair<1, false> E{RS, a.in[3], DM, 0, CVC, DM, exch, epc}; pg8::gemm_phase(lds, g, S, E); }
    SEAM(PH_INCV);
    if (IN(PH_INB)) { const pg8::Gemm g = pg8::dense(HB, (const bf16_t*)(ws + WS_WIN) + (size_t)2048 * 1024, MROWS, 1024, 1024); pg8::StaticOrder S; S.init(MROWS, 1024, G, bx);
        pg8::EpiMulB E{RS, CVC, Y}; pg8::gemm_phase(lds, g, S, E); }
    SEAM(PH_INB);
    if (IN(PH_OUTPROJ)) { const pg8::Gemm g = pg8::dense(Y, (const bf16_t*)(ws + WS_WOUT), MROWS, 1024, 1024); pg8::StaticOrder S; S.init(MROWS, 1024, G, bx);
        pg8::EpiResid<true, false> E{x_in, HB, nullptr, SSP}; pg8::gemm_phase(lds, g, S, E); }
    SEAM(PH_OUTPROJ);
    if (IN(PH_UP0)) { pg8::Gemm g = pg8::dense(HB, (const bf16_t*)(ws + WS_WUP0), MROWS, 5632, 1024); g.aperm = 1; pg8::ChainOrder S; S.init(22, G, bx);
        pg8::EpiConvPair<0, true> E{SSP, a.in[7], 5632, DFF, ACT, DFF, exch, epc}; pg8::gemm_phase(lds, g, S, E); }
    SEAM(PH_UP0);
    if (IN(PH_DN0)) { const pg8::Gemm g = pg8::dense(ACT, (const bf16_t*)(ws + WS_WDN0), MROWS, 1024, 2816); pg8::StaticOrder S; S.init(MROWS, 1024, G, bx);
        pg8::EpiResid<false, false> E{nullptr, HB, nullptr, SSP}; pg8::gemm_phase(lds, g, S, E); }
    SEAM(PH_DN0);
    if (IN(PH_KVQG)) { const pg8::Gemm g = pg8::dense(HB, (const bf16_t*)(ws + WS_WKVQG), MROWS, NKVQG, 1024); pg8::StaticOrder S; S.init(MROWS, NKVQG, G, bx);
        pg8::EpiKVQG E{SSP, (bf16_t*)(ws + WS_KV), (bf16_t*)(ws + WS_Q), (float*)(ws + WS_GATE)}; pg8::gemm_phase(lds, g, S, E); }
    SEAM(PH_KVQG);
    if (IN(PH_CMP)) { pg8::Gemm g = pg8::dense((const bf16_t*)(ws + WS_KV), (const bf16_t*)(ws + WS_W1T), 16384, 512, 2048);
        g.amode = 1; g.a_kstep = (size_t)NKV * 2; g.a_hstep = (size_t)32 * 16 * NKV * 2; g.a_tstep = (size_t)1024 * NKV * 2; g.a_pnstep = 512;
        pg8::StaticOrder S; S.init(16384, 512, G, bx); pg8::EpiCmpHidden E{(const float*)(ws + WS_B1F), (float*)(ws + WS_HID)}; pg8::gemm_phase(lds, g, S, E); }
    SEAM(PH_CMP);
    if (IN(PH_CMP2)) compress_out_phase(a, lds);
    SEAM(PH_CMP2);
    if (IN(PH_ATTN)) attn_mfma_phase(a, lds);
    SEAM(PH_ATTN);
    if (IN(PH_WO)) { const pg8::Gemm g = pg8::dense(Y, (const bf16_t*)(ws + WS_WO), MROWS, 1024, 1024); pg8::StaticOrder S; S.init(MROWS, 1024, G, bx);
        pg8::EpiResid<false, false> E{nullptr, HB, nullptr, SSP}; pg8::gemm_phase(lds, g, S, E); }
    SEAM(PH_WO);
    if (IN(PH_UP1)) { pg8::Gemm g = pg8::dense(HB, (const bf16_t*)(ws + WS_WUP1), MROWS, 5632, 1024); g.aperm = 1; pg8::ChainOrder S; S.init(22, G, bx);
        pg8::EpiConvPair<0, true> E{SSP, a.in[7] + 3 * 5632, 5632, DFF, ACT, DFF, exch, epc}; pg8::gemm_phase(lds, g, S, E); }
    SEAM(PH_UP1);
    if (IN(PH_DN1)) { const pg8::Gemm g = pg8::dense(ACT, (const bf16_t*)(ws + WS_WDN1), MROWS, 1024, 2816); pg8::StaticOrder S; S.init(MROWS, 1024, G, bx);
        pg8::EpiResid<false, false> E{nullptr, HB, nullptr, SSP}; pg8::gemm_phase(lds, g, S, E); }
    SEAM(PH_DN1);
    if (IN(PH_FINAL)) final_phase(xo, HB, SSP, a.in[18], 0, MROWS);
#undef IN
#undef SEAM
}

extern "C" void kernel_launch(void* const* d_in, const int* in_sizes, int n_in, void* d_out, int out_size, void* d_ws, size_t ws_size, hipStream_t stream) {
    static int grid = 0;
    if (grid == 0) {
        if (n_in != 19 || ws_size < WS_END) { fprintf(stderr, "kernel_launch: unexpected shapes (n_in %d, ws %zu < %zu)\n", n_in, ws_size, (size_t)WS_END); grid = -1; return; }
        int dev = 0, cus = 0;
        (void)hipGetDevice(&dev); (void)hipDeviceGetAttribute(&cus, hipDeviceAttributeMultiprocessorCount, dev);
        if (hipFuncSetAttribute((const void*)mk_fwd, hipFuncAttributeMaxDynamicSharedMemorySize, LDS_BYTES) != hipSuccess) { fprintf(stderr, "kernel_launch: hipFuncSetAttribute failed\n"); grid = -1; return; }
        int per_cu = 0;
        if (hipOccupancyMaxActiveBlocksPerMultiprocessor(&per_cu, (const void*)mk_fwd, NTHREADS, LDS_BYTES) != hipSuccess || per_cu < 1) per_cu = 1;
        (void)hipGetLastError();
        grid = (cus > 0 ? cus : 256) * per_cu;
    }
    if (grid < 0) return;
    Args a{};
    for (int i = 0; i < 19; ++i) a.in[i] = (const float*)d_in[i];
    a.out = (float*)d_out; a.ws = (unsigned char*)d_ws;
    (void)hipMemsetAsync((unsigned char*)d_ws + WS_BAR, 0, 16384, stream);
    a.ph_lo = 0; a.ph_hi = PH_COUNT;
    void* kargs[] = {&a};
    hipError_t e = hipLaunchCooperativeKernel((const void*)mk_fwd, dim3(grid), dim3(NTHREADS), kargs, LDS_BYTES, stream);
    if (e != hipSuccess) fprintf(stderr, "cooperative launch failed: %s (grid %d)\n", hipGetErrorString(e), grid);
}
```

```cpp
#include <hip/hip_runtime.h>
#include <hip/hip_cooperative_groups.h>
#include <cstdio>
#include <type_traits>
namespace cg = cooperative_groups;

#define LAS __attribute__((address_space(3)))
typedef unsigned short bf16_t;
typedef short bf16x8 __attribute__((ext_vector_type(8)));
typedef float f32x4 __attribute__((ext_vector_type(4)));
typedef float f32x2 __attribute__((ext_vector_type(2)));
typedef unsigned u32x4 __attribute__((ext_vector_type(4)));
typedef unsigned u32x2 __attribute__((ext_vector_type(2)));

constexpr int NB = 32, SEQ = 2048, DM = 1024, DFF = 2816, MROWS = NB * SEQ;
constexpr int NKV = 1536, NQG = 1072, NKVQG = 2816, NCMP = 127;
constexpr int NTHREADS = 512;
constexpr int EPC_OFF = 147456 + 16, LDS_BYTES = EPC_OFF + 8192;

constexpr size_t WS_WIN = 0;
constexpr size_t WS_WOUT = WS_WIN + (size_t)3072 * 1024 * 2;
constexpr size_t WS_WUP0 = WS_WOUT + (size_t)1024 * 1024 * 2;
constexpr size_t WS_WUP1 = WS_WUP0 + (size_t)5632 * 1024 * 2;
constexpr size_t WS_WDN0 = WS_WUP1 + (size_t)5632 * 1024 * 2;
constexpr size_t WS_WDN1 = WS_WDN0 + (size_t)1024 * 2816 * 2;
constexpr size_t WS_WKVQG = WS_WDN1 + (size_t)1024 * 2816 * 2;
constexpr size_t WS_WO = WS_WKVQG + (size_t)2816 * 1024 * 2;
constexpr size_t WS_W1T = WS_WO + (size_t)1024 * 1024 * 2;
constexpr size_t WS_B1F = WS_W1T + (size_t)2 * 256 * 2048 * 2;
constexpr size_t WS_HB = 56ull << 20;
constexpr size_t WS_BIG = WS_HB + (size_t)MROWS * 1024 * 2;
constexpr size_t WS_KV = WS_BIG;
constexpr size_t WS_Q = WS_BIG + (size_t)MROWS * NKV * 2;
constexpr size_t WS_Y = WS_BIG + (size_t)MROWS * DFF * 2;
constexpr size_t WS_RAW = WS_Y + (size_t)MROWS * 1024 * 2;
constexpr size_t WS_GATE = WS_RAW + (size_t)16384 * 5632 * 2;
constexpr size_t WS_KCMP = WS_GATE + (size_t)MROWS * 48 * 4;
constexpr size_t WS_RS = WS_KCMP + (size_t)2 * 32 * 128 * 4 * 64 * 4;
constexpr size_t WS_KCB = WS_RS + (size_t)MROWS * 4;
constexpr size_t WS_HID = WS_KCB + (size_t)2 * 32 * 128 * 4 * 64 * 2;
constexpr size_t WS_SSP = WS_HID + (size_t)2 * 16384 * 128 * 4;
constexpr size_t WS_BAR = WS_SSP + (size_t)MROWS * 16 * 4;
constexpr size_t WS_END = WS_BAR + 16384;

__device__ __forceinline__ float bf2f(bf16_t b) { return __uint_as_float(((unsigned)b) << 16); }
__device__ __forceinline__ bf16_t f2bf(float f) { unsigned u = __float_as_uint(f); u += 0x7fffu + ((u >> 16) & 1u); return (bf16_t)(u >> 16); }
__device__ __forceinline__ unsigned cvt_pk_bf16(float lo, float hi) { unsigned r; asm volatile("v_cvt_pk_bf16_f32 %0, %1, %2" : "=v"(r) : "v"(lo), "v"(hi)); return r; }
__device__ __forceinline__ float wave_sum(float v) { for (int o = 32; o >= 1; o >>= 1) v += __shfl_xor(v, o); return v; }
__device__ __forceinline__ float wave_max(float v) { for (int o = 32; o >= 1; o >>= 1) v = fmaxf(v, __shfl_xor(v, o)); return v; }

__device__ __forceinline__ float gelu_tanh(float x) { const float u = 0.7978845608028654f * (x + 0.044715f * x * x * x); return 0.5f * x * (1.0f + tanhf(u)); }
struct Args { const float* in[19]; float* out; unsigned char* ws; int ph_lo, ph_hi, seq0, nseq, nchunk, pad; };

namespace pg8 {
constexpr int BM = 256, BK = 64, HALF = 128, HTB = HALF * BK * 2, STAGE_BYTES = 8 * HTB, NXCD = 8, WGM = 8;
__host__ __device__ __forceinline__ int lds_byte(int r, int c) { const int st = (r >> 4) * 2 + (c >> 5), rr = r & 15, cc = c & 31, ob = rr * 64 + cc * 2; return st * 1024 + (ob ^ (((ob >> 9) & 1) << 5)); }
__host__ __device__ __forceinline__ void stage_rc(int b, int& R, int& C) { const int st = b / 1024, sb = b % 1024, swz = sb ^ (((sb >> 9) & 1) << 5); R = (st >> 1) * 16 + swz / 64; C = (st & 1) * 32 + (swz % 64) / 2; }
__host__ __device__ __forceinline__ int perm32(int rho) { const int n = rho >> 4, i = rho & 15; return 8 * (i >> 2) + 4 * n + (i & 3); }
struct Unit { int pm, pn; };
struct Gemm { const bf16_t* A; const bf16_t* Bt; int M, N, K; int amode, aperm; size_t a_kstep, a_hstep, a_tstep, a_pnstep; };
__device__ __forceinline__ Gemm dense(const bf16_t* A, const bf16_t* Bt, int M, int N, int K) { Gemm g; g.A = A; g.Bt = Bt; g.M = M; g.N = N; g.K = K; g.amode = 0; g.aperm = 0; g.a_kstep = 128; g.a_hstep = (size_t)128 * K * 2; g.a_tstep = (size_t)256 * K * 2; g.a_pnstep = 0; return g; }
struct StaticOrder {
    int nM, nN, nwg, G, c;
    __device__ void init(int M, int N, int G_, int c_) { nM = M / BM; nN = N / BM; nwg = nM * nN; G = G_; c = c_; }
    __device__ bool next(int i, Unit& u) const {
        const long L = (long)i * G + c; if (L >= nwg) return false;
        int wgid = (int)L; { const int q = nwg / NXCD, r = nwg % NXCD, xcd = wgid % NXCD, off = wgid / NXCD; wgid = (xcd < r ? xcd * (q + 1) : r * (q + 1) + (xcd - r) * q) + off; }
        const int nig = WGM * nN, gid = wgid / nig, fm = gid * WGM, gsz = (nM - fm) < WGM ? (nM - fm) : WGM;
        u.pm = fm + ((wgid % nig) % gsz); u.pn = (wgid % nig) / gsz; return true;
    }
};

__device__ __forceinline__ float row_scale16(const float* ssp, int row, int fq) {
    const f32x4 p = *(const f32x4*)(ssp + (size_t)row * 16 + 4 * fq); float s = (p[0] + p[1]) + (p[2] + p[3]);
    s += __shfl_xor(s, 16); s += __shfl_xor(s, 32); return rsqrtf(s * (1.0f / DM) + 1e-6f); }
template <bool BASE_F32, bool OUT_F32> struct EpiResid {
    static constexpr bool PERM = true;
    const float* base32; bf16_t* xb; float* out32; float* ssp;
    __device__ __forceinline__ void operator()(f32x4 (&acc)[2][2][4][2], const Unit& u, int ui, int wr, int wc, int fr, int fq) const {
        const int row0 = u.pm * BM + wr * 64 + fr, col0 = u.pn * BM + wc * 32 + 8 * fq;
#pragma unroll
        for (int ai = 0; ai < 2; ++ai) {
            u32x4 bb[4][2]; f32x4 bf[4][2][2];
#pragma unroll
            for (int m = 0; m < 4; ++m)
#pragma unroll
                for (int bj = 0; bj < 2; ++bj) { const size_t o = (size_t)(row0 + ai * HALF + m * 16) * DM + col0 + bj * HALF;
                    if (BASE_F32) { bf[m][bj][0] = __builtin_nontemporal_load((const f32x4*)(base32 + o)); bf[m][bj][1] = __builtin_nontemporal_load((const f32x4*)(base32 + o + 4)); } else bb[m][bj] = *(const u32x4*)(xb + o); }
            __builtin_amdgcn_sched_barrier(0);
#pragma unroll
            for (int m = 0; m < 4; ++m) { const int row = row0 + ai * HALF + m * 16; const size_t off = (size_t)row * DM + col0; float ss = 0.f;
#pragma unroll
                for (int bj = 0; bj < 2; ++bj) { const size_t o = off + bj * HALF; f32x4 v0, v1;
                    if (BASE_F32) { v0 = bf[m][bj][0]; v1 = bf[m][bj][1]; }
                    else { const u32x4 b = bb[m][bj];
                        v0 = (f32x4){__uint_as_float(b.x << 16), __uint_as_float(b.x & 0xffff0000u), __uint_as_float(b.y << 16), __uint_as_float(b.y & 0xffff0000u)};
                        v1 = (f32x4){__uint_as_float(b.z << 16), __uint_as_float(b.z & 0xffff0000u), __uint_as_float(b.w << 16), __uint_as_float(b.w & 0xffff0000u)}; }
                    v0 += acc[ai][bj][m][0]; v1 += acc[ai][bj][m][1];
                    ss += ((v0[0] * v0[0] + v0[1] * v0[1]) + (v0[2] * v0[2] + v0[3] * v0[3])) + ((v1[0] * v1[0] + v1[1] * v1[1]) + (v1[2] * v1[2] + v1[3] * v1[3]));
                    if (OUT_F32) { *(f32x4*)(out32 + o) = v0; *(f32x4*)(out32 + o + 4) = v1; }
                    else { u32x4 w; w.x = cvt_pk_bf16(v0[0], v0[1]); w.y = cvt_pk_bf16(v0[2], v0[3]); w.z = cvt_pk_bf16(v1[0], v1[1]); w.w = cvt_pk_bf16(v1[2], v1[3]); *(u32x4*)(xb + o) = w; } }
                if (!OUT_F32) { ss += __shfl_xor(ss, 16); ss += __shfl_xor(ss, 32); if (fq == 0) ssp[(size_t)row * 16 + u.pn * 4 + wc] = ss; } }
        }
    }
};
struct EpiKVQG {
    static constexpr bool PERM = true;
    const float* ssp; bf16_t* kv; bf16_t* q; float* gate;
    __device__ __forceinline__ void operator()(f32x4 (&acc)[2][2][4][2], const Unit& u, int ui, int wr, int wc, int fr, int fq) const {
        const int row0 = u.pm * BM + wr * 64 + fr, cin = wc * 32 + 8 * fq;
        float rsc[2][4];
#pragma unroll
        for (int ai = 0; ai < 2; ++ai)
#pragma unroll
            for (int m = 0; m < 4; ++m) rsc[ai][m] = row_scale16(ssp, row0 + ai * HALF + m * 16, fq);
#pragma unroll
        for (int ai = 0; ai < 2; ++ai)
#pragma unroll
            for (int m = 0; m < 4; ++m) { const int row = row0 + ai * HALF + m * 16; const float s = rsc[ai][m];
#pragma unroll
                for (int bj = 0; bj < 2; ++bj) { f32x4 v0 = acc[ai][bj][m][0] * s, v1 = acc[ai][bj][m][1] * s; const int col = cin + bj * HALF;
                    if (u.pn < 6) { u32x4 w; w.x = cvt_pk_bf16(v0[0], v0[1]); w.y = cvt_pk_bf16(v0[2], v0[3]); w.z = cvt_pk_bf16(v1[0], v1[1]); w.w = cvt_pk_bf16(v1[2], v1[3]);
                        *(u32x4*)(kv + (size_t)row * NKV + u.pn * BM + col) = w; }
                    else if (u.pn < 10) { v0 *= 0.125f; v1 *= 0.125f; u32x4 w; w.x = cvt_pk_bf16(v0[0], v0[1]); w.y = cvt_pk_bf16(v0[2], v0[3]); w.z = cvt_pk_bf16(v1[0], v1[1]); w.w = cvt_pk_bf16(v1[2], v1[3]);
                        *(u32x4*)(q + (size_t)row * DM + (u.pn - 6) * BM + col) = w; }
                    else if (col < 48) { f32x4 g0, g1;
#pragma unroll
                        for (int j = 0; j < 4; ++j) { g0[j] = 1.0f / (1.0f + __expf(-v0[j])); g1[j] = 1.0f / (1.0f + __expf(-v1[j])); }
                        *(f32x4*)(gate + (size_t)row * 48 + col) = g0; *(f32x4*)(gate + (size_t)row * 48 + col + 4) = g1; } } }
    }
};

struct ChainOrder {
    int nP, nchain_x, G8, xcd, slot; bool live;
    __device__ void init(int nP_, int G, int c) { nP = nP_; G8 = G / 8; xcd = c % 8; slot = c / 8; nchain_x = (NB / 8) * nP; live = c < 8 * G8; }
    __device__ bool next(int i, Unit& u) const {
        const int ci = i >> 3, w = i & 7, Lx = ci * G8 + slot; if (!live || Lx >= nchain_x) return false;
        const int seq = (Lx & 3) * 8 + xcd; u.pn = Lx >> 2; u.pm = seq * 8 + w; return true; }
};
template <int CTRL> __device__ __forceinline__ float dppf(float old, float src) {
    return __builtin_bit_cast(float, __builtin_amdgcn_update_dpp(__builtin_bit_cast(int, old), __builtin_bit_cast(int, src), CTRL, 0xf, 0xf, false)); }

template <int MODE, bool SSP> struct EpiConvPair {
    static constexpr bool PERM = true;
    const float* rs; const float* cw; int cw_ld, goff; bf16_t* O; int ldo; LAS float* exch; LAS float* cache;
    struct Pref { f32x4 w; f32x4 p0, p1; };
    __device__ __forceinline__ void issue(const Unit& nu, Pref& r) const {
        const int tid = threadIdx.x; r.w = (f32x4){0.f, 0.f, 0.f, 0.f};
        if (tid < (MODE == 0 ? 192 : 96)) { const int tt = tid >> 5, type = tt / 3, tap = tt % 3; r.w = *(const f32x4*)(cw + (size_t)tap * cw_ld + type * goff + nu.pn * HALF + (tid & 31) * 4); }
        const size_t row = (size_t)nu.pm * BM + (tid >> 1);
        if (SSP) { r.p0 = *(const f32x4*)(rs + row * 16 + 8 * (tid & 1)); r.p1 = *(const f32x4*)(rs + row * 16 + 8 * (tid & 1) + 4); } else { r.p0 = (f32x4){rs[row], 0.f, 0.f, 0.f}; r.p1 = r.p0; }
    }
    __device__ __forceinline__ void commit(int par, const Pref& r) const {
        const int tid = threadIdx.x; LAS float* c = cache + par * 1024;
        if (tid < (MODE == 0 ? 192 : 96)) *(LAS f32x4*)(c + (tid >> 5) * 128 + (tid & 31) * 4) = r.w;
        float sc;
        if (SSP) { float ss = ((r.p0[0] + r.p0[1]) + (r.p0[2] + r.p0[3])) + ((r.p1[0] + r.p1[1]) + (r.p1[2] + r.p1[3])); ss += dppf<0xB1>(0.f, ss); sc = rsqrtf(ss * (1.0f / DM) + 1e-6f); } else sc = r.p0[0];
        if ((tid & 1) == 0) c[768 + (tid >> 1)] = sc;
    }
    __device__ __forceinline__ void pre(const Unit& u) const { Pref r; issue(u, r); commit(0, r); }
    __device__ __forceinline__ void run(f32x4 (&acc)[2][2][4][2], const Unit& u, int ui, int wr, int wc, int fr, int fq, bool has_next, const Unit& nu) const {
        Pref pf; if (has_next) issue(nu, pf);
        const LAS float* cc = cache + (ui & 1) * 1024;
        const int row0 = u.pm * BM + wr * 64 + 4 * fr, lcol = wc * 32 + 8 * fq, lrow0 = wr * 64 + 4 * fr;
#pragma unroll
        for (int ai = 0; ai < 2; ++ai)
#pragma unroll
            for (int m = 0; m < 4; ++m) { const float sc = cc[768 + lrow0 + ai * HALF + m];
#pragma unroll
                for (int n = 0; n < 2; ++n) { if (MODE == 0) { acc[ai][0][m][n] *= sc; acc[ai][1][m][n] *= sc; } else acc[ai][0][m][n] = (acc[ai][0][m][n] * sc) * (acc[ai][1][m][n] * sc); } }
        LAS float* ex = exch + (ui & 1) * 2048;
        if (fr == 15) {
#pragma unroll
            for (int ai = 0; ai < 2; ++ai)
#pragma unroll
                for (int r = 0; r < 2; ++r) { LAS float* p = ex + ((ai * 2 + wr) * 2 + r) * 256 + lcol;
                    *(LAS f32x4*)p = acc[ai][0][2 + r][0]; *(LAS f32x4*)(p + 4) = acc[ai][0][2 + r][1];
                    if (MODE == 0) { *(LAS f32x4*)(p + 128) = acc[ai][1][2 + r][0]; *(LAS f32x4*)(p + 132) = acc[ai][1][2 + r][1]; } } }
        asm volatile("s_waitcnt lgkmcnt(0)" ::: "memory"); __builtin_amdgcn_s_barrier(); asm volatile("" ::: "memory"); __builtin_amdgcn_s_barrier(); asm volatile("" ::: "memory");
        const int f = u.pn * HALF + lcol;
        u32x2 keep[2][4];
#pragma unroll
        for (int n = 0; n < 2; ++n) {
            f32x4 wa[3], wg[3];
#pragma unroll
            for (int k = 0; k < 3; ++k) { wa[k] = *(const LAS f32x4*)(cc + k * 128 + lcol + 4 * n); if (MODE == 0) wg[k] = *(const LAS f32x4*)(cc + (3 + k) * 128 + lcol + 4 * n); }
#pragma unroll
            for (int ai = 0; ai < 2; ++ai) {
                const int blk = ai * 2 + wr;
                f32x4 ba2 = (f32x4){0.f, 0.f, 0.f, 0.f}, ba3 = ba2, bg2 = ba2, bg3 = ba2;
                const LAS float* src = nullptr;
                if (blk > 0) src = ex + (blk - 1) * 512; else if ((u.pm & 7) != 0) src = exch + ((ui & 1) ^ 1) * 2048 + 3 * 512;
                if (src != nullptr) { const LAS float* p = src + lcol + 4 * n; ba2 = *(const LAS f32x4*)p; ba3 = *(const LAS f32x4*)(p + 256);
                    if (MODE == 0) { bg2 = *(const LAS f32x4*)(p + 128); bg3 = *(const LAS f32x4*)(p + 256 + 128); } }
                float o[4][4];
#pragma unroll
                for (int j = 0; j < 4; ++j) {
                    const float v0 = acc[ai][0][0][n][j], v1 = acc[ai][0][1][n][j], v2 = acc[ai][0][2][n][j], v3 = acc[ai][0][3][n][j];
                    const float p2 = dppf<0x111>(ba2[j], v2), p3 = dppf<0x111>(ba3[j], v3);
                    const float w0 = wa[0][j], w1 = wa[1][j], w2 = wa[2][j];
                    float y[4] = {w2 * v0 + w1 * p3 + w0 * p2, w2 * v1 + w1 * v0 + w0 * p3, w2 * v2 + w1 * v1 + w0 * v0, w2 * v3 + w1 * v2 + w0 * v1};
                    if (MODE == 0) {
                        const float g0 = acc[ai][1][0][n][j], g1 = acc[ai][1][1][n][j], g2 = acc[ai][1][2][n][j], g3 = acc[ai][1][3][n][j];
                        const float q2 = dppf<0x111>(bg2[j], g2), q3 = dppf<0x111>(bg3[j], g3);
                        const float x0 = wg[0][j], x1 = wg[1][j], x2 = wg[2][j];
                        const float z[4] = {x2 * g0 + x1 * q3 + x0 * q2, x2 * g1 + x1 * g0 + x0 * q3, x2 * g2 + x1 * g1 + x0 * g0, x2 * g3 + x1 * g2 + x0 * g1};
#pragma unroll
                        for (int m = 0; m < 4; ++m) o[m][j] = y[m] * __builtin_amdgcn_rcpf(1.0f + __expf(-y[m])) * z[m];
                    } else {
#pragma unroll
                        for (int m = 0; m < 4; ++m) o[m][j] = y[m];
                    }
                }
#pragma unroll
                for (int m = 0; m < 4; ++m) { u32x2 w; w.x = cvt_pk_bf16(o[m][0], o[m][1]); w.y = cvt_pk_bf16(o[m][2], o[m][3]);
                    if (n == 0) keep[ai][m] = w;
                    else { u32x4 w4; w4.x = keep[ai][m].x; w4.y = keep[ai][m].y; w4.z = w.x; w4.w = w.y; __builtin_nontemporal_store(w4, (u32x4*)(O + (size_t)(row0 + ai * HALF + m) * ldo + f)); } }
            }
            __builtin_amdgcn_sched_barrier(0);
        }
        if (has_next) commit((ui & 1) ^ 1, pf);
    }
};
template <class T, class = void> struct has_pre : std::false_type {};
template <class T> struct has_pre<T, std::void_t<decltype(&T::pre)>> : std::true_type {};
struct EpiCmpHidden {
    static constexpr bool PERM = true;
    const float* b1f; float* H;
    __device__ __forceinline__ void operator()(f32x4 (&acc)[2][2][4][2], const Unit& u, int ui, int wr, int wc, int fr, int fq) const {
        const int row0 = u.pm * BM + wr * 64 + fr, col = wc * 32 + 8 * fq;
        const f32x4 b0 = *(const f32x4*)(b1f + u.pn * 128 + col), b1 = *(const f32x4*)(b1f + u.pn * 128 + col + 4);
#pragma unroll
        for (int ai = 0; ai < 2; ++ai)
#pragma unroll
            for (int m = 0; m < 4; ++m) { const int row = row0 + ai * HALF + m * 16; f32x4 v0 = acc[ai][0][m][0] + b0, v1 = acc[ai][0][m][1] + b1;
#pragma unroll
                for (int j = 0; j < 4; ++j) { v0[j] = gelu_tanh(v0[j]); v1[j] = gelu_tanh(v1[j]); }
                float* hp = H + ((size_t)u.pn * 16384 + row) * 128 + col; *(f32x4*)hp = v0; *(f32x4*)(hp + 4) = v1; }
    }
};
struct EpiMulB {
    static constexpr bool PERM = true;
    const float* rs; const bf16_t* other; bf16_t* Yo;
    __device__ __forceinline__ void operator()(f32x4 (&acc)[2][2][4][2], const Unit& u, int ui, int wr, int wc, int fr, int fq) const {
        const int row0 = u.pm * BM + wr * 64 + fr, col0 = u.pn * BM + wc * 32 + 8 * fq;
#pragma unroll
        for (int ai = 0; ai < 2; ++ai) {
            float sc[4]; bf16x8 ov[4][2];
#pragma unroll
            for (int m = 0; m < 4; ++m) { const int row = row0 + ai * HALF + m * 16; sc[m] = rs[row];
#pragma unroll
                for (int bj = 0; bj < 2; ++bj) ov[m][bj] = *(const bf16x8*)(other + (size_t)row * DM + col0 + bj * HALF); }
            __builtin_amdgcn_sched_barrier(0);
#pragma unroll
            for (int m = 0; m < 4; ++m) { const int row = row0 + ai * HALF + m * 16;
#pragma unroll
                for (int bj = 0; bj < 2; ++bj) { const size_t o = (size_t)row * DM + col0 + bj * HALF; const bf16x8 q = ov[m][bj];
                    const f32x4 v0 = acc[ai][bj][m][0] * sc[m], v1 = acc[ai][bj][m][1] * sc[m]; u32x4 w;
                    w.x = cvt_pk_bf16(v0[0] * bf2f((bf16_t)q[0]), v0[1] * bf2f((bf16_t)q[1])); w.y = cvt_pk_bf16(v0[2] * bf2f((bf16_t)q[2]), v0[3] * bf2f((bf16_t)q[3]));
                    w.z = cvt_pk_bf16(v1[0] * bf2f((bf16_t)q[4]), v1[1] * bf2f((bf16_t)q[5])); w.w = cvt_pk_bf16(v1[2] * bf2f((bf16_t)q[6]), v1[3] * bf2f((bf16_t)q[7]));
                    *(u32x4*)(Yo + o) = w; } }
        }
    }
};

template <class Epi, class Sched>
__device__ __forceinline__ void gemm_phase(LAS unsigned char* lds, const Gemm g, const Sched& S, const Epi& E) {
    int tid_ = threadIdx.x; asm volatile("" : "+v"(tid_));
    const int tid = tid_, wid = __builtin_amdgcn_readfirstlane(tid >> 6), lane = tid & 63, wr = wid >> 2, wc = wid & 3, fr = lane & 15, fq = lane >> 4;
    const int K = g.K, nt = K / BK;
    unsigned voffA[2], voffB[2];
#pragma unroll
    for (int i = 0; i < 2; ++i) { int R, C; stage_rc(tid * 16 + i * 8192, R, C); const int Rb = Epi::PERM ? ((R & ~31) + perm32(R & 31)) : R;
        const int Ra = g.aperm ? ((R & ~63) | ((R & 15) << 2) | ((R >> 4) & 3)) : R;
        voffA[i] = g.amode ? (unsigned)((R >> 2) * (16 * NKV) + (R & 3) * 64 + C) * 2u : (unsigned)(Ra * K + C) * 2u; voffB[i] = (unsigned)(Rb * K + C) * 2u; }
    const size_t kstep = (size_t)(BK * 2), hstep = (size_t)HALF * K * 2, tstep = 2 * hstep;
    const size_t akstep = g.a_kstep, ahstep = g.a_hstep, atstep = g.a_tstep;
    const unsigned ldsw = (unsigned)wid * 1024u;
    const int aoff = lds_byte(wr * 64 + fr, fq * 8), boff = lds_byte(wc * 32 + fr, fq * 8);
#define PG8_SA(b, h) (((b) * 2 + (h)) * HTB)
#define PG8_SB(b, h) ((4 + (b) * 2 + (h)) * HTB)
#define PG8_STAGE(bufoff, gbase, voff) do { _Pragma("unroll") for (int _i = 0; _i < 2; ++_i) \
        __builtin_amdgcn_global_load_lds((const unsigned*)((const char*)(gbase) + (voff)[_i]), (LAS unsigned*)(lds + (bufoff) + ldsw + _i * 8192), 16, 0, 0); } while (0)
#define PG8_LDA(dst, b, h) do { _Pragma("unroll") for (int m = 0; m < 4; ++m) _Pragma("unroll") for (int k = 0; k < 2; ++k) dst[m][k] = *(const LAS bf16x8*)(lds + PG8_SA(b, h) + aoff + m * 2048 + k * 1024); } while (0)
#define PG8_LDB(dst, b, h) do { _Pragma("unroll") for (int n = 0; n < 2; ++n) _Pragma("unroll") for (int k = 0; k < 2; ++k) dst[n][k] = *(const LAS bf16x8*)(lds + PG8_SB(b, h) + boff + n * 2048 + k * 1024); } while (0)
#define PG8_MMA(ai, bj, At, Bt) do { __builtin_amdgcn_s_setprio(1); _Pragma("unroll") for (int m = 0; m < 4; ++m) _Pragma("unroll") for (int n = 0; n < 2; ++n) _Pragma("unroll") for (int k = 0; k < 2; ++k) \
        acc[ai][bj][m][n] = __builtin_amdgcn_mfma_f32_16x16x32_bf16(Bt[n][k], At[m][k], acc[ai][bj][m][n], 0, 0, 0); __builtin_amdgcn_s_setprio(0); } while (0)
#define PG8_WAIT_V(n) asm volatile("s_waitcnt vmcnt(" #n ")" ::: "memory")
#define PG8_WAIT_L(n) asm volatile("s_waitcnt lgkmcnt(" #n ")" ::: "memory")
#define PG8_BAR __builtin_amdgcn_s_barrier()
#define PG8_SCHED __builtin_amdgcn_sched_barrier(0)
    Unit cur, nxt; int ui = 0;
    if (!S.next(0, cur)) return;
    if constexpr (has_pre<Epi>::value) E.pre(cur);
    f32x4 acc[2][2][4][2];
#pragma unroll
    for (int a = 0; a < 2; ++a)
#pragma unroll
        for (int b = 0; b < 2; ++b)
#pragma unroll
            for (int m = 0; m < 4; ++m)
#pragma unroll
                for (int n = 0; n < 2; ++n) acc[a][b][m][n] = (f32x4){0.f, 0.f, 0.f, 0.f};
    bf16x8 At[4][2], B0[2][2], B1[2][2];
    const char* cA = (const char*)g.A + (size_t)cur.pm * atstep + (size_t)cur.pn * g.a_pnstep; const char* cB = (const char*)g.Bt + (size_t)cur.pn * tstep;
    PG8_STAGE(PG8_SB(0, 0), cB, voffB); PG8_STAGE(PG8_SA(0, 0), cA, voffA); PG8_STAGE(PG8_SB(0, 1), cB + hstep, voffB); PG8_STAGE(PG8_SA(0, 1), cA + ahstep, voffA);
    if (wr == 1) PG8_BAR;
    PG8_WAIT_V(4); PG8_BAR;
    PG8_STAGE(PG8_SB(1, 0), cB + kstep, voffB); PG8_STAGE(PG8_SA(1, 0), cA + akstep, voffA); PG8_STAGE(PG8_SB(1, 1), cB + hstep + kstep, voffB);
    PG8_WAIT_V(6); PG8_BAR;
    for (;;) {
        const bool has_next = S.next(ui + 1, nxt);
        const char* nA = has_next ? (const char*)g.A + (size_t)nxt.pm * atstep + (size_t)nxt.pn * g.a_pnstep : cA; const char* nB = has_next ? (const char*)g.Bt + (size_t)nxt.pn * tstep : cB;
        for (int t = 0; t < nt; t += 2) {
            const bool last = (t == nt - 2);
            const char* a1 = cA + (size_t)(t + 1) * akstep;
            const char* a2 = last ? nA : cA + (size_t)(t + 2) * akstep; const char* b2 = last ? nB : cB + (size_t)(t + 2) * kstep;
            const char* a3 = a2 + akstep; const char* b3 = b2 + kstep;
            PG8_LDB(B0, 0, 0); PG8_SCHED; PG8_LDA(At, 0, 0); PG8_STAGE(PG8_SA(1, 1), a1 + ahstep, voffA);
            PG8_WAIT_L(8); PG8_BAR; PG8_WAIT_L(0); PG8_MMA(0, 0, At, B0); PG8_BAR; PG8_SCHED;
            PG8_LDB(B1, 0, 1); PG8_STAGE(PG8_SB(0, 0), b2, voffB);
            PG8_BAR; PG8_WAIT_L(0); PG8_MMA(0, 1, At, B1); PG8_BAR;
            PG8_LDA(At, 0, 1); PG8_STAGE(PG8_SA(0, 0), a2, voffA);
            PG8_BAR; PG8_WAIT_L(0); PG8_MMA(1, 0, At, B0); PG8_BAR; PG8_SCHED;
            PG8_STAGE(PG8_SB(0, 1), b2 + hstep, voffB);
            PG8_WAIT_V(6); PG8_BAR; PG8_MMA(1, 1, At, B1); PG8_BAR;
            PG8_LDB(B0, 1, 0); PG8_SCHED; PG8_LDA(At, 1, 0); PG8_STAGE(PG8_SA(0, 1), a2 + ahstep, voffA);
            PG8_WAIT_L(8); PG8_BAR; PG8_WAIT_L(0); PG8_MMA(0, 0, At, B0); PG8_BAR; PG8_SCHED;
            PG8_LDB(B1, 1, 1); PG8_STAGE(PG8_SB(1, 0), b3, voffB);
            PG8_BAR; PG8_WAIT_L(0); PG8_MMA(0, 1, At, B1); PG8_BAR;
            PG8_LDA(At, 1, 1); PG8_STAGE(PG8_SA(1, 0), a3, voffA);
            PG8_BAR; PG8_WAIT_L(0); PG8_MMA(1, 0, At, B0); PG8_BAR; PG8_SCHED;
            PG8_STAGE(PG8_SB(1, 1), b3 + hstep, voffB);
            PG8_WAIT_V(6); PG8_BAR; PG8_MMA(1, 1, At, B1); PG8_BAR;
        }
        if constexpr (has_pre<Epi>::value) E.run(acc, cur, ui, wr, wc, fr, fq, has_next, nxt); else E(acc, cur, ui, wr, wc, fr, fq);
        if (!has_next) break;
#pragma unroll
        for (int a = 0; a < 2; ++a)
#pragma unroll
            for (int b = 0; b < 2; ++b)
#pragma unroll
                for (int m = 0; m < 4; ++m)
#pragma unroll
                    for (int n = 0; n < 2; ++n) acc[a][b][m][n] = (f32x4){0.f, 0.f, 0.f, 0.f};
        cur = nxt; cA = nA; cB = nB; ++ui;
    }
    PG8_WAIT_V(0);
    if (wr == 0) PG8_BAR;
    PG8_BAR;
#undef PG8_SA
#undef PG8_SB
#undef PG8_STAGE
#undef PG8_LDA
#undef PG8_LDB
#undef PG8_MMA
#undef PG8_WAIT_V
#undef PG8_WAIT_L
#undef PG8_BAR
#undef PG8_SCHED
}
}

struct TrJob { const float* W0; int ld0, n0; const float* W1; int ld1, n1; const float* g0; const float* g1; int mode, pb0, pb1; bf16_t* Wt; int K, Nout; };
__device__ __forceinline__ TrJob get_job(int j, const Args& a) {
    unsigned char* ws = a.ws; TrJob t{}; t.W1 = nullptr; t.ld1 = 0; t.n1 = 0; t.g0 = nullptr; t.g1 = nullptr; t.mode = 0; t.pb0 = 0; t.pb1 = 0;
    switch (j) {
    case 0: t.W0 = a.in[2]; t.ld0 = 3072; t.n0 = 0; t.g0 = a.in[1]; t.mode = 1; t.pb0 = 1024; t.pb1 = 2048; t.Wt = (bf16_t*)(ws + WS_WIN); t.K = 1024; t.Nout = 2048; break;
    case 1: t.W0 = a.in[2]; t.ld0 = 3072; t.n0 = 1024; t.g0 = a.in[1]; t.Wt = (bf16_t*)(ws + WS_WIN) + (size_t)2048 * 1024; t.K = 1024; t.Nout = 1024; break;
    case 2: t.W0 = a.in[4]; t.ld0 = 1024; t.n0 = 1024; t.Wt = (bf16_t*)(ws + WS_WOUT); t.K = 1024; t.Nout = 1024; break;
    case 3: t.W0 = a.in[6]; t.ld0 = 5632; t.g0 = a.in[5]; t.mode = 1; t.pb0 = 0; t.pb1 = 2816; t.Wt = (bf16_t*)(ws + WS_WUP0); t.K = 1024; t.Nout = 5632; break;
    case 4: t.W0 = a.in[6] + (size_t)1024 * 5632; t.ld0 = 5632; t.g0 = a.in[5] + 1024; t.mode = 1; t.pb0 = 0; t.pb1 = 2816; t.Wt = (bf16_t*)(ws + WS_WUP1); t.K = 1024; t.Nout = 5632; break;
    case 5: t.W0 = a.in[8]; t.ld0 = 1024; t.n0 = 1024; t.Wt = (bf16_t*)(ws + WS_WDN0); t.K = 2816; t.Nout = 1024; break;
    case 6: t.W0 = a.in[8] + (size_t)2816 * 1024; t.ld0 = 1024; t.n0 = 1024; t.Wt = (bf16_t*)(ws + WS_WDN1); t.K = 2816; t.Nout = 1024; break;
    case 7: t.W0 = a.in[10]; t.ld0 = 1536; t.n0 = 1536; t.g0 = a.in[9]; t.W1 = a.in[15]; t.ld1 = 1072; t.n1 = 1072; t.g1 = a.in[1] + 1024; t.Wt = (bf16_t*)(ws + WS_WKVQG); t.K = 1024; t.Nout = 2816; break;
    case 8: t.W0 = a.in[16]; t.ld0 = 1024; t.n0 = 1024; t.Wt = (bf16_t*)(ws + WS_WO); t.K = 1024; t.Nout = 1024; break;
    case 9: t.W0 = a.in[12]; t.ld0 = 128; t.n0 = 128; t.Wt = (bf16_t*)(ws + WS_W1T); t.K = 2048; t.Nout = 256; break;
    default: t.W0 = a.in[12] + (size_t)2048 * 128; t.ld0 = 128; t.n0 = 128; t.Wt = (bf16_t*)(ws + WS_W1T) + (size_t)256 * 2048; t.K = 2048; t.Nout = 256; break;
    }
    return t;
}
__device__ __forceinline__ void wprep_phase(const Args& a, LAS unsigned char* lds) {
    LAS float* tile = (LAS float*)lds;
    const int tid = threadIdx.x, tx = tid & 63, ty = tid >> 6;
    int jstart = 0;
    for (int j = 0; j < 11; ++j) {
        const TrJob t = get_job(j, a);
        const int nkt = t.K / 64, nnt = t.Nout / 64, ntile = nkt * nnt;
        int first = ((int)blockIdx.x - jstart % (int)gridDim.x + (int)gridDim.x) % (int)gridDim.x;
        for (int ti = first; ti < ntile; ti += gridDim.x) {
            const int kt = ti % nkt, ntl = ti / nkt, k0 = kt * 64, n0 = ntl * 64;
            const int n = n0 + tx; const float* src = nullptr; int ld = 0; const float* gp = t.g0;
            if (t.mode == 1) { const int p = n >> 8, half = (n >> 7) & 1, c = n & 127; src = t.W0 + (half ? t.pb1 : t.pb0) + 128 * p + c; ld = t.ld0; }
            else if (n < t.n0) { src = t.W0 + n; ld = t.ld0; }
            else if (n - t.n0 < t.n1) { src = t.W1 + (n - t.n0); ld = t.ld1; gp = t.g1; }
            __syncthreads();
#pragma unroll
            for (int i = 0; i < 8; ++i) { const int k = k0 + ty + 8 * i; float v = 0.f; if (src) { v = src[(size_t)k * ld]; if (gp) v *= gp[k]; } tile[(ty + 8 * i) * 65 + tx] = v; }
            __syncthreads();
            { const int nn = tid >> 3, kc = (tid & 7) * 8; u32x4 w;
                w.x = cvt_pk_bf16(tile[(kc + 0) * 65 + nn], tile[(kc + 1) * 65 + nn]); w.y = cvt_pk_bf16(tile[(kc + 2) * 65 + nn], tile[(kc + 3) * 65 + nn]);
                w.z = cvt_pk_bf16(tile[(kc + 4) * 65 + nn], tile[(kc + 5) * 65 + nn]); w.w = cvt_pk_bf16(tile[(kc + 6) * 65 + nn], tile[(kc + 7) * 65 + nn]);
                *(u32x4*)(t.Wt + (size_t)(n0 + nn) * t.K + k0 + kc) = w; }
        }
        jstart += ntile;
    }
    if (tid < 64) for (int idx = blockIdx.x; idx < 256; idx += gridDim.x) { const int j = idx >> 7, n = idx & 127; float sacc = 0.f;
            for (int k = tid; k < 2048; k += 64) sacc += a.in[11][j * 2048 + k] * a.in[12][((size_t)j * 2048 + k) * 128 + n];
            sacc = wave_sum(sacc); if (tid == 0) ((float*)(a.ws + WS_B1F))[idx] = sacc + a.in[13][idx]; }
    __syncthreads();
}

__device__ __forceinline__ void rowstat_phase(const float* src, bf16_t* dstb, float* rs, int row0, int nrows) {
    const int wave = threadIdx.x >> 6, lane = threadIdx.x & 63;
    for (int r = blockIdx.x * 8 + wave; r < nrows; r += gridDim.x * 8) {
        const size_t row = (size_t)(row0 + r); const float* p = src + row * DM; float ss = 0.f;
#pragma unroll
        for (int i = 0; i < 2; ++i) { const int c = i * 512 + lane * 8; const f32x4 v0 = __builtin_nontemporal_load((const f32x4*)(p + c)), v1 = __builtin_nontemporal_load((const f32x4*)(p + c + 4));
            ss += ((v0[0] * v0[0] + v0[1] * v0[1]) + (v0[2] * v0[2] + v0[3] * v0[3])) + ((v1[0] * v1[0] + v1[1] * v1[1]) + (v1[2] * v1[2] + v1[3] * v1[3]));
            if (dstb) { u32x4 w; w.x = cvt_pk_bf16(v0[0], v0[1]); w.y = cvt_pk_bf16(v0[2], v0[3]); w.z = cvt_pk_bf16(v1[0], v1[1]); w.w = cvt_pk_bf16(v1[2], v1[3]); *(u32x4*)(dstb + row * DM + c) = w; } }
        ss = wave_sum(ss);
        if (lane == 0) rs[row] = rsqrtf(ss * (1.0f / DM) + 1e-6f);
    }
}
__device__ __forceinline__ void final_phase(float* out, const bf16_t* xb, const float* ssp, const float* gain, int row0, int nrows) {
    const int wave = threadIdx.x >> 6, lane = threadIdx.x & 63;
    for (int r = blockIdx.x * 8 + wave; r < nrows; r += gridDim.x * 8) {
        const size_t row = (size_t)(row0 + r);
        float ss = lane < 16 ? ssp[row * 16 + lane] : 0.f; ss = wave_sum(ss);
        const float sc = rsqrtf(ss * (1.0f / DM) + 1e-6f);
#pragma unroll
        for (int i = 0; i < 2; ++i) { const int c = i * 512 + lane * 8; const bf16x8 v = __builtin_nontemporal_load((const bf16x8*)(xb + row * DM + c));
            const f32x4 g0 = *(const f32x4*)(gain + c), g1 = *(const f32x4*)(gain + c + 4);
            f32x4 o0, o1;
#pragma unroll
            for (int j = 0; j < 4; ++j) { o0[j] = bf2f((bf16_t)v[j]) * sc * g0[j]; o1[j] = bf2f((bf16_t)v[4 + j]) * sc * g1[j]; }
            __builtin_nontemporal_store(o0, (f32x4*)(out + row * DM + c)); __builtin_nontemporal_store(o1, (f32x4*)(out + row * DM + c + 4)); }
    }
}
__device__ __forceinline__ void compress_out_phase(const Args& a, LAS unsigned char* lds) {
    const float* H = (const float*)(a.ws + WS_HID); bf16_t* kcb = (bf16_t*)(a.ws + WS_KCB); const float* w2 = a.in[14];
    LAS float* w2s = (LAS float*)lds;
    const int tid = threadIdx.x, wave = tid >> 6, lane = tid & 63;
    LAS float* hrow = w2s + 2 * 128 * 64 + wave * 128;
    for (int e = tid; e < 2 * 128 * 64; e += NTHREADS) w2s[e] = w2[e];
    __syncthreads();
    for (int r = blockIdx.x * 8 + wave; r < 2 * 16384; r += gridDim.x * 8) {
        const int j = r >> 14, row = r & 16383, i = (row >> 2) & 127;
        hrow[lane] = H[(size_t)r * 128 + lane]; hrow[lane + 64] = H[(size_t)r * 128 + 64 + lane];
        asm volatile("s_waitcnt lgkmcnt(0)" ::: "memory");
        float o = 0.f;
#pragma unroll 8
        for (int n = 0; n < 128; ++n) o += hrow[n] * w2s[(j * 128 + n) * 64 + lane];
        kcb[(size_t)r * 64 + lane] = (i == 127) ? (bf16_t)0 : f2bf(o);
        asm volatile("s_waitcnt lgkmcnt(0)" ::: "memory");
    }
    __syncthreads();
}
__device__ __forceinline__ int rel_bucket(int d) { if (d < 16) return d; const int l = 16 + (int)(logf((float)d / 16.0f) / 2.0794415416798357f * 16.0f); return l < 31 ? l : 31; }

typedef float f32x16 __attribute__((ext_vector_type(16)));
typedef short s16x4 __attribute__((ext_vector_type(4)));
typedef __bf16 bf16x2_t __attribute__((ext_vector_type(2)));
#define MFMA32(a, b, c) __builtin_amdgcn_mfma_f32_32x32x16_bf16((a), (b), (c), 0, 0, 0)
constexpr int TP = 144, TILE_B = 64 * TP;
constexpr int TABN = 336;
constexpr int AT_IMP = 4 * TILE_B, AT_SELM = AT_IMP + 4 * 64 * 33 * 4, AT_BTAB = AT_SELM + 256, AT_BUCK = AT_BTAB + TABN * 16, AT_OUT = AT_BUCK + 512, AT_END = AT_OUT + 8 * 8192;
constexpr float LOG2E = 1.4426950408889634f;
__device__ __forceinline__ unsigned pk2(float a, float b) { const f32x2 v = {a, b}; return __builtin_bit_cast(unsigned, __builtin_convertvector(v, bf16x2_t)); }
__device__ __forceinline__ int crow16(int i) { return (i & 3) + 8 * (i >> 2); }

__device__ __forceinline__ float xor32f(float v, int xaddr) { return __builtin_bit_cast(float, __builtin_amdgcn_ds_bpermute(xaddr, __builtin_bit_cast(int, v))); }
template <int CTRL> __device__ __forceinline__ unsigned dppu(unsigned v) { return (unsigned)__builtin_amdgcn_update_dpp(0, (int)v, CTRL, 0xf, 0xf, true); }
struct AttnState { f32x16 O[2]; float m, l; int xaddr; };

template <int BR, bool PASS2>
__device__ __forceinline__ void attn_block(LAS unsigned char* lds, int Kt, int Vt, int kpos0, bool selbit, const bf16x8 (&qf)[4], AttnState& st, int hh, int tq, int lane,
                                           float inv, LAS float* improw, float& eprev, int blk, bool win) {
    const int h = lane >> 5, l31 = lane & 31;
    const int tq0 = __builtin_amdgcn_readfirstlane(tq - l31);
    if (BR != 0) { if (tq0 + 31 < kpos0) return; if (win && tq0 - (kpos0 + 63) >= 512) return; }
    f32x16 S[2];
#pragma unroll
    for (int kb = 0; kb < 2; ++kb) {
#pragma unroll
        for (int i = 0; i < 16; ++i) S[kb][i] = 0.f;
#pragma unroll
        for (int s = 0; s < 4; ++s) { const bf16x8 kf = *(const LAS bf16x8*)(lds + Kt + (32 * kb + l31) * TP + (16 * s + 8 * h) * 2); S[kb] = MFMA32(kf, qf[s], S[kb]); }
    }
    const LAS float* btab = (const LAS float*)(lds + AT_BTAB);
    const bool fast = (BR != 0) && (tq0 - (kpos0 + 63) >= 113) && (!win || (tq0 + 31 - kpos0) <= 511);
    float mx = -INFINITY, cb = 0.f; const bool okl = (BR == 1) ? (selbit || win) : true;
    const bool nearp = (BR == 1) && !fast && (tq0 + 31 - kpos0) <= 271;
    if (fast) { cb = btab[(127 + 64) * 4 + hh]; float mr = S[0][0];
#pragma unroll
        for (int kb = 0; kb < 2; ++kb)
#pragma unroll
            for (int i = 0; i < 16; ++i) mr = fmaxf(mr, S[kb][i]);
        mx = okl ? __builtin_fmaf(mr, LOG2E, cb) : -INFINITY;
    } else if (nearp) {
        const LAS float* tb = btab + (tq - kpos0 - 4 * h + 64 - 59) * 4 + hh;
#pragma unroll
        for (int kb = 0; kb < 2; ++kb)
#pragma unroll
            for (int i0 = 0; i0 < 16; i0 += 8) { float bv[8];
#pragma unroll
                for (int e = 0; e < 8; ++e) bv[e] = tb[(59 - 32 * kb - crow16(i0 + e)) * 4];
                __builtin_amdgcn_sched_barrier(0);
#pragma unroll
                for (int e = 0; e < 8; ++e) { const float v = __builtin_fmaf(S[kb][i0 + e], LOG2E, bv[e]); S[kb][i0 + e] = v; mx = fmaxf(mx, v); }
                __builtin_amdgcn_sched_barrier(0); }
        mx = okl ? mx : -INFINITY;
    } else {
#pragma unroll
        for (int kb = 0; kb < 2; ++kb)
#pragma unroll
            for (int i0 = 0; i0 < 16; i0 += 8) {
                float bv[8]; float pen[8];
#pragma unroll
                for (int e = 0; e < 8; ++e) { const int i = i0 + e; const int kidx = kpos0 + 32 * kb + 4 * h + crow16(i); const int dist = tq - ((BR == 0) ? (16 * kidx + 31) : kidx);
                    const int dc = dist < -1 ? -1 : (dist > 127 ? 127 : dist);
                    bv[e] = btab[(dc + 64) * 4 + hh]; pen[e] = (BR == 1 && win && dist >= 512) ? -INFINITY : 0.f; }
                __builtin_amdgcn_sched_barrier(0);
#pragma unroll
                for (int e = 0; e < 8; ++e) { const int i = i0 + e; float v = __builtin_fmaf(S[kb][i], LOG2E, bv[e]); if (BR == 1) v += pen[e]; S[kb][i] = v; mx = fmaxf(mx, v); }
                __builtin_amdgcn_sched_barrier(0);
            }
        if (BR == 1) mx = okl ? mx : -INFINITY;
    }
    __builtin_amdgcn_sched_barrier(0);
    if (!PASS2) {
        mx = fmaxf(mx, xor32f(mx, st.xaddr));
        const float mnew = fmaxf(st.m, mx), muse = (mnew == -INFINITY) ? 0.f : mnew, alpha = __builtin_amdgcn_exp2f(st.m - muse);
        float ls = 0.f;
        if (fast) { const float cbm = okl ? (cb - muse) : -INFINITY;
#pragma unroll
            for (int kb = 0; kb < 2; ++kb)
#pragma unroll
                for (int i = 0; i < 16; ++i) { const float pv = __builtin_amdgcn_exp2f(__builtin_fmaf(S[kb][i], LOG2E, cbm)); S[kb][i] = pv; ls += pv; }
        } else { const float musel = (BR == 1 && !okl) ? INFINITY : muse;
#pragma unroll
            for (int kb = 0; kb < 2; ++kb)
#pragma unroll
                for (int i = 0; i < 16; ++i) { const float pv = __builtin_amdgcn_exp2f(S[kb][i] - musel); S[kb][i] = pv; ls += pv; }
        }
        st.l = st.l * alpha + ls; st.m = mnew;
        if (__builtin_amdgcn_ballot_w64(alpha != 1.0f) != 0ull) {
#pragma unroll
            for (int db = 0; db < 2; ++db)
#pragma unroll
                for (int i = 0; i < 16; ++i) st.O[db][i] *= alpha; }
        const int i16 = lane & 15, q4 = i16 >> 2, p4 = i16 & 3, b16 = (lane >> 4) & 1;
        LAS unsigned char* vbase = lds + Vt + (4 * h + q4) * TP + 32 * b16 + 8 * p4;
#pragma unroll
        for (int kb = 0; kb < 2; ++kb) {
            bf16x8 vf[2][2];
#pragma unroll
            for (int s2 = 0; s2 < 2; ++s2)
#pragma unroll
                for (int db = 0; db < 2; ++db) { LAS unsigned char* va = vbase + (32 * kb + 16 * s2) * TP + db * 64;
                    const s16x4 lo = __builtin_bit_cast(s16x4, __builtin_amdgcn_ds_read_tr16_b64_v4i16((LAS s16x4*)va));
                    const s16x4 hi = __builtin_bit_cast(s16x4, __builtin_amdgcn_ds_read_tr16_b64_v4i16((LAS s16x4*)(va + 8 * TP)));
                    vf[s2][db] = __builtin_shufflevector(lo, hi, 0, 1, 2, 3, 4, 5, 6, 7); }
            __builtin_amdgcn_sched_barrier(0);
#pragma unroll
            for (int s2 = 0; s2 < 2; ++s2) {
                u32x4 pw; pw.x = pk2(S[kb][8 * s2 + 0], S[kb][8 * s2 + 1]); pw.y = pk2(S[kb][8 * s2 + 2], S[kb][8 * s2 + 3]); pw.z = pk2(S[kb][8 * s2 + 4], S[kb][8 * s2 + 5]); pw.w = pk2(S[kb][8 * s2 + 6], S[kb][8 * s2 + 7]);
                const bf16x8 pf = __builtin_bit_cast(bf16x8, pw);
#pragma unroll
                for (int db = 0; db < 2; ++db) st.O[db] = MFMA32(vf[s2][db], pf, st.O[db]);
            }
            __builtin_amdgcn_sched_barrier(0);
        }
    } else {
        const float muse = (st.m == -INFINITY) ? 0.f : st.m;
#pragma unroll
        for (int kb = 0; kb < 2; ++kb)
#pragma unroll
            for (int gq = 0; gq < 4; ++gq) {
                const float p0 = __builtin_amdgcn_exp2f(S[kb][4 * gq] - muse) * inv, p1 = __builtin_amdgcn_exp2f(S[kb][4 * gq + 1] - muse) * inv,
                            p2 = __builtin_amdgcn_exp2f(S[kb][4 * gq + 2] - muse) * inv, p3 = __builtin_amdgcn_exp2f(S[kb][4 * gq + 3] - muse) * inv;
                const float esw = xor32f(p3, st.xaddr);
                const float val = ((p0 + p1) + (p2 + p3)) + (h ? esw : eprev);
                improw[16 * blk + 8 * kb + 2 * gq + h] = val; eprev = esw; }
    }
}

__device__ __forceinline__ void attn_mfma_phase(const Args& a, LAS unsigned char* lds) {
    const bf16_t* kv = (const bf16_t*)(a.ws + WS_KV); const bf16_t* qb_ = (const bf16_t*)(a.ws + WS_Q); const float* gate = (const float*)(a.ws + WS_GATE);
    const bf16_t* kcb = (const bf16_t*)(a.ws + WS_KCB); bf16_t* yo = (bf16_t*)(a.ws + WS_Y); const float* relb = a.in[17];
    int tid_ = threadIdx.x; asm volatile("" : "+v"(tid_));
    const int tid = tid_, wid = __builtin_amdgcn_readfirstlane(tid >> 6), lane = tid & 63, hh = wid >> 1, qh = wid & 1, h = lane >> 5, l31 = lane & 31;
    const int lkey = tid >> 3, lch = tid & 7;
    LAS int* buck = (LAS int*)(lds + AT_BUCK); LAS float* btab = (LAS float*)(lds + AT_BTAB); LAS unsigned* selm = (LAS unsigned*)(lds + AT_SELM); LAS float* imp = (LAS float*)(lds + AT_IMP);
    if (tid < 128) buck[tid] = rel_bucket(tid);
    __syncthreads();
    const int nitems = NB * 32 * 4;
    const bool swz = gridDim.x == 256; const int bx_ = blockIdx.x, sx = bx_ & 7, ss_ = bx_ >> 3, sgrp = ss_ >> 3, sq8 = ss_ & 7;
    const int nk = swz ? 16 : (nitems - bx_ + (int)gridDim.x - 1) / (int)gridDim.x;
    for (int kk = 0; kk < nk; ++kk) {
        int qb, b, g;
        if (swz) { const int bg = sx * 16 + (kk >> 2) * 4 + sgrp, t4 = kk & 3; qb = t4 == 0 ? sq8 : (t4 == 1 ? 15 - sq8 : (t4 == 2 ? 16 + sq8 : 31 - sq8)); b = bg >> 2; g = bg & 3; }
        else { const int it = bx_ + kk * (int)gridDim.x; qb = it >> 7; b = (it >> 2) & 31; g = it & 3; }
        const int qs = 64 * qb, head = g * 4 + hh, tq = qs + 32 * qh + l31;
        const size_t rowq = (size_t)b * SEQ + tq;
        bf16x8 qf[4];
#pragma unroll
        for (int s = 0; s < 4; ++s) qf[s] = *(const bf16x8*)(qb_ + rowq * DM + head * 64 + 16 * s + 8 * h);
        const float* gp = gate + rowq * 48 + head * 3; const float g0 = gp[0], g1 = gp[1], g2 = gp[2];
        __syncthreads();
        for (int e = tid; e < TABN * 4; e += NTHREADS) { const int d = (e >> 2) - 64; btab[e] = d < 0 ? -INFINITY : relb[buck[d > 127 ? 127 : d] * 16 + g * 4 + (e & 3)] * LOG2E; }
        {
            const bf16_t* kc = kcb + (((size_t)b * 128) * 4 + g) * 64; const bf16_t* vc = kc + (size_t)NB * 128 * 4 * 64;
#pragma unroll
            for (int blk = 0; blk < 2; ++blk) { const u32x4 kx = *(const u32x4*)(kc + (size_t)(64 * blk + lkey) * 256 + lch * 8), vx = *(const u32x4*)(vc + (size_t)(64 * blk + lkey) * 256 + lch * 8);
                *(LAS u32x4*)(lds + blk * TILE_B + lkey * TP + lch * 16) = kx; *(LAS u32x4*)(lds + (2 + blk) * TILE_B + lkey * TP + lch * 16) = vx; }
        }
        __syncthreads();
        AttnState st; float edummy = 0.f; LAS unsigned char* outp = lds + AT_OUT + wid * 8192 + lane * 16;
#pragma unroll
        for (int db = 0; db < 2; ++db)
#pragma unroll
            for (int i = 0; i < 16; ++i) st.O[db][i] = 0.f;
        st.m = -INFINITY; st.l = 0.f; st.xaddr = (lane ^ 32) << 2;
#pragma nounroll
        for (int blk = 0; blk < (qb >= 16 ? 2 : 1); ++blk)
            attn_block<0, false>(lds, blk * TILE_B, (2 + blk) * TILE_B, 64 * blk, true, qf, st, hh, tq, lane, 0.f, nullptr, edummy, blk, false);
        {   const float lt = st.l + xor32f(st.l, st.xaddr), inv = lt > 0.f ? 1.0f / lt : 0.f, sc = g0 * inv;
#pragma unroll
            for (int db = 0; db < 2; ++db)
#pragma unroll
                for (int gq = 0; gq < 4; ++gq) { const f32x4 v = {st.O[db][4 * gq] * sc, st.O[db][4 * gq + 1] * sc, st.O[db][4 * gq + 2] * sc, st.O[db][4 * gq + 3] * sc};
                    *(LAS f32x4*)(outp + (db * 4 + gq) * 1024) = v; st.O[db][4 * gq] = 0.f; st.O[db][4 * gq + 1] = 0.f; st.O[db][4 * gq + 2] = 0.f; st.O[db][4 * gq + 3] = 0.f; }
            if (qb >= 16) { float ep = 0.f; LAS float* improw = imp + (hh * 64 + 32 * qh + l31) * 33;
#pragma nounroll
                for (int blk = 0; blk < 2; ++blk) attn_block<0, true>(lds, blk * TILE_B, (2 + blk) * TILE_B, 64 * blk, true, qf, st, hh, tq, lane, inv, improw, ep, blk, false); }
            st.m = -INFINITY; st.l = 0.f; }
        __syncthreads();
        if (qb >= 16) {
            {
                const int q = tid >> 3, j0 = (tid & 7) * 4;
#pragma unroll
                for (int u = 0; u < 4; ++u) { const int j = j0 + u; imp[q * 33 + j] = (imp[(0 * 64 + q) * 33 + j] + imp[(1 * 64 + q) * 33 + j]) + (imp[(2 * 64 + q) * 33 + j] + imp[(3 * 64 + q) * 33 + j]); }
            }
            __syncthreads();
            const int q = tid >> 3, sub = tid & 7; unsigned mk = 0u;
            for (int u = 0; u < 4; ++u) { const int s = 4 * sub + u; const float mine = imp[q * 33 + s];
                int rank = 0;
                for (int j = 1; j < 32; ++j) { const float ij = imp[q * 33 + j]; const bool cj = (j < qb - 1); if (cj && (ij > mine || (ij == mine && j < s))) ++rank; }
                const bool forced = (s == 0) || (s == qb) || (s == qb - 1); if (forced || (s <= qb && rank < 13)) mk |= 1u << s; }
            mk |= dppu<0xB1>(mk); mk |= dppu<0x4E>(mk); mk |= dppu<0x141>(mk);
            if (sub == 0) selm[q] = mk;
        } else if (tid < 64) selm[tid] = (qb >= 31) ? 0xffffffffu : ((2u << qb) - 1u);
        __syncthreads();
        const unsigned mysel = selm[32 * qh + l31];
        const int nsel = qb + 1, wlo = qb > 8 ? qb - 8 : 0, nstep = nsel + (qb - wlo + 1);
        const bf16_t* kvb = kv + (size_t)b * SEQ * NKV + g * 64;
        u32x4 kx, vx;
        { const bf16_t* r0 = kvb + (size_t)(0 + lkey) * NKV + lch * 8; kx = *(const u32x4*)(r0 + 2 * 256); vx = *(const u32x4*)(r0 + 3 * 256); }
        *(LAS u32x4*)(lds + 0 * TILE_B + lkey * TP + lch * 16) = kx; *(LAS u32x4*)(lds + 2 * TILE_B + lkey * TP + lch * 16) = vx;
        __syncthreads();
        for (int k = 0; k < nstep; ++k) {
            const int buf = k & 1;
            if (k + 1 < nstep) { const int k1 = k + 1, isw = k1 >= nsel, jb1 = isw ? wlo + (k1 - nsel) : k1; const bf16_t* r0 = kvb + (size_t)(64 * jb1 + lkey) * NKV + lch * 8 + (isw ? 4 * 256 : 2 * 256);
                kx = *(const u32x4*)r0; vx = *(const u32x4*)(r0 + 256); }
            if (k == nsel) {
                const float lt = st.l + xor32f(st.l, st.xaddr), sc = g1 / lt;
#pragma unroll
                for (int db = 0; db < 2; ++db)
#pragma unroll
                    for (int gq = 0; gq < 4; ++gq) { f32x4 v = *(LAS f32x4*)(outp + (db * 4 + gq) * 1024);
                        v[0] += st.O[db][4 * gq] * sc; v[1] += st.O[db][4 * gq + 1] * sc; v[2] += st.O[db][4 * gq + 2] * sc; v[3] += st.O[db][4 * gq + 3] * sc;
                        *(LAS f32x4*)(outp + (db * 4 + gq) * 1024) = v; st.O[db][4 * gq] = 0.f; st.O[db][4 * gq + 1] = 0.f; st.O[db][4 * gq + 2] = 0.f; st.O[db][4 * gq + 3] = 0.f; }
                st.m = -INFINITY; st.l = 0.f; }
            { const bool isw = k >= nsel; const int jbk = isw ? wlo + k - nsel : k;
              attn_block<1, false>(lds, buf * TILE_B, (2 + buf) * TILE_B, 64 * jbk, (mysel >> (jbk & 31)) & 1u, qf, st, hh, tq, lane, 0.f, nullptr, edummy, 0, isw); }
            if (k + 1 < nstep) { *(LAS u32x4*)(lds + (buf ^ 1) * TILE_B + lkey * TP + lch * 16) = kx; *(LAS u32x4*)(lds + (2 + (buf ^ 1)) * TILE_B + lkey * TP + lch * 16) = vx; }
            __syncthreads();
        }
        {   const float lt = st.l + xor32f(st.l, st.xaddr), sc = g2 / lt;
            u32x2 w[2][4];
#pragma unroll
            for (int db = 0; db < 2; ++db)
#pragma unroll
                for (int gq = 0; gq < 4; ++gq) { const f32x4 v = *(LAS f32x4*)(outp + (db * 4 + gq) * 1024);
                    w[db][gq].x = pk2(v[0] + st.O[db][4 * gq] * sc, v[1] + st.O[db][4 * gq + 1] * sc); w[db][gq].y = pk2(v[2] + st.O[db][4 * gq + 2] * sc, v[3] + st.O[db][4 * gq + 3] * sc); }
            LAS unsigned char* tp = lds + AT_OUT + wid * 8192;
#pragma unroll
            for (int db = 0; db < 2; ++db)
#pragma unroll
                for (int gq = 0; gq < 4; ++gq) *(LAS u32x2*)(tp + l31 * TP + (32 * db + 8 * gq + 4 * h) * 2) = w[db][gq];
            asm volatile("s_waitcnt lgkmcnt(0)" ::: "memory");
            bf16_t* obase = yo + ((size_t)b * SEQ + qs + 32 * qh) * DM + head * 64;
#pragma unroll
            for (int it = 0; it < 4; ++it) { const int r = (lane >> 3) + 8 * it, ch = lane & 7; const u32x4 v = *(const LAS u32x4*)(tp + r * TP + ch * 16); *(u32x4*)(obase + (size_t)r * DM + ch * 8) = v; }
        }
    }
    __syncthreads();
}

#define XB_TMO      128
#define XB_XCNT(j)  (256  + 64 * (j))
#define XB_XSUB(j)  (1280 + 64 * (j))
#define XB_XGEN(j)  (2304 + 64 * (j))
#define XB_TOP      3328
#define XB_TOPGEN   3392
#define XCD_BAR_WORDS 3456
#define XB_SPIN_CAP (1u << 18)
__device__ __forceinline__ unsigned xb_ld(unsigned* p)              { return __hip_atomic_load(p, __ATOMIC_RELAXED, __HIP_MEMORY_SCOPE_AGENT); }
__device__ __forceinline__ unsigned xb_add(unsigned* p, unsigned v) { return __hip_atomic_fetch_add(p, v, __ATOMIC_RELAXED, __HIP_MEMORY_SCOPE_AGENT); }
__device__ __forceinline__ unsigned xb_xcc_id() { return (unsigned)__builtin_amdgcn_s_getreg((3 << 11) | 20) & 0xFu; }
#define XB_SPIN(cond, bar) do { unsigned _sp = 0; while (cond) { __builtin_amdgcn_s_sleep(1); \
    if ((++_sp & 255u) == 0u) { if (xb_ld(&(bar)[XB_TMO])) break; if (_sp > XB_SPIN_CAP) { atomicAdd(&(bar)[XB_TMO], 1u); break; } } } } while (0)
struct XcdBarrier { unsigned* bar; unsigned x; volatile LAS unsigned* st; };
__device__ __forceinline__ XcdBarrier xcd_barrier_post(unsigned* bar, volatile LAS unsigned* st) {
    XcdBarrier b; b.bar = bar; b.x = xb_xcc_id(); b.st = st;
    if (threadIdx.x == 0) (void)xb_add(&bar[XB_XCNT(b.x)], 1u);
    return b;
}
__device__ __forceinline__ void xcd_barrier_complete(unsigned* bar, unsigned x, unsigned& nloc, unsigned& nx) {
    const unsigned G = gridDim.x * gridDim.y * gridDim.z;
    unsigned sum, cnt, mine, sp = 0u;
    for (;;) {
        sum = 0u; cnt = 0u; mine = 0u;
#pragma unroll
        for (unsigned j = 0; j < 16; ++j) { const unsigned c = xb_ld(&bar[XB_XCNT(j)]); sum += c; cnt += (c > 0u) ? 1u : 0u; mine = (j == x) ? c : mine; }
        if (sum == G) break;
        __builtin_amdgcn_s_sleep(1);
        if ((++sp & 255u) == 0u) { if (xb_ld(&bar[XB_TMO])) break; if (sp > XB_SPIN_CAP) { atomicAdd(&bar[XB_TMO], 1u); break; } }
    }
    nloc = mine > 0u ? mine : 1u; nx = cnt > 0u ? cnt : 1u;
}
__device__ __forceinline__ void xcd_barrier(const XcdBarrier& b) {
    asm volatile("s_waitcnt vmcnt(0)" ::: "memory");
    __syncthreads();
    if (threadIdx.x == 0) {
        unsigned* bar = b.bar;
        __builtin_amdgcn_s_waitcnt(0);
        unsigned nloc = b.st[0], nx = b.st[1];
        if (nloc == 0u) { xcd_barrier_complete(bar, b.x, nloc, nx); b.st[0] = nloc; b.st[1] = nx; }
        const unsigned old = xb_add(&bar[XB_XSUB(b.x)], 1u);
        const unsigned gen = old / nloc;
        if (old + 1u == (gen + 1u) * nloc) {
            __builtin_amdgcn_fence(__ATOMIC_RELEASE, "agent");
            asm volatile("s_waitcnt vmcnt(0)" ::: "memory");
            const unsigned og = xb_add(&bar[XB_TOP], 1u);
            const unsigned tg = og / nx;
            if (og + 1u == (tg + 1u) * nx) xb_add(&bar[XB_TOPGEN], 1u);
            else XB_SPIN(xb_ld(&bar[XB_TOPGEN]) == tg, bar);
            __builtin_amdgcn_fence(__ATOMIC_ACQUIRE, "agent");
            xb_add(&bar[XB_XGEN(b.x)], 1u);
            asm volatile("s_waitcnt vmcnt(0)" ::: "memory");
        } else {
            XB_SPIN(xb_ld(&bar[XB_XGEN(b.x)]) == gen, bar);
            __builtin_amdgcn_fence(__ATOMIC_ACQUIRE, "agent");
            asm volatile("s_waitcnt vmcnt(0)" ::: "memory");
        }
    }
    __syncthreads();
}

enum { PH_WPREP = 0, PH_XPREP, PH_INCV, PH_INB, PH_OUTPROJ, PH_UP0, PH_DN0, PH_KVQG, PH_CMP, PH_CMP2, PH_ATTN, PH_WO, PH_UP1, PH_DN1, PH_FINAL, PH_COUNT };

__global__ void __launch_bounds__(NTHREADS, 2) mk_fwd(Args a) {
    extern __shared__ __attribute__((aligned(16))) unsigned char lds_raw[];
    LAS unsigned char* lds = (LAS unsigned char*)lds_raw;
    LAS float* exch = (LAS float*)(lds + 131072); LAS float* epc = (LAS float*)(lds + EPC_OFF);
    unsigned char* ws = a.ws;
    const int G = gridDim.x, bx = blockIdx.x;
    const float* x_in = a.in[0]; float* xo = a.out;
    bf16_t* HB = (bf16_t*)(ws + WS_HB); bf16_t* ACT = (bf16_t*)(ws + WS_BIG); bf16_t* Y = (bf16_t*)(ws + WS_Y); bf16_t* CVC = (bf16_t*)(ws + WS_RAW);
    float* RS = (float*)(ws + WS_RS); float* SSP = (float*)(ws + WS_SSP);
    const int lo = a.ph_lo, hi = a.ph_hi;
#define IN(k) (lo <= (k) && (k) < hi)
    volatile LAS unsigned* xst = (volatile LAS unsigned*)(lds + 147456);
    if (threadIdx.x < 4) xst[threadIdx.x] = 0u;
    __syncthreads();
    const XcdBarrier xbar = xcd_barrier_post((unsigned*)(ws + WS_BAR), xst);
#define SEAM(k) do { if (IN(k) && IN((k) + 1)) xcd_barrier(xbar); } while (0)
    if (hi < 0) cg::this_grid().sync();

    if (IN(PH_WPREP)) wprep_phase(a, lds);
    if (IN(PH_XPREP)) rowstat_phase(x_in, HB, RS, 0, MROWS);
    SEAM(PH_XPREP);
    if (IN(PH_INCV)) { pg8::Gemm g = pg8::dense(HB, (const bf16_t*)(ws + WS_WIN), MROWS, 2048, 1024); g.aperm = 1; pg8::ChainOrder S; S.init(8, G, bx);
        pg8::EpiConvPair<1, false> E{RS, a.in[3], DM, 0, CVC, DM, exch, epc}; pg8::gemm_phase(lds, g, S, E); }
    SEAM(PH_INCV);
    if (IN(PH_INB)) { const pg8::Gemm g = pg8::dense(HB, (const bf16_t*)(ws + WS_WIN) + (size_t)2048 * 1024, MROWS, 1024, 1024); pg8::StaticOrder S; S.init(MROWS, 1024, G, bx);
        pg8::EpiMulB E{RS, CVC, Y}; pg8::gemm_phase(lds, g, S, E); }
    SEAM(PH_INB);
    if (IN(PH_OUTPROJ)) { const pg8::Gemm g = pg8::dense(Y, (const bf16_t*)(ws + WS_WOUT), MROWS, 1024, 1024); pg8::StaticOrder S; S.init(MROWS, 1024, G, bx);
        pg8::EpiResid<true, false> E{x_in, HB, nullptr, SSP}; pg8::gemm_phase(lds, g, S, E); }
    SEAM(PH_OUTPROJ);
    if (IN(PH_UP0)) { pg8::Gemm g = pg8::dense(HB, (const bf16_t*)(ws + WS_WUP0), MROWS, 5632, 1024); g.aperm = 1; pg8::ChainOrder S; S.init(22, G, bx);
        pg8::EpiConvPair<0, true> E{SSP, a.in[7], 5632, DFF, ACT, DFF, exch, epc}; pg8::gemm_phase(lds, g, S, E); }
    SEAM(PH_UP0);
    if (IN(PH_DN0)) { const pg8::Gemm g = pg8::dense(ACT, (const bf16_t*)(ws + WS_WDN0), MROWS, 1024, 2816); pg8::StaticOrder S; S.init(MROWS, 1024, G, bx);
        pg8::EpiResid<false, false> E{nullptr, HB, nullptr, SSP}; pg8::gemm_phase(lds, g, S, E); }
    SEAM(PH_DN0);
    if (IN(PH_KVQG)) { const pg8::Gemm g = pg8::dense(HB, (const bf16_t*)(ws + WS_WKVQG), MROWS, NKVQG, 1024); pg8::StaticOrder S; S.init(MROWS, NKVQG, G, bx);
        pg8::EpiKVQG E{SSP, (bf16_t*)(ws + WS_KV), (bf16_t*)(ws + WS_Q), (float*)(ws + WS_GATE)}; pg8::gemm_phase(lds, g, S, E); }
    SEAM(PH_KVQG);
    if (IN(PH_CMP)) { pg8::Gemm g = pg8::dense((const bf16_t*)(ws + WS_KV), (const bf16_t*)(ws + WS_W1T), 16384, 512, 2048);
        g.amode = 1; g.a_kstep = (size_t)NKV * 2; g.a_hstep = (size_t)32 * 16 * NKV * 2; g.a_tstep = (size_t)1024 * NKV * 2; g.a_pnstep = 512;
        pg8::StaticOrder S; S.init(16384, 512, G, bx); pg8::EpiCmpHidden E{(const float*)(ws + WS_B1F), (float*)(ws + WS_HID)}; pg8::gemm_phase(lds, g, S, E); }
    SEAM(PH_CMP);
    if (IN(PH_CMP2)) compress_out_phase(a, lds);
    SEAM(PH_CMP2);
    if (IN(PH_ATTN)) attn_mfma_phase(a, lds);
    SEAM(PH_ATTN);
    if (IN(PH_WO)) { const pg8::Gemm g = pg8::dense(Y, (const bf16_t*)(ws + WS_WO), MROWS, 1024, 1024); pg8::StaticOrder S; S.init(MROWS, 1024, G, bx);
        pg8::EpiResid<false, false> E{nullptr, HB, nullptr, SSP}; pg8::gemm_phase(lds, g, S, E); }
    SEAM(PH_WO);
    if (IN(PH_UP1)) { pg8::Gemm g = pg8::dense(HB, (const bf16_t*)(ws + WS_WUP1), MROWS, 5632, 1024); g.aperm = 1; pg8::ChainOrder S; S.init(22, G, bx);
        pg8::EpiConvPair<0, true> E{SSP, a.in[7] + 3 * 5632, 5632, DFF, ACT, DFF, exch, epc}; pg8::gemm_phase(lds, g, S, E); }
    SEAM(PH_UP1);
    if (IN(PH_DN1)) { const pg8::Gemm g = pg8::dense(ACT, (const bf16_t*)(ws + WS_WDN1), MROWS, 1024, 2816); pg8::StaticOrder S; S.init(MROWS, 1024, G, bx);
        pg8::EpiResid<false, false> E{nullptr, HB, nullptr, SSP}; pg8::gemm_phase(lds, g, S, E); }
    SEAM(PH_DN1);
    if (IN(PH_FINAL)) final_phase(xo, HB, SSP, a.in[18], 0, MROWS);
#undef IN
#undef SEAM
}

extern "C" void kernel_launch(void* const* d_in, const int* in_sizes, int n_in, void* d_out, int out_size, void* d_ws, size_t ws_size, hipStream_t stream) {
    static int grid = 0;
    if (grid == 0) {
        if (n_in != 19 || ws_size < WS_END) { fprintf(stderr, "kernel_launch: unexpected shapes (n_in %d, ws %zu < %zu)\n", n_in, ws_size, (size_t)WS_END); grid = -1; return; }
        int dev = 0, cus = 0;
        (void)hipGetDevice(&dev); (void)hipDeviceGetAttribute(&cus, hipDeviceAttributeMultiprocessorCount, dev);
        if (hipFuncSetAttribute((const void*)mk_fwd, hipFuncAttributeMaxDynamicSharedMemorySize, LDS_BYTES) != hipSuccess) { fprintf(stderr, "kernel_launch: hipFuncSetAttribute failed\n"); grid = -1; return; }
        int per_cu = 0;
        if (hipOccupancyMaxActiveBlocksPerMultiprocessor(&per_cu, (const void*)mk_fwd, NTHREADS, LDS_BYTES) != hipSuccess || per_cu < 1) per_cu = 1;
        (void)hipGetLastError();
        grid = (cus > 0 ? cus : 256) * per_cu;
    }
    if (grid < 0) return;
    Args a{};
    for (int i = 0; i < 19; ++i) a.in[i] = (const float*)d_in[i];
    a.out = (float*)d_out; a.ws = (unsigned char*)d_ws;
    (void)hipMemsetAsync((unsigned char*)d_ws + WS_BAR, 0, 16384, stream);
    a.ph_lo = 0; a.ph_hi = PH_COUNT;
    void* kargs[] = {&a};
    hipError_t e = hipLaunchCooperativeKernel((const void*)mk_fwd, dim3(grid), dim3(NTHREADS), kargs, LDS_BYTES, stream);
    if (e != hipSuccess) fprintf(stderr, "cooperative launch failed: %s (grid %d)\n", hipGetErrorString(e), grid);
}
```

```cpp
#include <hip/hip_runtime.h>
#include <hip/hip_cooperative_groups.h>
#include <cstdio>
#include <type_traits>
namespace cg = cooperative_groups;

#define LAS __attribute__((address_space(3)))
typedef unsigned short bf16_t;
typedef short bf16x8 __attribute__((ext_vector_type(8)));
typedef float f32x4 __attribute__((ext_vector_type(4)));
typedef float f32x2 __attribute__((ext_vector_type(2)));
typedef unsigned u32x4 __attribute__((ext_vector_type(4)));
typedef unsigned u32x2 __attribute__((ext_vector_type(2)));

constexpr int NB = 32, SEQ = 2048, DM = 1024, DFF = 2816, MROWS = NB * SEQ;
constexpr int NKV = 1536, NQG = 1072, NKVQG = 2816, NCMP = 127;
constexpr int NTHREADS = 512;
constexpr int EPC_OFF = 147456 + 16, LDS_BYTES = EPC_OFF + 8192;

constexpr size_t WS_WIN = 0;
constexpr size_t WS_WOUT = WS_WIN + (size_t)3072 * 1024 * 2;
constexpr size_t WS_WUP0 = WS_WOUT + (size_t)1024 * 1024 * 2;
constexpr size_t WS_WUP1 = WS_WUP0 + (size_t)5632 * 1024 * 2;
constexpr size_t WS_WDN0 = WS_WUP1 + (size_t)5632 * 1024 * 2;
constexpr size_t WS_WDN1 = WS_WDN0 + (size_t)1024 * 2816 * 2;
constexpr size_t WS_WKVQG = WS_WDN1 + (size_t)1024 * 2816 * 2;
constexpr size_t WS_WO = WS_WKVQG + (size_t)2816 * 1024 * 2;
constexpr size_t WS_W1T = WS_WO + (size_t)1024 * 1024 * 2;
constexpr size_t WS_B1F = WS_W1T + (size_t)2 * 256 * 2048 * 2;
constexpr size_t WS_HB = 56ull << 20;
constexpr size_t WS_BIG = WS_HB + (size_t)MROWS * 1024 * 2;
constexpr size_t WS_KV = WS_BIG;
constexpr size_t WS_Q = WS_BIG + (size_t)MROWS * NKV * 2;
constexpr size_t WS_Y = WS_BIG + (size_t)MROWS * DFF * 2;
constexpr size_t WS_RAW = WS_Y + (size_t)MROWS * 1024 * 2;
constexpr size_t WS_GATE = WS_RAW + (size_t)16384 * 5632 * 2;
constexpr size_t WS_KCMP = WS_GATE + (size_t)MROWS * 48 * 4;
constexpr size_t WS_RS = WS_KCMP + (size_t)2 * 32 * 128 * 4 * 64 * 4;
constexpr size_t WS_KCB = WS_RS + (size_t)MROWS * 4;
constexpr size_t WS_HID = WS_KCB + (size_t)2 * 32 * 128 * 4 * 64 * 2;
constexpr size_t WS_SSP = WS_HID + (size_t)2 * 16384 * 128 * 4;
constexpr size_t WS_BAR = WS_SSP + (size_t)MROWS * 16 * 4;
constexpr size_t WS_END = WS_BAR + 16384;

__device__ __forceinline__ float bf2f(bf16_t b) { return __uint_as_float(((unsigned)b) << 16); }
__device__ __forceinline__ bf16_t f2bf(float f) { unsigned u = __float_as_uint(f); u += 0x7fffu + ((u >> 16) & 1u); return (bf16_t)(u >> 16); }
__device__ __forceinline__ unsigned cvt_pk_bf16(float lo, float hi) { unsigned r; asm volatile("v_cvt_pk_bf16_f32 %0, %1, %2" : "=v"(r) : "v"(lo), "v"(hi)); return r; }
__device__ __forceinline__ float wave_sum(float v) { for (int o = 32; o >= 1; o >>= 1) v += __shfl_xor(v, o); return v; }
__device__ __forceinline__ float wave_max(float v) { for (int o = 32; o >= 1; o >>= 1) v = fmaxf(v, __shfl_xor(v, o)); return v; }

__device__ __forceinline__ float gelu_tanh(float x) { const float u = 0.7978845608028654f * (x + 0.044715f * x * x * x); return 0.5f * x * (1.0f + tanhf(u)); }
struct Args { const float* in[19]; float* out; unsigned char* ws; int ph_lo, ph_hi, seq0, nseq, nchunk, pad; };

namespace pg8 {
constexpr int BM = 256, BK = 64, HALF = 128, HTB = HALF * BK * 2, STAGE_BYTES = 8 * HTB, NXCD = 8, WGM = 8;
__host__ __device__ __forceinline__ int lds_byte(int r, int c) { const int st = (r >> 4) * 2 + (c >> 5), rr = r & 15, cc = c & 31, ob = rr * 64 + cc * 2; return st * 1024 + (ob ^ (((ob >> 9) & 1) << 5)); }
__host__ __device__ __forceinline__ void stage_rc(int b, int& R, int& C) { const int st = b / 1024, sb = b % 1024, swz = sb ^ (((sb >> 9) & 1) << 5); R = (st >> 1) * 16 + swz / 64; C = (st & 1) * 32 + (swz % 64) / 2; }
__host__ __device__ __forceinline__ int perm32(int rho) { const int n = rho >> 4, i = rho & 15; return 8 * (i >> 2) + 4 * n + (i & 3); }
struct Unit { int pm, pn; };
struct Gemm { const bf16_t* A; const bf16_t* Bt; int M, N, K; int amode, aperm; size_t a_kstep, a_hstep, a_tstep, a_pnstep; };
__device__ __forceinline__ Gemm dense(const bf16_t* A, const bf16_t* Bt, int M, int N, int K) { Gemm g; g.A = A; g.Bt = Bt; g.M = M; g.N = N; g.K = K; g.amode = 0; g.aperm = 0; g.a_kstep = 128; g.a_hstep = (size_t)128 * K * 2; g.a_tstep = (size_t)256 * K * 2; g.a_pnstep = 0; return g; }
struct StaticOrder {
    int nM, nN, nwg, G, c;
    __device__ void init(int M, int N, int G_, int c_) { nM = M / BM; nN = N / BM; nwg = nM * nN; G = G_; c = c_; }
    __device__ bool next(int i, Unit& u) const {
        const long L = (long)i * G + c; if (L >= nwg) return false;
        int wgid = (int)L; { const int q = nwg / NXCD, r = nwg % NXCD, xcd = wgid % NXCD, off = wgid / NXCD; wgid = (xcd < r ? xcd * (q + 1) : r * (q + 1) + (xcd - r) * q) + off; }
        const int nig = WGM * nN, gid = wgid / nig, fm = gid * WGM, gsz = (nM - fm) < WGM ? (nM - fm) : WGM;
        u.pm = fm + ((wgid % nig) % gsz); u.pn = (wgid % nig) / gsz; return true;
    }
};

__device__ __forceinline__ float row_scale16(const float* ssp, int row, int fq) {
    const f32x4 p = *(const f32x4*)(ssp + (size_t)row * 16 + 4 * fq); float s = (p[0] + p[1]) + (p[2] + p[3]);
    s += __shfl_xor(s, 16); s += __shfl_xor(s, 32); return rsqrtf(s * (1.0f / DM) + 1e-6f); }
template <bool BASE_F32, bool OUT_F32> struct EpiResid {
    static constexpr bool PERM = true;
    const float* base32; bf16_t* xb; float* out32; float* ssp;
    __device__ __forceinline__ void operator()(f32x4 (&acc)[2][2][4][2], const Unit& u, int ui, int wr, int wc, int fr, int fq) const {
        const int row0 = u.pm * BM + wr * 64 + fr, col0 = u.pn * BM + wc * 32 + 8 * fq;
#pragma unroll
        for (int ai = 0; ai < 2; ++ai) {
            u32x4 bb[4][2]; f32x4 bf[4][2][2];
#pragma unroll
            for (int m = 0; m < 4; ++m)
#pragma unroll
                for (int bj = 0; bj < 2; ++bj) { const size_t o = (size_t)(row0 + ai * HALF + m * 16) * DM + col0 + bj * HALF;
                    if (BASE_F32) { bf[m][bj][0] = __builtin_nontemporal_load((const f32x4*)(base32 + o)); bf[m][bj][1] = __builtin_nontemporal_load((const f32x4*)(base32 + o + 4)); } else bb[m][bj] = *(const u32x4*)(xb + o); }
            __builtin_amdgcn_sched_barrier(0);
#pragma unroll
            for (int m = 0; m < 4; ++m) { const int row = row0 + ai * HALF + m * 16; const size_t off = (size_t)row * DM + col0; float ss = 0.f;
#pragma unroll
                for (int bj = 0; bj < 2; ++bj) { const size_t o = off + bj * HALF; f32x4 v0, v1;
                    if (BASE_F32) { v0 = bf[m][bj][0]; v1 = bf[m][bj][1]; }
                    else { const u32x4 b = bb[m][bj];
                        v0 = (f32x4){__uint_as_float(b.x << 16), __uint_as_float(b.x & 0xffff0000u), __uint_as_float(b.y << 16), __uint_as_float(b.y & 0xffff0000u)};
                        v1 = (f32x4){__uint_as_float(b.z << 16), __uint_as_float(b.z & 0xffff0000u), __uint_as_float(b.w << 16), __uint_as_float(b.w & 0xffff0000u)}; }
                    v0 += acc[ai][bj][m][0]; v1 += acc[ai][bj][m][1];
                    ss += ((v0[0] * v0[0] + v0[1] * v0[1]) + (v0[2] * v0[2] + v0[3] * v0[3])) + ((v1[0] * v1[0] + v1[1] * v1[1]) + (v1[2] * v1[2] + v1[3] * v1[3]));
                    if (OUT_F32) { *(f32x4*)(out32 + o) = v0; *(f32x4*)(out32 + o + 4) = v1; }
                    else { u32x4 w; w.x = cvt_pk_bf16(v0[0], v0[1]); w.y = cvt_pk_bf16(v0[2], v0[3]); w.z = cvt_pk_bf16(v1[0], v1[1]); w.w = cvt_pk_bf16(v1[2], v1[3]); *(u32x4*)(xb + o) = w; } }
                if (!OUT_F32) { ss += __shfl_xor(ss, 16); ss += __shfl_xor(ss, 32); if (fq == 0) ssp[(size_t)row * 16 + u.pn * 4 + wc] = ss; } }
        }
    }
};
struct EpiKVQG {
    static constexpr bool PERM = true;
    const float* ssp; bf16_t* kv; bf16_t* q; float* gate; LAS float* cache;
    struct Pref { f32x4 p0, p1; };
    __device__ __forceinline__ void issue(const Unit& nu, Pref& r) const { const int tid = threadIdx.x; const size_t row = (size_t)nu.pm * BM + (tid >> 1);
        r.p0 = *(const f32x4*)(ssp + row * 16 + 8 * (tid & 1)); r.p1 = *(const f32x4*)(ssp + row * 16 + 8 * (tid & 1) + 4); }
    __device__ __forceinline__ void commit(int par, const Pref& r) const { const int tid = threadIdx.x;
        float ss = ((r.p0[0] + r.p0[1]) + (r.p0[2] + r.p0[3])) + ((r.p1[0] + r.p1[1]) + (r.p1[2] + r.p1[3])); ss += __shfl_xor(ss, 1);
        if ((tid & 1) == 0) cache[par * 1024 + 768 + (tid >> 1)] = rsqrtf(ss * (1.0f / DM) + 1e-6f); }
    __device__ __forceinline__ void pre(const Unit& u) const { Pref r; issue(u, r); commit(0, r); }
    __device__ __forceinline__ void run(f32x4 (&acc)[2][2][4][2], const Unit& u, int ui, int wr, int wc, int fr, int fq, bool has_next, const Unit& nu) const {
        Pref pf; if (has_next) issue(nu, pf);
        const LAS float* cc = cache + (ui & 1) * 1024 + 768 + wr * 64 + fr;
        const int row0 = u.pm * BM + wr * 64 + fr, cin = wc * 32 + 8 * fq;
        float rsc[2][4];
#pragma unroll
        for (int ai = 0; ai < 2; ++ai)
#pragma unroll
            for (int m = 0; m < 4; ++m) rsc[ai][m] = cc[ai * HALF + m * 16];
#pragma unroll
        for (int ai = 0; ai < 2; ++ai)
#pragma unroll
            for (int m = 0; m < 4; ++m) { const int row = row0 + ai * HALF + m * 16; const float s = rsc[ai][m];
#pragma unroll
                for (int bj = 0; bj < 2; ++bj) { f32x4 v0 = acc[ai][bj][m][0] * s, v1 = acc[ai][bj][m][1] * s; const int col = cin + bj * HALF;
                    if (u.pn < 6) { u32x4 w; w.x = cvt_pk_bf16(v0[0], v0[1]); w.y = cvt_pk_bf16(v0[2], v0[3]); w.z = cvt_pk_bf16(v1[0], v1[1]); w.w = cvt_pk_bf16(v1[2], v1[3]);
                        *(u32x4*)(kv + (size_t)row * NKV + u.pn * BM + col) = w; }
                    else if (u.pn < 10) { v0 *= 0.125f; v1 *= 0.125f; u32x4 w; w.x = cvt_pk_bf16(v0[0], v0[1]); w.y = cvt_pk_bf16(v0[2], v0[3]); w.z = cvt_pk_bf16(v1[0], v1[1]); w.w = cvt_pk_bf16(v1[2], v1[3]);
                        *(u32x4*)(q + (size_t)row * DM + (u.pn - 6) * BM + col) = w; }
                    else if (col < 48) { f32x4 g0, g1;
#pragma unroll
                        for (int j = 0; j < 4; ++j) { g0[j] = 1.0f / (1.0f + __expf(-v0[j])); g1[j] = 1.0f / (1.0f + __expf(-v1[j])); }
                        *(f32x4*)(gate + (size_t)row * 48 + col) = g0; *(f32x4*)(gate + (size_t)row * 48 + col + 4) = g1; } } }
        if (has_next) commit((ui & 1) ^ 1, pf);
    }
};

struct ChainOrder {
    int nP, nchain_x, G8, xcd, slot; bool live;
    __device__ void init(int nP_, int G, int c) { nP = nP_; G8 = G / 8; xcd = c % 8; slot = c / 8; nchain_x = (NB / 8) * nP; live = c < 8 * G8; }
    __device__ bool next(int i, Unit& u) const {
        const int ci = i >> 3, w = i & 7, Lx = ci * G8 + slot; if (!live || Lx >= nchain_x) return false;
        const int seq = (Lx & 3) * 8 + xcd; u.pn = Lx >> 2; u.pm = seq * 8 + w; return true; }
};
template <int CTRL> __device__ __forceinline__ float dppf(float old, float src) {
    return __builtin_bit_cast(float, __builtin_amdgcn_update_dpp(__builtin_bit_cast(int, old), __builtin_bit_cast(int, src), CTRL, 0xf, 0xf, false)); }

template <int MODE, bool SSP> struct EpiConvPair {
    static constexpr bool PERM = true;
    const float* rs; const float* cw; int cw_ld, goff; bf16_t* O; int ldo; LAS float* exch; LAS float* cache;
    struct Pref { f32x4 w; f32x4 p0, p1; };
    __device__ __forceinline__ void issue(const Unit& nu, Pref& r) const {
        const int tid = threadIdx.x; r.w = (f32x4){0.f, 0.f, 0.f, 0.f};
        if (tid < (MODE == 0 ? 192 : 96)) { const int tt = tid >> 5, type = tt / 3, tap = tt % 3; r.w = *(const f32x4*)(cw + (size_t)tap * cw_ld + type * goff + nu.pn * HALF + (tid & 31) * 4); }
        const size_t row = (size_t)nu.pm * BM + (tid >> 1);
        if (SSP) { r.p0 = *(const f32x4*)(rs + row * 16 + 8 * (tid & 1)); r.p1 = *(const f32x4*)(rs + row * 16 + 8 * (tid & 1) + 4); } else { r.p0 = (f32x4){rs[row], 0.f, 0.f, 0.f}; r.p1 = r.p0; }
    }
    __device__ __forceinline__ void commit(int par, const Pref& r) const {
        const int tid = threadIdx.x; LAS float* c = cache + par * 1024;
        if (tid < (MODE == 0 ? 192 : 96)) *(LAS f32x4*)(c + (tid >> 5) * 128 + (tid & 31) * 4) = r.w;
        float sc;
        if (SSP) { float ss = ((r.p0[0] + r.p0[1]) + (r.p0[2] + r.p0[3])) + ((r.p1[0] + r.p1[1]) + (r.p1[2] + r.p1[3])); ss += dppf<0xB1>(0.f, ss); sc = rsqrtf(ss * (1.0f / DM) + 1e-6f); } else sc = r.p0[0];
        if ((tid & 1) == 0) c[768 + (tid >> 1)] = sc;
    }
    __device__ __forceinline__ void pre(const Unit& u) const { Pref r; issue(u, r); commit(0, r); }
    __device__ __forceinline__ void run(f32x4 (&acc)[2][2][4][2], const Unit& u, int ui, int wr, int wc, int fr, int fq, bool has_next, const Unit& nu) const {
        Pref pf; if (has_next) issue(nu, pf);
        const LAS float* cc = cache + (ui & 1) * 1024;
        const int row0 = u.pm * BM + wr * 64 + 4 * fr, lcol = wc * 32 + 8 * fq, lrow0 = wr * 64 + 4 * fr;
#pragma unroll
        for (int ai = 0; ai < 2; ++ai)
#pragma unroll
            for (int m = 0; m < 4; ++m) { const float sc = cc[768 + lrow0 + ai * HALF + m];
#pragma unroll
                for (int n = 0; n < 2; ++n) { if (MODE == 0) { acc[ai][0][m][n] *= sc; acc[ai][1][m][n] *= sc; } else acc[ai][0][m][n] = (acc[ai][0][m][n] * sc) * (acc[ai][1][m][n] * sc); } }
        LAS float* ex = exch + (ui & 1) * 2048;
        if (fr == 15) {
#pragma unroll
            for (int ai = 0; ai < 2; ++ai)
#pragma unroll
                for (int r = 0; r < 2; ++r) { LAS float* p = ex + ((ai * 2 + wr) * 2 + r) * 256 + lcol;
                    *(LAS f32x4*)p = acc[ai][0][2 + r][0]; *(LAS f32x4*)(p + 4) = acc[ai][0][2 + r][1];
                    if (MODE == 0) { *(LAS f32x4*)(p + 128) = acc[ai][1][2 + r][0]; *(LAS f32x4*)(p + 132) = acc[ai][1][2 + r][1]; } } }
        asm volatile("s_waitcnt lgkmcnt(0)" ::: "memory"); __builtin_amdgcn_s_barrier(); asm volatile("" ::: "memory"); __builtin_amdgcn_s_barrier(); asm volatile("" ::: "memory");
        const int f = u.pn * HALF + lcol;
        u32x2 keep[2][4];
#pragma unroll
        for (int n = 0; n < 2; ++n) {
            f32x4 wa[3], wg[3];
#pragma unroll
            for (int k = 0; k < 3; ++k) { wa[k] = *(const LAS f32x4*)(cc + k * 128 + lcol + 4 * n); if (MODE == 0) wg[k] = *(const LAS f32x4*)(cc + (3 + k) * 128 + lcol + 4 * n); }
#pragma unroll
            for (int ai = 0; ai < 2; ++ai) {
                const int blk = ai * 2 + wr;
                f32x4 ba2 = (f32x4){0.f, 0.f, 0.f, 0.f}, ba3 = ba2, bg2 = ba2, bg3 = ba2;
                const LAS float* src = nullptr;
                if (blk > 0) src = ex + (blk - 1) * 512; else if ((u.pm & 7) != 0) src = exch + ((ui & 1) ^ 1) * 2048 + 3 * 512;
                if (src != nullptr) { const LAS float* p = src + lcol + 4 * n; ba2 = *(const LAS f32x4*)p; ba3 = *(const LAS f32x4*)(p + 256);
                    if (MODE == 0) { bg2 = *(const LAS f32x4*)(p + 128); bg3 = *(const LAS f32x4*)(p + 256 + 128); } }
                float o[4][4];
#pragma unroll
                for (int j = 0; j < 4; ++j) {
                    const float v0 = acc[ai][0][0][n][j], v1 = acc[ai][0][1][n][j], v2 = acc[ai][0][2][n][j], v3 = acc[ai][0][3][n][j];
                    const float p2 = dppf<0x111>(ba2[j], v2), p3 = dppf<0x111>(ba3[j], v3);
                    const float w0 = wa[0][j], w1 = wa[1][j], w2 = wa[2][j];
                    float y[4] = {w2 * v0 + w1 * p3 + w0 * p2, w2 * v1 + w1 * v0 + w0 * p3, w2 * v2 + w1 * v1 + w0 * v0, w2 * v3 + w1 * v2 + w0 * v1};
                    if (MODE == 0) {
                        const float g0 = acc[ai][1][0][n][j], g1 = acc[ai][1][1][n][j], g2 = acc[ai][1][2][n][j], g3 = acc[ai][1][3][n][j];
                        const float q2 = dppf<0x111>(bg2[j], g2), q3 = dppf<0x111>(bg3[j], g3);
                        const float x0 = wg[0][j], x1 = wg[1][j], x2 = wg[2][j];
                        const float z[4] = {x2 * g0 + x1 * q3 + x0 * q2, x2 * g1 + x1 * g0 + x0 * q3, x2 * g2 + x1 * g1 + x0 * g0, x2 * g3 + x1 * g2 + x0 * g1};
#pragma unroll
                        for (int m = 0; m < 4; ++m) o[m][j] = y[m] * __builtin_amdgcn_rcpf(1.0f + __expf(-y[m])) * z[m];
                    } else {
#pragma unroll
                        for (int m = 0; m < 4; ++m) o[m][j] = y[m];
                    }
                }
#pragma unroll
                for (int m = 0; m < 4; ++m) { u32x2 w; w.x = cvt_pk_bf16(o[m][0], o[m][1]); w.y = cvt_pk_bf16(o[m][2], o[m][3]);
                    if (n == 0) keep[ai][m] = w;
                    else { u32x4 w4; w4.x = keep[ai][m].x; w4.y = keep[ai][m].y; w4.z = w.x; w4.w = w.y; __builtin_nontemporal_store(w4, (u32x4*)(O + (size_t)(row0 + ai * HALF + m) * ldo + f)); } }
            }
            __builtin_amdgcn_sched_barrier(0);
        }
        if (has_next) commit((ui & 1) ^ 1, pf);
    }
};
template <class T, class = void> struct has_pre : std::false_type {};
template <class T> struct has_pre<T, std::void_t<decltype(&T::pre)>> : std::true_type {};
struct EpiCmpHidden {
    static constexpr bool PERM = true;
    const float* b1f; float* H;
    __device__ __forceinline__ void operator()(f32x4 (&acc)[2][2][4][2], const Unit& u, int ui, int wr, int wc, int fr, int fq) const {
        const int row0 = u.pm * BM + wr * 64 + fr, col = wc * 32 + 8 * fq;
        const f32x4 b0 = *(const f32x4*)(b1f + u.pn * 128 + col), b1 = *(const f32x4*)(b1f + u.pn * 128 + col + 4);
#pragma unroll
        for (int ai = 0; ai < 2; ++ai)
#pragma unroll
            for (int m = 0; m < 4; ++m) { const int row = row0 + ai * HALF + m * 16; f32x4 v0 = acc[ai][0][m][0] + b0, v1 = acc[ai][0][m][1] + b1;
#pragma unroll
                for (int j = 0; j < 4; ++j) { v0[j] = gelu_tanh(v0[j]); v1[j] = gelu_tanh(v1[j]); }
                float* hp = H + ((size_t)u.pn * 16384 + row) * 128 + col; *(f32x4*)hp = v0; *(f32x4*)(hp + 4) = v1; }
    }
};
struct EpiMulB {
    static constexpr bool PERM = true;
    const float* rs; const bf16_t* other; bf16_t* Yo;
    __device__ __forceinline__ void operator()(f32x4 (&acc)[2][2][4][2], const Unit& u, int ui, int wr, int wc, int fr, int fq) const {
        const int row0 = u.pm * BM + wr * 64 + fr, col0 = u.pn * BM + wc * 32 + 8 * fq;
#pragma unroll
        for (int ai = 0; ai < 2; ++ai) {
            float sc[4]; bf16x8 ov[4][2];
#pragma unroll
            for (int m = 0; m < 4; ++m) { const int row = row0 + ai * HALF + m * 16; sc[m] = rs[row];
#pragma unroll
                for (int bj = 0; bj < 2; ++bj) ov[m][bj] = *(const bf16x8*)(other + (size_t)row * DM + col0 + bj * HALF); }
            __builtin_amdgcn_sched_barrier(0);
#pragma unroll
            for (int m = 0; m < 4; ++m) { const int row = row0 + ai * HALF + m * 16;
#pragma unroll
                for (int bj = 0; bj < 2; ++bj) { const size_t o = (size_t)row * DM + col0 + bj * HALF; const bf16x8 q = ov[m][bj];
                    const f32x4 v0 = acc[ai][bj][m][0] * sc[m], v1 = acc[ai][bj][m][1] * sc[m]; u32x4 w;
                    w.x = cvt_pk_bf16(v0[0] * bf2f((bf16_t)q[0]), v0[1] * bf2f((bf16_t)q[1])); w.y = cvt_pk_bf16(v0[2] * bf2f((bf16_t)q[2]), v0[3] * bf2f((bf16_t)q[3]));
                    w.z = cvt_pk_bf16(v1[0] * bf2f((bf16_t)q[4]), v1[1] * bf2f((bf16_t)q[5])); w.w = cvt_pk_bf16(v1[2] * bf2f((bf16_t)q[6]), v1[3] * bf2f((bf16_t)q[7]));
                    *(u32x4*)(Yo + o) = w; } }
        }
    }
};

template <class Epi, class Sched>
__device__ __forceinline__ void gemm_phase(LAS unsigned char* lds, const Gemm g, const Sched& S, const Epi& E) {
    int tid_ = threadIdx.x; asm volatile("" : "+v"(tid_));
    const int tid = tid_, wid = __builtin_amdgcn_readfirstlane(tid >> 6), lane = tid & 63, wr = wid >> 2, wc = wid & 3, fr = lane & 15, fq = lane >> 4;
    const int K = g.K, nt = K / BK;
    unsigned voffA[2], voffB[2];
#pragma unroll
    for (int i = 0; i < 2; ++i) { int R, C; stage_rc(tid * 16 + i * 8192, R, C); const int Rb = Epi::PERM ? ((R & ~31) + perm32(R & 31)) : R;
        const int Ra = g.aperm ? ((R & ~63) | ((R & 15) << 2) | ((R >> 4) & 3)) : R;
        voffA[i] = g.amode ? (unsigned)((R >> 2) * (16 * NKV) + (R & 3) * 64 + C) * 2u : (unsigned)(Ra * K + C) * 2u; voffB[i] = (unsigned)(Rb * K + C) * 2u; }
    const size_t kstep = (size_t)(BK * 2), hstep = (size_t)HALF * K * 2, tstep = 2 * hstep;
    const size_t akstep = g.a_kstep, ahstep = g.a_hstep, atstep = g.a_tstep;
    const unsigned ldsw = (unsigned)wid * 1024u;
    const int aoff = lds_byte(wr * 64 + fr, fq * 8), boff = lds_byte(wc * 32 + fr, fq * 8);
#define PG8_SA(b, h) (((b) * 2 + (h)) * HTB)
#define PG8_SB(b, h) ((4 + (b) * 2 + (h)) * HTB)
#define PG8_STAGE(bufoff, gbase, voff) do { _Pragma("unroll") for (int _i = 0; _i < 2; ++_i) \
        __builtin_amdgcn_global_load_lds((const unsigned*)((const char*)(gbase) + (voff)[_i]), (LAS unsigned*)(lds + (bufoff) + ldsw + _i * 8192), 16, 0, 0); } while (0)
#define PG8_LDA(dst, b, h) do { _Pragma("unroll") for (int m = 0; m < 4; ++m) _Pragma("unroll") for (int k = 0; k < 2; ++k) dst[m][k] = *(const LAS bf16x8*)(lds + PG8_SA(b, h) + aoff + m * 2048 + k * 1024); } while (0)
#define PG8_LDB(dst, b, h) do { _Pragma("unroll") for (int n = 0; n < 2; ++n) _Pragma("unroll") for (int k = 0; k < 2; ++k) dst[n][k] = *(const LAS bf16x8*)(lds + PG8_SB(b, h) + boff + n * 2048 + k * 1024); } while (0)
#define PG8_MMA(ai, bj, At, Bt) do { __builtin_amdgcn_s_setprio(1); _Pragma("unroll") for (int m = 0; m < 4; ++m) _Pragma("unroll") for (int n = 0; n < 2; ++n) _Pragma("unroll") for (int k = 0; k < 2; ++k) \
        acc[ai][bj][m][n] = __builtin_amdgcn_mfma_f32_16x16x32_bf16(Bt[n][k], At[m][k], acc[ai][bj][m][n], 0, 0, 0); __builtin_amdgcn_s_setprio(0); } while (0)
#define PG8_WAIT_V(n) asm volatile("s_waitcnt vmcnt(" #n ")" ::: "memory")
#define PG8_WAIT_L(n) asm volatile("s_waitcnt lgkmcnt(" #n ")" ::: "memory")
#define PG8_BAR __builtin_amdgcn_s_barrier()
#define PG8_SCHED __builtin_amdgcn_sched_barrier(0)
    Unit cur, nxt; int ui = 0;
    if (!S.next(0, cur)) return;
    if constexpr (has_pre<Epi>::value) E.pre(cur);
    f32x4 acc[2][2][4][2];
#pragma unroll
    for (int a = 0; a < 2; ++a)
#pragma unroll
        for (int b = 0; b < 2; ++b)
#pragma unroll
            for (int m = 0; m < 4; ++m)
#pragma unroll
                for (int n = 0; n < 2; ++n) acc[a][b][m][n] = (f32x4){0.f, 0.f, 0.f, 0.f};
    bf16x8 At[4][2], B0[2][2], B1[2][2];
    const char* cA = (const char*)g.A + (size_t)cur.pm * atstep + (size_t)cur.pn * g.a_pnstep; const char* cB = (const char*)g.Bt + (size_t)cur.pn * tstep;
    PG8_STAGE(PG8_SB(0, 0), cB, voffB); PG8_STAGE(PG8_SA(0, 0), cA, voffA); PG8_STAGE(PG8_SB(0, 1), cB + hstep, voffB); PG8_STAGE(PG8_SA(0, 1), cA + ahstep, voffA);
    if (wr == 1) PG8_BAR;
    PG8_WAIT_V(4); PG8_BAR;
    PG8_STAGE(PG8_SB(1, 0), cB + kstep, voffB); PG8_STAGE(PG8_SA(1, 0), cA + akstep, voffA); PG8_STAGE(PG8_SB(1, 1), cB + hstep + kstep, voffB);
    PG8_WAIT_V(6); PG8_BAR;
    for (;;) {
        const bool has_next = S.next(ui + 1, nxt);
        const char* nA = has_next ? (const char*)g.A + (size_t)nxt.pm * atstep + (size_t)nxt.pn * g.a_pnstep : cA; const char* nB = has_next ? (const char*)g.Bt + (size_t)nxt.pn * tstep : cB;
        for (int t = 0; t < nt; t += 2) {
            const bool last = (t == nt - 2);
            const char* a1 = cA + (size_t)(t + 1) * akstep;
            const char* a2 = last ? nA : cA + (size_t)(t + 2) * akstep; const char* b2 = last ? nB : cB + (size_t)(t + 2) * kstep;
            const char* a3 = a2 + akstep; const char* b3 = b2 + kstep;
            PG8_LDB(B0, 0, 0); PG8_SCHED; PG8_LDA(At, 0, 0); PG8_STAGE(PG8_SA(1, 1), a1 + ahstep, voffA);
            PG8_WAIT_L(8); PG8_BAR; PG8_WAIT_L(0); PG8_MMA(0, 0, At, B0); PG8_BAR; PG8_SCHED;
            PG8_LDB(B1, 0, 1); PG8_STAGE(PG8_SB(0, 0), b2, voffB);
            PG8_BAR; PG8_WAIT_L(0); PG8_MMA(0, 1, At, B1); PG8_BAR;
            PG8_LDA(At, 0, 1); PG8_STAGE(PG8_SA(0, 0), a2, voffA);
            PG8_BAR; PG8_WAIT_L(0); PG8_MMA(1, 0, At, B0); PG8_BAR; PG8_SCHED;
            PG8_STAGE(PG8_SB(0, 1), b2 + hstep, voffB);
            PG8_WAIT_V(6); PG8_BAR; PG8_MMA(1, 1, At, B1); PG8_BAR;
            PG8_LDB(B0, 1, 0); PG8_SCHED; PG8_LDA(At, 1, 0); PG8_STAGE(PG8_SA(0, 1), a2 + ahstep, voffA);
            PG8_WAIT_L(8); PG8_BAR; PG8_WAIT_L(0); PG8_MMA(0, 0, At, B0); PG8_BAR; PG8_SCHED;
            PG8_LDB(B1, 1, 1); PG8_STAGE(PG8_SB(1, 0), b3, voffB);
            PG8_BAR; PG8_WAIT_L(0); PG8_MMA(0, 1, At, B1); PG8_BAR;
            PG8_LDA(At, 1, 1); PG8_STAGE(PG8_SA(1, 0), a3, voffA);
            PG8_BAR; PG8_WAIT_L(0); PG8_MMA(1, 0, At, B0); PG8_BAR; PG8_SCHED;
            PG8_STAGE(PG8_SB(1, 1), b3 + hstep, voffB);
            PG8_WAIT_V(6); PG8_BAR; PG8_MMA(1, 1, At, B1); PG8_BAR;
        }
        if constexpr (has_pre<Epi>::value) E.run(acc, cur, ui, wr, wc, fr, fq, has_next, nxt); else E(acc, cur, ui, wr, wc, fr, fq);
        if (!has_next) break;
#pragma unroll
        for (int a = 0; a < 2; ++a)
#pragma unroll
            for (int b = 0; b < 2; ++b)
#pragma unroll
                for (int m = 0; m < 4; ++m)
#pragma unroll
                    for (int n = 0; n < 2; ++n) acc[a][b][m][n] = (f32x4){0.f, 0.f, 0.f, 0.f};
        cur = nxt; cA = nA; cB = nB; ++ui;
    }
    PG8_WAIT_V(0);
    if (wr == 0) PG8_BAR;
    PG8_BAR;
#undef PG8_SA
#undef PG8_SB
#undef PG8_STAGE
#undef PG8_LDA
#undef PG8_LDB
#undef PG8_MMA
#undef PG8_WAIT_V
#undef PG8_WAIT_L
#undef PG8_BAR
#undef PG8_SCHED
}
}

struct TrJob { const float* W0; int ld0, n0; const float* W1; int ld1, n1; const float* g0; const float* g1; int mode, pb0, pb1; bf16_t* Wt; int K, Nout; };
__device__ __forceinline__ TrJob get_job(int j, const Args& a) {
    unsigned char* ws = a.ws; TrJob t{}; t.W1 = nullptr; t.ld1 = 0; t.n1 = 0; t.g0 = nullptr; t.g1 = nullptr; t.mode = 0; t.pb0 = 0; t.pb1 = 0;
    switch (j) {
    case 0: t.W0 = a.in[2]; t.ld0 = 3072; t.n0 = 0; t.g0 = a.in[1]; t.mode = 1; t.pb0 = 1024; t.pb1 = 2048; t.Wt = (bf16_t*)(ws + WS_WIN); t.K = 1024; t.Nout = 2048; break;
    case 1: t.W0 = a.in[2]; t.ld0 = 3072; t.n0 = 1024; t.g0 = a.in[1]; t.Wt = (bf16_t*)(ws + WS_WIN) + (size_t)2048 * 1024; t.K = 1024; t.Nout = 1024; break;
    case 2: t.W0 = a.in[4]; t.ld0 = 1024; t.n0 = 1024; t.Wt = (bf16_t*)(ws + WS_WOUT); t.K = 1024; t.Nout = 1024; break;
    case 3: t.W0 = a.in[6]; t.ld0 = 5632; t.g0 = a.in[5]; t.mode = 1; t.pb0 = 0; t.pb1 = 2816; t.Wt = (bf16_t*)(ws + WS_WUP0); t.K = 1024; t.Nout = 5632; break;
    case 4: t.W0 = a.in[6] + (size_t)1024 * 5632; t.ld0 = 5632; t.g0 = a.in[5] + 1024; t.mode = 1; t.pb0 = 0; t.pb1 = 2816; t.Wt = (bf16_t*)(ws + WS_WUP1); t.K = 1024; t.Nout = 5632; break;
    case 5: t.W0 = a.in[8]; t.ld0 = 1024; t.n0 = 1024; t.Wt = (bf16_t*)(ws + WS_WDN0); t.K = 2816; t.Nout = 1024; break;
    case 6: t.W0 = a.in[8] + (size_t)2816 * 1024; t.ld0 = 1024; t.n0 = 1024; t.Wt = (bf16_t*)(ws + WS_WDN1); t.K = 2816; t.Nout = 1024; break;
    case 7: t.W0 = a.in[10]; t.ld0 = 1536; t.n0 = 1536; t.g0 = a.in[9]; t.W1 = a.in[15]; t.ld1 = 1072; t.n1 = 1072; t.g1 = a.in[1] + 1024; t.Wt = (bf16_t*)(ws + WS_WKVQG); t.K = 1024; t.Nout = 2816; break;
    case 8: t.W0 = a.in[16]; t.ld0 = 1024; t.n0 = 1024; t.Wt = (bf16_t*)(ws + WS_WO); t.K = 1024; t.Nout = 1024; break;
    case 9: t.W0 = a.in[12]; t.ld0 = 128; t.n0 = 128; t.Wt = (bf16_t*)(ws + WS_W1T); t.K = 2048; t.Nout = 256; break;
    default: t.W0 = a.in[12] + (size_t)2048 * 128; t.ld0 = 128; t.n0 = 128; t.Wt = (bf16_t*)(ws + WS_W1T) + (size_t)256 * 2048; t.K = 2048; t.Nout = 256; break;
    }
    return t;
}
__device__ __forceinline__ void wprep_phase(const Args& a, LAS unsigned char* lds) {
    LAS float* tile = (LAS float*)lds;
    const int tid = threadIdx.x, tx = tid & 63, ty = tid >> 6;
    int jstart = 0;
    for (int j = 0; j < 11; ++j) {
        const TrJob t = get_job(j, a);
        const int nkt = t.K / 64, nnt = t.Nout / 64, ntile = nkt * nnt;
        int first = ((int)blockIdx.x - jstart % (int)gridDim.x + (int)gridDim.x) % (int)gridDim.x;
        for (int ti = first; ti < ntile; ti += gridDim.x) {
            const int kt = ti % nkt, ntl = ti / nkt, k0 = kt * 64, n0 = ntl * 64;
            const int n = n0 + tx; const float* src = nullptr; int ld = 0; const float* gp = t.g0;
            if (t.mode == 1) { const int p = n >> 8, half = (n >> 7) & 1, c = n & 127; src = t.W0 + (half ? t.pb1 : t.pb0) + 128 * p + c; ld = t.ld0; }
            else if (n < t.n0) { src = t.W0 + n; ld = t.ld0; }
            else if (n - t.n0 < t.n1) { src = t.W1 + (n - t.n0); ld = t.ld1; gp = t.g1; }
            __syncthreads();
#pragma unroll
            for (int i = 0; i < 8; ++i) { const int k = k0 + ty + 8 * i; float v = 0.f; if (src) { v = src[(size_t)k * ld]; if (gp) v *= gp[k]; } tile[(ty + 8 * i) * 65 + tx] = v; }
            __syncthreads();
            { const int nn = tid >> 3, kc = (tid & 7) * 8; u32x4 w;
                w.x = cvt_pk_bf16(tile[(kc + 0) * 65 + nn], tile[(kc + 1) * 65 + nn]); w.y = cvt_pk_bf16(tile[(kc + 2) * 65 + nn], tile[(kc + 3) * 65 + nn]);
                w.z = cvt_pk_bf16(tile[(kc + 4) * 65 + nn], tile[(kc + 5) * 65 + nn]); w.w = cvt_pk_bf16(tile[(kc + 6) * 65 + nn], tile[(kc + 7) * 65 + nn]);
                *(u32x4*)(t.Wt + (size_t)(n0 + nn) * t.K + k0 + kc) = w; }
        }
        jstart += ntile;
    }
    if (tid < 64) for (int idx = blockIdx.x; idx < 256; idx += gridDim.x) { const int j = idx >> 7, n = idx & 127; float sacc = 0.f;
            for (int k = tid; k < 2048; k += 64) sacc += a.in[11][j * 2048 + k] * a.in[12][((size_t)j * 2048 + k) * 128 + n];
            sacc = wave_sum(sacc); if (tid == 0) ((float*)(a.ws + WS_B1F))[idx] = sacc + a.in[13][idx]; }
    __syncthreads();
}

__device__ __forceinline__ void rowstat_phase(const float* src, bf16_t* dstb, float* rs, int row0, int nrows) {
    const int wave = threadIdx.x >> 6, lane = threadIdx.x & 63;
    for (int r = blockIdx.x * 8 + wave; r < nrows; r += gridDim.x * 8) {
        const size_t row = (size_t)(row0 + r); const float* p = src + row * DM; float ss = 0.f;
#pragma unroll
        for (int i = 0; i < 2; ++i) { const int c = i * 512 + lane * 8; const f32x4 v0 = __builtin_nontemporal_load((const f32x4*)(p + c)), v1 = __builtin_nontemporal_load((const f32x4*)(p + c + 4));
            ss += ((v0[0] * v0[0] + v0[1] * v0[1]) + (v0[2] * v0[2] + v0[3] * v0[3])) + ((v1[0] * v1[0] + v1[1] * v1[1]) + (v1[2] * v1[2] + v1[3] * v1[3]));
            if (dstb) { u32x4 w; w.x = cvt_pk_bf16(v0[0], v0[1]); w.y = cvt_pk_bf16(v0[2], v0[3]); w.z = cvt_pk_bf16(v1[0], v1[1]); w.w = cvt_pk_bf16(v1[2], v1[3]); *(u32x4*)(dstb + row * DM + c) = w; } }
        ss = wave_sum(ss);
        if (lane == 0) rs[row] = rsqrtf(ss * (1.0f / DM) + 1e-6f);
    }
}
__device__ __forceinline__ void final_phase(float* out, const bf16_t* xb, const float* ssp, const float* gain, int row0, int nrows) {
    const int wave = threadIdx.x >> 6, lane = threadIdx.x & 63;
    for (int r = blockIdx.x * 8 + wave; r < nrows; r += gridDim.x * 8) {
        const size_t row = (size_t)(row0 + r);
        float ss = lane < 16 ? ssp[row * 16 + lane] : 0.f; ss = wave_sum(ss);
        const float sc = rsqrtf(ss * (1.0f / DM) + 1e-6f);
#pragma unroll
        for (int i = 0; i < 2; ++i) { const int c = i * 512 + lane * 8; const bf16x8 v = __builtin_nontemporal_load((const bf16x8*)(xb + row * DM + c));
            const f32x4 g0 = *(const f32x4*)(gain + c), g1 = *(const f32x4*)(gain + c + 4);
            f32x4 o0, o1;
#pragma unroll
            for (int j = 0; j < 4; ++j) { o0[j] = bf2f((bf16_t)v[j]) * sc * g0[j]; o1[j] = bf2f((bf16_t)v[4 + j]) * sc * g1[j]; }
            __builtin_nontemporal_store(o0, (f32x4*)(out + row * DM + c)); __builtin_nontemporal_store(o1, (f32x4*)(out + row * DM + c + 4)); }
    }
}
__device__ __forceinline__ void compress_out_phase(const Args& a, LAS unsigned char* lds) {
    const float* H = (const float*)(a.ws + WS_HID); bf16_t* kcb = (bf16_t*)(a.ws + WS_KCB); const float* w2 = a.in[14];
    LAS float* w2s = (LAS float*)lds;
    const int tid = threadIdx.x, wave = tid >> 6, lane = tid & 63;
    LAS float* hrow = w2s + 2 * 128 * 64 + wave * 128;
    for (int e = tid; e < 2 * 128 * 64; e += NTHREADS) w2s[e] = w2[e];
    __syncthreads();
    for (int r = blockIdx.x * 8 + wave; r < 2 * 16384; r += gridDim.x * 8) {
        const int j = r >> 14, row = r & 16383, i = (row >> 2) & 127;
        hrow[lane] = H[(size_t)r * 128 + lane]; hrow[lane + 64] = H[(size_t)r * 128 + 64 + lane];
        asm volatile("s_waitcnt lgkmcnt(0)" ::: "memory");
        float o = 0.f;
#pragma unroll 8
        for (int n = 0; n < 128; ++n) o += hrow[n] * w2s[(j * 128 + n) * 64 + lane];
        kcb[(size_t)r * 64 + lane] = (i == 127) ? (bf16_t)0 : f2bf(o);
        asm volatile("s_waitcnt lgkmcnt(0)" ::: "memory");
    }
    __syncthreads();
}
__device__ __forceinline__ int rel_bucket(int d) { if (d < 16) return d; const int l = 16 + (int)(logf((float)d / 16.0f) / 2.0794415416798357f * 16.0f); return l < 31 ? l : 31; }

typedef float f32x16 __attribute__((ext_vector_type(16)));
typedef short s16x4 __attribute__((ext_vector_type(4)));
typedef __bf16 bf16x2_t __attribute__((ext_vector_type(2)));
#define MFMA32(a, b, c) __builtin_amdgcn_mfma_f32_32x32x16_bf16((a), (b), (c), 0, 0, 0)
constexpr int TP = 144, TILE_B = 64 * TP;
constexpr int TABN = 336;
constexpr int AT_IMP = 4 * TILE_B, AT_SELM = AT_IMP + 4 * 64 * 33 * 4, AT_BTAB = AT_SELM + 256, AT_BUCK = AT_BTAB + TABN * 16, AT_OUT = AT_BUCK + 512, AT_END = AT_OUT + 8 * 8192;
constexpr float LOG2E = 1.4426950408889634f;
__device__ __forceinline__ unsigned pk2(float a, float b) { const f32x2 v = {a, b}; return __builtin_bit_cast(unsigned, __builtin_convertvector(v, bf16x2_t)); }
__device__ __forceinline__ int crow16(int i) { return (i & 3) + 8 * (i >> 2); }

__device__ __forceinline__ float xor32f(float v, int xaddr) { return __builtin_bit_cast(float, __builtin_amdgcn_ds_bpermute(xaddr, __builtin_bit_cast(int, v))); }
template <int CTRL> __device__ __forceinline__ unsigned dppu(unsigned v) { return (unsigned)__builtin_amdgcn_update_dpp(0, (int)v, CTRL, 0xf, 0xf, true); }
struct AttnState { f32x16 O[2]; float m, l; int xaddr; };

template <int BR, bool PASS2>
__device__ __forceinline__ void attn_block(LAS unsigned char* lds, int Kt, int Vt, int kpos0, bool selbit, const bf16x8 (&qf)[4], AttnState& st, int hh, int tq, int lane,
                                           float inv, LAS float* improw, float& eprev, int blk, bool win) {
    const int h = lane >> 5, l31 = lane & 31;
    const int tq0 = __builtin_amdgcn_readfirstlane(tq - l31);
    if (BR != 0) { if (tq0 + 31 < kpos0) return; if (win && tq0 - (kpos0 + 63) >= 512) return; }
    f32x16 S[2];
#pragma unroll
    for (int kb = 0; kb < 2; ++kb) {
#pragma unroll
        for (int i = 0; i < 16; ++i) S[kb][i] = 0.f;
#pragma unroll
        for (int s = 0; s < 4; ++s) { const bf16x8 kf = *(const LAS bf16x8*)(lds + Kt + (32 * kb + l31) * TP + (16 * s + 8 * h) * 2); S[kb] = MFMA32(kf, qf[s], S[kb]); }
    }
    const LAS float* btab = (const LAS float*)(lds + AT_BTAB);
    const bool fast = (BR != 0) && (tq0 - (kpos0 + 63) >= 113) && (!win || (tq0 + 31 - kpos0) <= 511);
    float mx = -INFINITY, cb = 0.f; const bool okl = (BR == 1) ? (selbit || win) : true;
    const bool nearp = (BR == 1) && !fast && (tq0 + 31 - kpos0) <= 271;
    if (fast) { cb = btab[(127 + 64) * 4 + hh]; float mr = S[0][0];
#pragma unroll
        for (int kb = 0; kb < 2; ++kb)
#pragma unroll
            for (int i = 0; i < 16; ++i) mr = fmaxf(mr, S[kb][i]);
        mx = okl ? __builtin_fmaf(mr, LOG2E, cb) : -INFINITY;
    } else if (nearp) {
        const LAS float* tb = btab + (tq - kpos0 - 4 * h + 64 - 59) * 4 + hh;
#pragma unroll
        for (int kb = 0; kb < 2; ++kb)
#pragma unroll
            for (int i0 = 0; i0 < 16; i0 += 8) { float bv[8];
#pragma unroll
                for (int e = 0; e < 8; ++e) bv[e] = tb[(59 - 32 * kb - crow16(i0 + e)) * 4];
                __builtin_amdgcn_sched_barrier(0);
#pragma unroll
                for (int e = 0; e < 8; ++e) { const float v = __builtin_fmaf(S[kb][i0 + e], LOG2E, bv[e]); S[kb][i0 + e] = v; mx = fmaxf(mx, v); }
                __builtin_amdgcn_sched_barrier(0); }
        mx = okl ? mx : -INFINITY;
    } else {
#pragma unroll
        for (int kb = 0; kb < 2; ++kb)
#pragma unroll
            for (int i0 = 0; i0 < 16; i0 += 8) {
                float bv[8]; float pen[8];
#pragma unroll
                for (int e = 0; e < 8; ++e) { const int i = i0 + e; const int kidx = kpos0 + 32 * kb + 4 * h + crow16(i); const int dist = tq - ((BR == 0) ? (16 * kidx + 31) : kidx);
                    const int dc = dist < -1 ? -1 : (dist > 127 ? 127 : dist);
                    bv[e] = btab[(dc + 64) * 4 + hh]; pen[e] = (BR == 1 && win && dist >= 512) ? -INFINITY : 0.f; }
                __builtin_amdgcn_sched_barrier(0);
#pragma unroll
                for (int e = 0; e < 8; ++e) { const int i = i0 + e; float v = __builtin_fmaf(S[kb][i], LOG2E, bv[e]); if (BR == 1) v += pen[e]; S[kb][i] = v; mx = fmaxf(mx, v); }
                __builtin_amdgcn_sched_barrier(0);
            }
        if (BR == 1) mx = okl ? mx : -INFINITY;
    }
    __builtin_amdgcn_sched_barrier(0);
    if (!PASS2) {
        mx = fmaxf(mx, xor32f(mx, st.xaddr));
        const float mnew = fmaxf(st.m, mx), muse = (mnew == -INFINITY) ? 0.f : mnew, alpha = __builtin_amdgcn_exp2f(st.m - muse);
        float ls = 0.f;
        if (fast) { const float cbm = okl ? (cb - muse) : -INFINITY;
#pragma unroll
            for (int kb = 0; kb < 2; ++kb)
#pragma unroll
                for (int i = 0; i < 16; ++i) { const float pv = __builtin_amdgcn_exp2f(__builtin_fmaf(S[kb][i], LOG2E, cbm)); S[kb][i] = pv; ls += pv; }
        } else { const float musel = (BR == 1 && !okl) ? INFINITY : muse;
#pragma unroll
            for (int kb = 0; kb < 2; ++kb)
#pragma unroll
                for (int i = 0; i < 16; ++i) { const float pv = __builtin_amdgcn_exp2f(S[kb][i] - musel); S[kb][i] = pv; ls += pv; }
        }
        st.l = st.l * alpha + ls; st.m = mnew;
        if (__builtin_amdgcn_ballot_w64(alpha != 1.0f) != 0ull) {
#pragma unroll
            for (int db = 0; db < 2; ++db)
#pragma unroll
                for (int i = 0; i < 16; ++i) st.O[db][i] *= alpha; }
        const int i16 = lane & 15, q4 = i16 >> 2, p4 = i16 & 3, b16 = (lane >> 4) & 1;
        LAS unsigned char* vbase = lds + Vt + (4 * h + q4) * TP + 32 * b16 + 8 * p4;
#pragma unroll
        for (int kb = 0; kb < 2; ++kb) {
            bf16x8 vf[2][2];
#pragma unroll
            for (int s2 = 0; s2 < 2; ++s2)
#pragma unroll
                for (int db = 0; db < 2; ++db) { LAS unsigned char* va = vbase + (32 * kb + 16 * s2) * TP + db * 64;
                    const s16x4 lo = __builtin_bit_cast(s16x4, __builtin_amdgcn_ds_read_tr16_b64_v4i16((LAS s16x4*)va));
                    const s16x4 hi = __builtin_bit_cast(s16x4, __builtin_amdgcn_ds_read_tr16_b64_v4i16((LAS s16x4*)(va + 8 * TP)));
                    vf[s2][db] = __builtin_shufflevector(lo, hi, 0, 1, 2, 3, 4, 5, 6, 7); }
            __builtin_amdgcn_sched_barrier(0);
#pragma unroll
            for (int s2 = 0; s2 < 2; ++s2) {
                u32x4 pw; pw.x = pk2(S[kb][8 * s2 + 0], S[kb][8 * s2 + 1]); pw.y = pk2(S[kb][8 * s2 + 2], S[kb][8 * s2 + 3]); pw.z = pk2(S[kb][8 * s2 + 4], S[kb][8 * s2 + 5]); pw.w = pk2(S[kb][8 * s2 + 6], S[kb][8 * s2 + 7]);
                const bf16x8 pf = __builtin_bit_cast(bf16x8, pw);
#pragma unroll
                for (int db = 0; db < 2; ++db) st.O[db] = MFMA32(vf[s2][db], pf, st.O[db]);
            }
            __builtin_amdgcn_sched_barrier(0);
        }
    } else {
        const float muse = (st.m == -INFINITY) ? 0.f : st.m;
#pragma unroll
        for (int kb = 0; kb < 2; ++kb)
#pragma unroll
            for (int gq = 0; gq < 4; ++gq) {
                const float p0 = __builtin_amdgcn_exp2f(S[kb][4 * gq] - muse) * inv, p1 = __builtin_amdgcn_exp2f(S[kb][4 * gq + 1] - muse) * inv,
                            p2 = __builtin_amdgcn_exp2f(S[kb][4 * gq + 2] - muse) * inv, p3 = __builtin_amdgcn_exp2f(S[kb][4 * gq + 3] - muse) * inv;
                const float esw = xor32f(p3, st.xaddr);
                const float val = ((p0 + p1) + (p2 + p3)) + (h ? esw : eprev);
                improw[16 * blk + 8 * kb + 2 * gq + h] = val; eprev = esw; }
    }
}

__device__ __forceinline__ void attn_mfma_phase(const Args& a, LAS unsigned char* lds) {
    const bf16_t* kv = (const bf16_t*)(a.ws + WS_KV); const bf16_t* qb_ = (const bf16_t*)(a.ws + WS_Q); const float* gate = (const float*)(a.ws + WS_GATE);
    const bf16_t* kcb = (const bf16_t*)(a.ws + WS_KCB); bf16_t* yo = (bf16_t*)(a.ws + WS_Y); const float* relb = a.in[17];
    int tid_ = threadIdx.x; asm volatile("" : "+v"(tid_));
    const int tid = tid_, wid = __builtin_amdgcn_readfirstlane(tid >> 6), lane = tid & 63, hh = wid >> 1, qh = wid & 1, h = lane >> 5, l31 = lane & 31;
    const int lkey = tid >> 3, lch = tid & 7;
    LAS int* buck = (LAS int*)(lds + AT_BUCK); LAS float* btab = (LAS float*)(lds + AT_BTAB); LAS unsigned* selm = (LAS unsigned*)(lds + AT_SELM); LAS float* imp = (LAS float*)(lds + AT_IMP);
    if (tid < 128) buck[tid] = rel_bucket(tid);
    __syncthreads();
    const int nitems = NB * 32 * 4;
    const bool swz = gridDim.x == 256; const int bx_ = blockIdx.x, sx = bx_ & 7, ss_ = bx_ >> 3, sgrp = ss_ >> 3, sq8 = ss_ & 7;
    const int nk = swz ? 16 : (nitems - bx_ + (int)gridDim.x - 1) / (int)gridDim.x;
    for (int kk = 0; kk < nk; ++kk) {
        int qb, b, g;
        if (swz) { const int bg = sx * 16 + (kk >> 2) * 4 + sgrp, t4 = kk & 3; qb = t4 == 0 ? sq8 : (t4 == 1 ? 15 - sq8 : (t4 == 2 ? 16 + sq8 : 31 - sq8)); b = bg >> 2; g = bg & 3; }
        else { const int it = bx_ + kk * (int)gridDim.x; qb = it >> 7; b = (it >> 2) & 31; g = it & 3; }
        const int qs = 64 * qb, head = g * 4 + hh, tq = qs + 32 * qh + l31;
        const size_t rowq = (size_t)b * SEQ + tq;
        bf16x8 qf[4];
#pragma unroll
        for (int s = 0; s < 4; ++s) qf[s] = *(const bf16x8*)(qb_ + rowq * DM + head * 64 + 16 * s + 8 * h);
        const float* gp = gate + rowq * 48 + head * 3; const float g0 = gp[0], g1 = gp[1], g2 = gp[2];
        __syncthreads();
        for (int e = tid; e < TABN * 4; e += NTHREADS) { const int d = (e >> 2) - 64; btab[e] = d < 0 ? -INFINITY : relb[buck[d > 127 ? 127 : d] * 16 + g * 4 + (e & 3)] * LOG2E; }
        {
            const bf16_t* kc = kcb + (((size_t)b * 128) * 4 + g) * 64; const bf16_t* vc = kc + (size_t)NB * 128 * 4 * 64;
#pragma unroll
            for (int blk = 0; blk < 2; ++blk) { const u32x4 kx = *(const u32x4*)(kc + (size_t)(64 * blk + lkey) * 256 + lch * 8), vx = *(const u32x4*)(vc + (size_t)(64 * blk + lkey) * 256 + lch * 8);
                *(LAS u32x4*)(lds + blk * TILE_B + lkey * TP + lch * 16) = kx; *(LAS u32x4*)(lds + (2 + blk) * TILE_B + lkey * TP + lch * 16) = vx; }
        }
        __syncthreads();
        AttnState st; float edummy = 0.f; LAS unsigned char* outp = lds + AT_OUT + wid * 8192 + lane * 16;
#pragma unroll
        for (int db = 0; db < 2; ++db)
#pragma unroll
            for (int i = 0; i < 16; ++i) st.O[db][i] = 0.f;
        st.m = -INFINITY; st.l = 0.f; st.xaddr = (lane ^ 32) << 2;
#pragma nounroll
        for (int blk = 0; blk < (qb >= 16 ? 2 : 1); ++blk)
            attn_block<0, false>(lds, blk * TILE_B, (2 + blk) * TILE_B, 64 * blk, true, qf, st, hh, tq, lane, 0.f, nullptr, edummy, blk, false);
        {   const float lt = st.l + xor32f(st.l, st.xaddr), inv = lt > 0.f ? 1.0f / lt : 0.f, sc = g0 * inv;
#pragma unroll
            for (int db = 0; db < 2; ++db)
#pragma unroll
                for (int gq = 0; gq < 4; ++gq) { const f32x4 v = {st.O[db][4 * gq] * sc, st.O[db][4 * gq + 1] * sc, st.O[db][4 * gq + 2] * sc, st.O[db][4 * gq + 3] * sc};
                    *(LAS f32x4*)(outp + (db * 4 + gq) * 1024) = v; st.O[db][4 * gq] = 0.f; st.O[db][4 * gq + 1] = 0.f; st.O[db][4 * gq + 2] = 0.f; st.O[db][4 * gq + 3] = 0.f; }
            if (qb >= 16) { float ep = 0.f; LAS float* improw = imp + (hh * 64 + 32 * qh + l31) * 33;
#pragma nounroll
                for (int blk = 0; blk < 2; ++blk) attn_block<0, true>(lds, blk * TILE_B, (2 + blk) * TILE_B, 64 * blk, true, qf, st, hh, tq, lane, inv, improw, ep, blk, false); }
            st.m = -INFINITY; st.l = 0.f; }
        __syncthreads();
        if (qb >= 16) {
            {
                const int q = tid >> 3, j0 = (tid & 7) * 4;
#pragma unroll
                for (int u = 0; u < 4; ++u) { const int j = j0 + u; imp[q * 33 + j] = (imp[(0 * 64 + q) * 33 + j] + imp[(1 * 64 + q) * 33 + j]) + (imp[(2 * 64 + q) * 33 + j] + imp[(3 * 64 + q) * 33 + j]); }
            }
            __syncthreads();
            const int q = tid >> 3, sub = tid & 7; unsigned mk = 0u;
            for (int u = 0; u < 4; ++u) { const int s = 4 * sub + u; const float mine = imp[q * 33 + s];
                int rank = 0;
                for (int j = 1; j < 32; ++j) { const float ij = imp[q * 33 + j]; const bool cj = (j < qb - 1); if (cj && (ij > mine || (ij == mine && j < s))) ++rank; }
                const bool forced = (s == 0) || (s == qb) || (s == qb - 1); if (forced || (s <= qb && rank < 13)) mk |= 1u << s; }
            mk |= dppu<0xB1>(mk); mk |= dppu<0x4E>(mk); mk |= dppu<0x141>(mk);
            if (sub == 0) selm[q] = mk;
        } else if (tid < 64) selm[tid] = (qb >= 31) ? 0xffffffffu : ((2u << qb) - 1u);
        __syncthreads();
        const unsigned mysel = selm[32 * qh + l31];
        const int nsel = qb + 1, wlo = qb > 8 ? qb - 8 : 0, nstep = nsel + (qb - wlo + 1);
        const bf16_t* kvb = kv + (size_t)b * SEQ * NKV + g * 64;
        u32x4 kx, vx;
        { const bf16_t* r0 = kvb + (size_t)(0 + lkey) * NKV + lch * 8; kx = *(const u32x4*)(r0 + 2 * 256); vx = *(const u32x4*)(r0 + 3 * 256); }
        *(LAS u32x4*)(lds + 0 * TILE_B + lkey * TP + lch * 16) = kx; *(LAS u32x4*)(lds + 2 * TILE_B + lkey * TP + lch * 16) = vx;
        __syncthreads();
        for (int k = 0; k < nstep; ++k) {
            const int buf = k & 1;
            if (k + 1 < nstep) { const int k1 = k + 1, isw = k1 >= nsel, jb1 = isw ? wlo + (k1 - nsel) : k1; const bf16_t* r0 = kvb + (size_t)(64 * jb1 + lkey) * NKV + lch * 8 + (isw ? 4 * 256 : 2 * 256);
                kx = *(const u32x4*)r0; vx = *(const u32x4*)(r0 + 256); }
            if (k == nsel) {
                const float lt = st.l + xor32f(st.l, st.xaddr), sc = g1 / lt;
#pragma unroll
                for (int db = 0; db < 2; ++db)
#pragma unroll
                    for (int gq = 0; gq < 4; ++gq) { f32x4 v = *(LAS f32x4*)(outp + (db * 4 + gq) * 1024);
                        v[0] += st.O[db][4 * gq] * sc; v[1] += st.O[db][4 * gq + 1] * sc; v[2] += st.O[db][4 * gq + 2] * sc; v[3] += st.O[db][4 * gq + 3] * sc;
                        *(LAS f32x4*)(outp + (db * 4 + gq) * 1024) = v; st.O[db][4 * gq] = 0.f; st.O[db][4 * gq + 1] = 0.f; st.O[db][4 * gq + 2] = 0.f; st.O[db][4 * gq + 3] = 0.f; }
                st.m = -INFINITY; st.l = 0.f; }
            { const bool isw = k >= nsel; const int jbk = isw ? wlo + k - nsel : k;
              attn_block<1, false>(lds, buf * TILE_B, (2 + buf) * TILE_B, 64 * jbk, (mysel >> (jbk & 31)) & 1u, qf, st, hh, tq, lane, 0.f, nullptr, edummy, 0, isw); }
            if (k + 1 < nstep) { *(LAS u32x4*)(lds + (buf ^ 1) * TILE_B + lkey * TP + lch * 16) = kx; *(LAS u32x4*)(lds + (2 + (buf ^ 1)) * TILE_B + lkey * TP + lch * 16) = vx; }
            __syncthreads();
        }
        {   const float lt = st.l + xor32f(st.l, st.xaddr), sc = g2 / lt;
            u32x2 w[2][4];
#pragma unroll
            for (int db = 0; db < 2; ++db)
#pragma unroll
                for (int gq = 0; gq < 4; ++gq) { const f32x4 v = *(LAS f32x4*)(outp + (db * 4 + gq) * 1024);
                    w[db][gq].x = pk2(v[0] + st.O[db][4 * gq] * sc, v[1] + st.O[db][4 * gq + 1] * sc); w[db][gq].y = pk2(v[2] + st.O[db][4 * gq + 2] * sc, v[3] + st.O[db][4 * gq + 3] * sc); }
            LAS unsigned char* tp = lds + AT_OUT + wid * 8192;
#pragma unroll
            for (int db = 0; db < 2; ++db)
#pragma unroll
                for (int gq = 0; gq < 4; ++gq) *(LAS u32x2*)(tp + l31 * TP + (32 * db + 8 * gq + 4 * h) * 2) = w[db][gq];
            asm volatile("s_waitcnt lgkmcnt(0)" ::: "memory");
            bf16_t* obase = yo + ((size_t)b * SEQ + qs + 32 * qh) * DM + head * 64;
#pragma unroll
            for (int it = 0; it < 4; ++it) { const int r = (lane >> 3) + 8 * it, ch = lane & 7; const u32x4 v = *(const LAS u32x4*)(tp + r * TP + ch * 16); *(u32x4*)(obase + (size_t)r * DM + ch * 8) = v; }
        }
    }
    __syncthreads();
}

#define XB_TMO      128
#define XB_XCNT(j)  (256  + 64 * (j))
#define XB_XSUB(j)  (1280 + 64 * (j))
#define XB_XGEN(j)  (2304 + 64 * (j))
#define XB_TOP      3328
#define XB_TOPGEN   3392
#define XCD_BAR_WORDS 3456
#define XB_SPIN_CAP (1u << 18)
__device__ __forceinline__ unsigned xb_ld(unsigned* p)              { return __hip_atomic_load(p, __ATOMIC_RELAXED, __HIP_MEMORY_SCOPE_AGENT); }
__device__ __forceinline__ unsigned xb_add(unsigned* p, unsigned v) { return __hip_atomic_fetch_add(p, v, __ATOMIC_RELAXED, __HIP_MEMORY_SCOPE_AGENT); }
__device__ __forceinline__ unsigned xb_xcc_id() { return (unsigned)__builtin_amdgcn_s_getreg((3 << 11) | 20) & 0xFu; }
#define XB_SPIN(cond, bar) do { unsigned _sp = 0; while (cond) { __builtin_amdgcn_s_sleep(1); \
    if ((++_sp & 255u) == 0u) { if (xb_ld(&(bar)[XB_TMO])) break; if (_sp > XB_SPIN_CAP) { atomicAdd(&(bar)[XB_TMO], 1u); break; } } } } while (0)
struct XcdBarrier { unsigned* bar; unsigned x; volatile LAS unsigned* st; };
__device__ __forceinline__ XcdBarrier xcd_barrier_post(unsigned* bar, volatile LAS unsigned* st) {
    XcdBarrier b; b.bar = bar; b.x = xb_xcc_id(); b.st = st;
    if (threadIdx.x == 0) (void)xb_add(&bar[XB_XCNT(b.x)], 1u);
    return b;
}
__device__ __forceinline__ void xcd_barrier_complete(unsigned* bar, unsigned x, unsigned& nloc, unsigned& nx) {
    const unsigned G = gridDim.x * gridDim.y * gridDim.z;
    unsigned sum, cnt, mine, sp = 0u;
    for (;;) {
        sum = 0u; cnt = 0u; mine = 0u;
#pragma unroll
        for (unsigned j = 0; j < 16; ++j) { const unsigned c = xb_ld(&bar[XB_XCNT(j)]); sum += c; cnt += (c > 0u) ? 1u : 0u; mine = (j == x) ? c : mine; }
        if (sum == G) break;
        __builtin_amdgcn_s_sleep(1);
        if ((++sp & 255u) == 0u) { if (xb_ld(&bar[XB_TMO])) break; if (sp > XB_SPIN_CAP) { atomicAdd(&bar[XB_TMO], 1u); break; } }
    }
    nloc = mine > 0u ? mine : 1u; nx = cnt > 0u ? cnt : 1u;
}
__device__ __forceinline__ void xcd_barrier(const XcdBarrier& b) {
    asm volatile("s_waitcnt vmcnt(0)" ::: "memory");
    __syncthreads();
    if (threadIdx.x == 0) {
        unsigned* bar = b.bar;
        __builtin_amdgcn_s_waitcnt(0);
        unsigned nloc = b.st[0], nx = b.st[1];
        if (nloc == 0u) { xcd_barrier_complete(bar, b.x, nloc, nx); b.st[0] = nloc; b.st[1] = nx; }
        const unsigned old = xb_add(&bar[XB_XSUB(b.x)], 1u);
        const unsigned gen = old / nloc;
        if (old + 1u == (gen + 1u) * nloc) {
            __builtin_amdgcn_fence(__ATOMIC_RELEASE, "agent");
            asm volatile("s_waitcnt vmcnt(0)" ::: "memory");
            const unsigned og = xb_add(&bar[XB_TOP], 1u);
            const unsigned tg = og / nx;
            if (og + 1u == (tg + 1u) * nx) xb_add(&bar[XB_TOPGEN], 1u);
            else XB_SPIN(xb_ld(&bar[XB_TOPGEN]) == tg, bar);
            __builtin_amdgcn_fence(__ATOMIC_ACQUIRE, "agent");
            xb_add(&bar[XB_XGEN(b.x)], 1u);
            asm volatile("s_waitcnt vmcnt(0)" ::: "memory");
        } else {
            XB_SPIN(xb_ld(&bar[XB_XGEN(b.x)]) == gen, bar);
            __builtin_amdgcn_fence(__ATOMIC_ACQUIRE, "agent");
            asm volatile("s_waitcnt vmcnt(0)" ::: "memory");
        }
    }
    __syncthreads();
}

enum { PH_WPREP = 0, PH_XPREP, PH_INCV, PH_INB, PH_OUTPROJ, PH_UP0, PH_DN0, PH_KVQG, PH_CMP, PH_CMP2, PH_ATTN, PH_WO, PH_UP1, PH_DN1, PH_FINAL, PH_COUNT };

__global__ void __launch_bounds__(NTHREADS, 2) mk_fwd(Args a) {
    extern __shared__ __attribute__((aligned(16))) unsigned char lds_raw[];
    LAS unsigned char* lds = (LAS unsigned char*)lds_raw;
    LAS float* exch = (LAS float*)(lds + 131072); LAS float* epc = (LAS float*)(lds + EPC_OFF);
    unsigned char* ws = a.ws;
    const int G = gridDim.x, bx = blockIdx.x;
    const float* x_in = a.in[0]; float* xo = a.out;
    bf16_t* HB = (bf16_t*)(ws + WS_HB); bf16_t* ACT = (bf16_t*)(ws + WS_BIG); bf16_t* Y = (bf16_t*)(ws + WS_Y); bf16_t* CVC = (bf16_t*)(ws + WS_RAW);
    float* RS = (float*)(ws + WS_RS); float* SSP = (float*)(ws + WS_SSP);
    const int lo = a.ph_lo, hi = a.ph_hi;
#define IN(k) (lo <= (k) && (k) < hi)
    volatile LAS unsigned* xst = (volatile LAS unsigned*)(lds + 147456);
    if (threadIdx.x < 4) xst[threadIdx.x] = 0u;
    __syncthreads();
    const XcdBarrier xbar = xcd_barrier_post((unsigned*)(ws + WS_BAR), xst);
#define SEAM(k) do { if (IN(k) && IN((k) + 1)) xcd_barrier(xbar); } while (0)
    if (hi < 0) cg::this_grid().sync();

    if (IN(PH_WPREP)) wprep_phase(a, lds);
    if (IN(PH_XPREP)) rowstat_phase(x_in, HB, RS, 0, MROWS);
    SEAM(PH_XPREP);
    if (IN(PH_INCV)) { pg8::Gemm g = pg8::dense(HB, (const bf16_t*)(ws + WS_WIN), MROWS, 2048, 1024); g.aperm = 1; pg8::ChainOrder S; S.init(8, G, bx);
        pg8::EpiConvPair<1, false> E{RS, a.in[3], DM, 0, CVC, DM, exch, epc}; pg8::gemm_phase(lds, g, S, E); }
    SEAM(PH_INCV);
    if (IN(PH_INB)) { const pg8::Gemm g = pg8::dense(HB, (const bf16_t*)(ws + WS_WIN) + (size_t)2048 * 1024, MROWS, 1024, 1024); pg8::StaticOrder S; S.init(MROWS, 1024, G, bx);
        pg8::EpiMulB E{RS, CVC, Y}; pg8::gemm_phase(lds, g, S, E); }
    SEAM(PH_INB);
    if (IN(PH_OUTPROJ)) { const pg8::Gemm g = pg8::dense(Y, (const bf16_t*)(ws + WS_WOUT), MROWS, 1024, 1024); pg8::StaticOrder S; S.init(MROWS, 1024, G, bx);
        pg8::EpiResid<true, false> E{x_in, HB, nullptr, SSP}; pg8::gemm_phase(lds, g, S, E); }
    SEAM(PH_OUTPROJ);
    if (IN(PH_UP0)) { pg8::Gemm g = pg8::dense(HB, (const bf16_t*)(ws + WS_WUP0), MROWS, 5632, 1024); g.aperm = 1; pg8::ChainOrder S; S.init(22, G, bx);
        pg8::EpiConvPair<0, true> E{SSP, a.in[7], 5632, DFF, ACT, DFF, exch, epc}; pg8::gemm_phase(lds, g, S, E); }
    SEAM(PH_UP0);
    if (IN(PH_DN0)) { const pg8::Gemm g = pg8::dense(ACT, (const bf16_t*)(ws + WS_WDN0), MROWS, 1024, 2816); pg8::StaticOrder S; S.init(MROWS, 1024, G, bx);
        pg8::EpiResid<false, false> E{nullptr, HB, nullptr, SSP}; pg8::gemm_phase(lds, g, S, E); }
    SEAM(PH_DN0);
    if (IN(PH_KVQG)) { const pg8::Gemm g = pg8::dense(HB, (const bf16_t*)(ws + WS_WKVQG), MROWS, NKVQG, 1024); pg8::StaticOrder S; S.init(MROWS, NKVQG, G, bx);
        pg8::EpiKVQG E{SSP, (bf16_t*)(ws + WS_KV), (bf16_t*)(ws + WS_Q), (float*)(ws + WS_GATE), epc}; pg8::gemm_phase(lds, g, S, E); }
    SEAM(PH_KVQG);
    if (IN(PH_CMP)) { pg8::Gemm g = pg8::dense((const bf16_t*)(ws + WS_KV), (const bf16_t*)(ws + WS_W1T), 16384, 512, 2048);
        g.amode = 1; g.a_kstep = (size_t)NKV * 2; g.a_hstep = (size_t)32 * 16 * NKV * 2; g.a_tstep = (size_t)1024 * NKV * 2; g.a_pnstep = 512;
        pg8::StaticOrder S; S.init(16384, 512, G, bx); pg8::EpiCmpHidden E{(const float*)(ws + WS_B1F), (float*)(ws + WS_HID)}; pg8::gemm_phase(lds, g, S, E); }
    SEAM(PH_CMP);
    if (IN(PH_CMP2)) compress_out_phase(a, lds);
    SEAM(PH_CMP2);
    if (IN(PH_ATTN)) attn_mfma_phase(a, lds);
    SEAM(PH_ATTN);
    if (IN(PH_WO)) { const pg8::Gemm g = pg8::dense(Y, (const bf16_t*)(ws + WS_WO), MROWS, 1024, 1024); pg8::StaticOrder S; S.init(MROWS, 1024, G, bx);
        pg8::EpiResid<false, false> E{nullptr, HB, nullptr, SSP}; pg8::gemm_phase(lds, g, S, E); }
    SEAM(PH_WO);
    if (IN(PH_UP1)) { pg8::Gemm g = pg8::dense(HB, (const bf16_t*)(ws + WS_WUP1), MROWS, 5632, 1024); g.aperm = 1; pg8::ChainOrder S; S.init(22, G, bx);
        pg8::EpiConvPair<0, true> E{SSP, a.in[7] + 3 * 5632, 5632, DFF, ACT, DFF, exch, epc}; pg8::gemm_phase(lds, g, S, E); }
    SEAM(PH_UP1);
    if (IN(PH_DN1)) { const pg8::Gemm g = pg8::dense(ACT, (const bf16_t*)(ws + WS_WDN1), MROWS, 1024, 2816); pg8::StaticOrder S; S.init(MROWS, 1024, G, bx);
        pg8::EpiResid<false, false> E{nullptr, HB, nullptr, SSP}; pg8::gemm_phase(lds, g, S, E); }
    SEAM(PH_DN1);
    if (IN(PH_FINAL)) final_phase(xo, HB, SSP, a.in[18], 0, MROWS);
#undef IN
#undef SEAM
}

extern "C" void kernel_launch(void* const* d_in, const int* in_sizes, int n_in, void* d_out, int out_size, void* d_ws, size_t ws_size, hipStream_t stream) {
    static int grid = 0;
    if (grid == 0) {
        if (n_in != 19 || ws_size < WS_END) { fprintf(stderr, "kernel_launch: unexpected shapes (n_in %d, ws %zu < %zu)\n", n_in, ws_size, (size_t)WS_END); grid = -1; return; }
        int dev = 0, cus = 0;
        (void)hipGetDevice(&dev); (void)hipDeviceGetAttribute(&cus, hipDeviceAttributeMultiprocessorCount, dev);
        if (hipFuncSetAttribute((const void*)mk_fwd, hipFuncAttributeMaxDynamicSharedMemorySize, LDS_BYTES) != hipSuccess) { fprintf(stderr, "kernel_launch: hipFuncSetAttribute failed\n"); grid = -1; return; }
        int per_cu = 0;
        if (hipOccupancyMaxActiveBlocksPerMultiprocessor(&per_cu, (const void*)mk_fwd, NTHREADS, LDS_BYTES) != hipSuccess || per_cu < 1) per_cu = 1;
        (void)hipGetLastError();
        grid = (cus > 0 ? cus : 256) * per_cu;
    }
    if (grid < 0) return;
    Args a{};
    for (int i = 0; i < 19; ++i) a.in[i] = (const float*)d_in[i];
    a.out = (float*)d_out; a.ws = (unsigned char*)d_ws;
    (void)hipMemsetAsync((unsigned char*)d_ws + WS_BAR, 0, 16384, stream);
    a.ph_lo = 0; a.ph_hi = PH_COUNT;
    void* kargs[] = {&a};
    hipError_t e = hipLaunchCooperativeKernel((const void*)mk_fwd, dim3(grid), dim3(NTHREADS), kargs, LDS_BYTES, stream);
    if (e != hipSuccess) fprintf(stderr, "cooperative launch failed: %s (grid %d)\n", hipGetErrorString(e), grid);
}
```
